# Optimizing an MI355X kernel written in HIP

```python
import jax, jax.numpy as jnp
from jax import lax
import numpy as np

D_MODEL = 1024
BATCH = 8
SEQ = 2048
DEPTH = 1
DEC_BATCH = 128
DEC_SEQ = 1
PAST_LEN = 16384
PAGE_SIZE = 128

D_A = D_MODEL
G_A = 8
D_B = D_MODEL
G_B = 8
DG_B = D_B // G_B
CHUNK = 128
CONV_W = 3
D_FF = 2816
P_DIM = 256
N_IN = 3 * D_A + 2 * D_B + 2 * D_MODEL
EPS = 1e-6

kernel_name = "hybrid_shortconv_gmlp_convffn_step"


def rmsnorm(x, g):
    xf = x.astype(jnp.float32)
    xf = xf * lax.rsqrt(jnp.mean(xf * xf, axis=-1, keepdims=True) + EPS)
    return (xf * g.astype(jnp.float32)).astype(x.dtype)


def causal_dwconv(x, w, prev):
    L = x.shape[1]
    xp = jnp.concatenate([prev, x], axis=1)
    y = xp[:, 0:L] * w[0]
    for k in range(1, CONV_W):
        y = y + xp[:, k:k + L] * w[k]
    return y, xp[:, -(CONV_W - 1):]


def chunk_spatial(v, w_s, b_s):
    B, L, _ = v.shape
    lc = min(L, CHUNK)
    n_c = -(-L // lc)
    lp = n_c * lc
    vp = jnp.pad(v, ((0, 0), (0, lp - L), (0, 0))).reshape(B, n_c, lc, G_B, DG_B)
    w = jnp.tril(w_s[:, :lc, :lc])
    out = jnp.einsum("gts,bcsgd->bctgd", w, vp) + b_s[:, :lc].T[None, None, :, :, None]
    return out.reshape(B, lp, D_B)[:, :L]


def layer(h, p, prev_a, prev_ffn, g_mix, w_in, w_conv_a, w_out_a, g_v, w_spatial, b_spatial,
          w_out_b, w_o, g_ffn, w_up, w_conv_ffn, w_down, g_ple, w_ple_gate, w_ple):
    L = h.shape[1]
    xn = rmsnorm(h, g_mix)
    z = xn @ w_in
    x_a, b_a, c_a, uv, ga, gb = jnp.split(
        z, [D_A, 2 * D_A, 3 * D_A, 3 * D_A + 2 * D_B, 3 * D_A + 2 * D_B + D_MODEL], axis=-1)
    a_conv, new_a = causal_dwconv(c_a * x_a, w_conv_a, prev_a)
    y_a = (b_a * a_conv) @ w_out_a
    uv = jax.nn.gelu(uv)
    u, v = jnp.split(uv, 2, axis=-1)
    v = rmsnorm(v, g_v)
    s = chunk_spatial(v, w_spatial, b_spatial)
    y_b = (u * s) @ w_out_b
    start = ((L - 1) // CHUNK) * CHUNK
    chunk_v = v[:, start:]
    m = jax.nn.sigmoid(ga) * y_a + jax.nn.sigmoid(gb) * y_b
    h = h + m @ w_o
    up = rmsnorm(h, g_ffn) @ w_up
    up_c, new_ffn = causal_dwconv(up, w_conv_ffn, prev_ffn)
    fa, fb = jnp.split(up_c, 2, axis=-1)
    h = h + (jax.nn.gelu(fa) * fb) @ w_down
    gate = jax.nn.sigmoid(rmsnorm(h, g_ple) @ w_ple_gate)
    h = h + gate * (p @ w_ple)
    return h, new_a, chunk_v, new_ffn


def setup_inputs(seed: int = 0) -> dict:
    key = jax.random.key(seed)
    ks = jax.random.split(key, 24)
    f32 = jnp.float32

    def nrm(k, shape, scale):
        return jax.random.normal(k, shape, f32) * scale

    def gain(k, shape):
        return 1.0 + 0.05 * jax.random.normal(k, shape, f32)

    return {
        "x_prompt": nrm(ks[0], (BATCH, SEQ, D_MODEL), 1.0),
        "x_sample": nrm(ks[1], (DEC_BATCH, DEC_SEQ, D_MODEL), 1.0),
        "p_prompt": nrm(ks[2], (DEPTH, BATCH, SEQ, P_DIM), 1.0),
        "p_sample": nrm(ks[3], (DEPTH, DEC_BATCH, DEC_SEQ, P_DIM), 1.0),
        "state_conv_a": nrm(ks[4], (DEPTH, DEC_BATCH, CONV_W - 1, D_A), 1.0),
        "state_conv_ffn": nrm(ks[5], (DEPTH, DEC_BATCH, CONV_W - 1, 2 * D_FF), 1.0),
        "g_mix": gain(ks[6], (DEPTH, D_MODEL)),
        "w_in": nrm(ks[7], (DEPTH, D_MODEL, N_IN), D_MODEL ** -0.5),
        "w_conv_a": nrm(ks[8], (DEPTH, CONV_W, D_A), CONV_W ** -0.5),
        "w_out_a": nrm(ks[9], (DEPTH, D_A, D_MODEL), D_A ** -0.5),
        "g_v": gain(ks[10], (DEPTH, D_B)),
        "w_spatial": nrm(ks[11], (DEPTH, G_B, CHUNK, CHUNK), CHUNK ** -0.5),
        "b_spatial": 1.0 + 0.05 * jax.random.normal(ks[12], (DEPTH, G_B, CHUNK), f32),
        "w_out_b": nrm(ks[13], (DEPTH, D_B, D_MODEL), D_B ** -0.5),
        "w_o": nrm(ks[14], (DEPTH, D_MODEL, D_MODEL), 0.5 * D_MODEL ** -0.5),
        "g_ffn": gain(ks[15], (DEPTH, D_MODEL)),
        "w_up": nrm(ks[16], (DEPTH, D_MODEL, 2 * D_FF), D_MODEL ** -0.5),
        "w_conv_ffn": nrm(ks[17], (DEPTH, CONV_W, 2 * D_FF), CONV_W ** -0.5),
        "w_down": nrm(ks[18], (DEPTH, D_FF, D_MODEL), 0.5 * D_FF ** -0.5),
        "g_ple": gain(ks[19], (DEPTH, D_MODEL)),
        "w_ple_gate": nrm(ks[20], (DEPTH, D_MODEL, D_MODEL), D_MODEL ** -0.5),
        "w_ple": nrm(ks[21], (DEPTH, P_DIM, D_MODEL), P_DIM ** -0.5),
        "g_final": gain(ks[22], (D_MODEL,)),
    }


def reference(x_prompt, x_sample, p_prompt, p_sample, state_conv_a, state_conv_ffn,
              g_mix, w_in, w_conv_a, w_out_a, g_v, w_spatial, b_spatial, w_out_b, w_o,
              g_ffn, w_up, w_conv_ffn, w_down, g_ple, w_ple_gate, w_ple, g_final):
    hp, hs = x_prompt, x_sample
    ca_p, ca_s, cv_p, cv_s, cf_p, cf_s = [], [], [], [], [], []
    for i in range(DEPTH):
        params = (g_mix[i], w_in[i], w_conv_a[i], w_out_a[i], g_v[i], w_spatial[i], b_spatial[i],
                  w_out_b[i], w_o[i], g_ffn[i], w_up[i], w_conv_ffn[i], w_down[i], g_ple[i],
                  w_ple_gate[i], w_ple[i])
        zero_a = jnp.zeros((hp.shape[0], CONV_W - 1, D_A), hp.dtype)
        zero_f = jnp.zeros((hp.shape[0], CONV_W - 1, 2 * D_FF), hp.dtype)
        hp, na, vp, nf = layer(hp, p_prompt[i], zero_a, zero_f, *params)
        ca_p.append(na); cv_p.append(vp); cf_p.append(nf)
        hs, na, vs, nf = layer(hs, p_sample[i], state_conv_a[i], state_conv_ffn[i], *params)
        ca_s.append(na); cv_s.append(vs); cf_s.append(nf)
    y_prompt = rmsnorm(hp, g_final)
    y_sample = rmsnorm(hs, g_final)
    new_conv_a_prompt = jnp.stack(ca_p)
    new_conv_a_sample = jnp.stack(ca_s)
    chunk_v_prompt = jnp.stack(cv_p)
    chunk_v_sample = jnp.stack(cv_s)
    new_conv_ffn_prompt = jnp.stack(cf_p)
    new_conv_ffn_sample = jnp.stack(cf_s)
    return (y_prompt, y_sample, new_conv_a_prompt, new_conv_a_sample, chunk_v_prompt,
            chunk_v_sample, new_conv_ffn_prompt, new_conv_ffn_sample)
```

```cpp
#include <hip/hip_runtime.h>
#include <cstdio>
#include <cstdint>
namespace pg8 {
#define PG8_LAS __attribute__((address_space(3)))
typedef unsigned short bf16_t;
typedef short bf16x8 __attribute__((ext_vector_type(8)));
typedef float f32x4 __attribute__((ext_vector_type(4)));
typedef unsigned u32x4 __attribute__((ext_vector_type(4)));
constexpr int BM = 256, BK = 64, HALF = 128, HTB = HALF * BK * 2  , STAGE_BYTES = 8 * HTB, NXCD = 8, WGM = 8;

__host__ __device__ __forceinline__ int lds_byte(int r, int c) { const int st = (r >> 4) * 2 + (c >> 5), rr = r & 15, cc = c & 31, ob = rr * 64 + cc * 2; return st * 1024 + (ob ^ (((ob >> 9) & 1) << 5)); }
__host__ __device__ __forceinline__ void stage_rc(int b, int& R, int& C) { const int st = b / 1024, sb = b % 1024, swz = sb ^ (((sb >> 9) & 1) << 5); R = (st >> 1) * 16 + swz / 64; C = (st & 1) * 32 + (swz % 64) / 2; }
__host__ __device__ __forceinline__ int perm32(int rho) { const int n = rho >> 4, i = rho & 15; return 8 * (i >> 2) + 4 * n + (i & 3); }

struct Unit { int pm, pn; };
struct Gemm { const bf16_t* A; const bf16_t* Bt; int M, N, K, lda, ldb, pad; };

struct StaticOrder {
    int nM, nN, nwg, G, c;
    __host__ __device__ void init(int M, int N, int G_, int c_) { nM = M / BM; nN = N / BM; nwg = nM * nN; G = G_; c = c_; }
    __host__ __device__ bool next(int i, Unit& u) const {
        const long L = (long)i * G + c; if (L >= nwg) return false;
        int wgid = (int)L; { const int q = nwg / NXCD, r = nwg % NXCD, xcd = wgid % NXCD, off = wgid / NXCD; wgid = (xcd < r ? xcd * (q + 1) : r * (q + 1) + (xcd - r) * q) + off; }
        const int nig = WGM * nN, gid = wgid / nig, fm = gid * WGM, gsz = (nM - fm) < WGM ? (nM - fm) : WGM;
        u.pm = fm + ((wgid % nig) % gsz); u.pn = (wgid % nig) / gsz; return true;
    }
    __device__ __forceinline__ void a_ready(const Unit&) const {}
    __device__ __forceinline__ void done(const Unit&) const {}
};


__device__ __forceinline__ unsigned cvt_pk_bf16(float lo, float hi) { unsigned r; asm volatile("v_cvt_pk_bf16_f32 %0, %1, %2" : "=v"(r) : "v"(lo), "v"(hi)); return r; }
template <class Epi, class Sched, bool ALIGN_EPI = false, bool SP2 = false>
__device__ __forceinline__ void gemm_phase(PG8_LAS unsigned char* lds, const Gemm g, const Sched& S, const Epi& E) {
    const int tid = threadIdx.x, wid = __builtin_amdgcn_readfirstlane(tid >> 6), lane = tid & 63, wr = wid >> 2, wc = wid & 3, fr = lane & 15, fq = lane >> 4;
    const int K = g.K, nt = K / BK;
    unsigned voffA[2], voffB[2];
#pragma unroll
    for (int i = 0; i < 2; ++i) { int R, C; stage_rc(tid * 16 + i * 8192, R, C); voffA[i] = (unsigned)(R * g.lda + C) * 2u; voffB[i] = (unsigned)(R * g.ldb + C) * 2u; }
    const size_t kstep = (size_t)(BK * 2);
    const size_t hstepA = (size_t)HALF * g.lda * 2, hstepB = (size_t)HALF * g.ldb * 2;
    const size_t tstepA = 2 * hstepA, tstepB = 2 * hstepB;
    const unsigned ldsw = (unsigned)wid * 1024u;
    const int aoff = lds_byte(wr * 64 + fr, fq * 8), boff = lds_byte(wc * 32 + fr, fq * 8);
#define PG8_SA(b, h) (((b) * 2 + (h)) * HTB)
#define PG8_SB(b, h) ((4 + (b) * 2 + (h)) * HTB)
#define PG8_STAGE(bufoff, gbase, voff) do { _Pragma("unroll") for (int _i = 0; _i < 2; ++_i) \
        __builtin_amdgcn_global_load_lds((const unsigned*)((const char*)(gbase) + (voff)[_i]), (PG8_LAS unsigned*)(lds + (bufoff) + ldsw + _i * 8192), 16, 0, 0); } while (0)
#define PG8_LDA(dst, b, h) do { _Pragma("unroll") for (int m = 0; m < 4; ++m) _Pragma("unroll") for (int k = 0; k < 2; ++k) dst[m][k] = *(const PG8_LAS bf16x8*)(lds + PG8_SA(b, h) + aoff + m * 2048 + k * 1024); } while (0)
#define PG8_LDB(dst, b, h) do { _Pragma("unroll") for (int n = 0; n < 2; ++n) _Pragma("unroll") for (int k = 0; k < 2; ++k) dst[n][k] = *(const PG8_LAS bf16x8*)(lds + PG8_SB(b, h) + boff + n * 2048 + k * 1024); } while (0)
#define PG8_MMA(ai, bj, At, Bt) do { __builtin_amdgcn_s_setprio(1); _Pragma("unroll") for (int m = 0; m < 4; ++m) _Pragma("unroll") for (int n = 0; n < 2; ++n) _Pragma("unroll") for (int k = 0; k < 2; ++k) \
        acc[ai][bj][m][n] = __builtin_amdgcn_mfma_f32_16x16x32_bf16(Bt[n][k], At[m][k], acc[ai][bj][m][n], 0, 0, 0); __builtin_amdgcn_s_setprio(0); } while (0)
#define PG8_WAIT_V(n) asm volatile("s_waitcnt vmcnt(" #n ")" ::: "memory")
#define PG8_WAIT_L(n) asm volatile("s_waitcnt lgkmcnt(" #n ")" ::: "memory")
#define PG8_BAR __builtin_amdgcn_s_barrier()
#define PG8_SCHED __builtin_amdgcn_sched_barrier(0)
    Unit cur, nxt; int ui = 0;
    if (!S.next(0, cur)) return;
    f32x4 acc[2][2][4][2];
#pragma unroll
    for (int a = 0; a < 2; ++a)
#pragma unroll
        for (int b = 0; b < 2; ++b)
#pragma unroll
            for (int m = 0; m < 4; ++m)
#pragma unroll
                for (int n = 0; n < 2; ++n) acc[a][b][m][n] = (f32x4){0.f, 0.f, 0.f, 0.f};
    bf16x8 At[4][2], B0[2][2], B1[2][2];
    const char* cA = (const char*)g.A + (size_t)cur.pm * tstepA; const char* cB = (const char*)g.Bt + (size_t)cur.pn * tstepB;
    S.a_ready(cur);
    if constexpr (SP2) {
        PG8_STAGE(PG8_SB(0, 0), cB, voffB); PG8_STAGE(PG8_SB(0, 1), cB + hstepB, voffB); PG8_STAGE(PG8_SA(0, 0), cA, voffA); PG8_STAGE(PG8_SA(0, 1), cA + hstepA, voffA);
        if (wr == 1) PG8_BAR;
        PG8_WAIT_V(2); PG8_BAR;
        PG8_STAGE(PG8_SB(1, 0), cB + kstep, voffB); PG8_STAGE(PG8_SA(1, 0), cA + kstep, voffA); PG8_STAGE(PG8_SB(1, 1), cB + hstepB + kstep, voffB);
        PG8_WAIT_V(6); PG8_BAR;
    } else {
        PG8_STAGE(PG8_SB(0, 0), cB, voffB); PG8_STAGE(PG8_SA(0, 0), cA, voffA); PG8_STAGE(PG8_SB(0, 1), cB + hstepB, voffB); PG8_STAGE(PG8_SA(0, 1), cA + hstepA, voffA);
        if (wr == 1) PG8_BAR;
        PG8_WAIT_V(4); PG8_BAR;
        PG8_STAGE(PG8_SB(1, 0), cB + kstep, voffB); PG8_STAGE(PG8_SA(1, 0), cA + kstep, voffA); PG8_STAGE(PG8_SB(1, 1), cB + hstepB + kstep, voffB);
        PG8_WAIT_V(6); PG8_BAR;
    }
    for (;;) {
        const bool has_next = S.next(ui + 1, nxt);
        const char* nA = has_next ? (const char*)g.A + (size_t)nxt.pm * tstepA : cA; const char* nB = has_next ? (const char*)g.Bt + (size_t)nxt.pn * tstepB : cB;
        for (int t = 0; t < nt; t += 2) {
            const bool last = (t == nt - 2);
            const char* a1 = cA + (size_t)(t + 1) * kstep;
            const char* a2 = last ? nA : cA + (size_t)(t + 2) * kstep; const char* b2 = last ? nB : cB + (size_t)(t + 2) * kstep;
            const char* a3 = a2 + kstep; const char* b3 = b2 + kstep;
            if (last && has_next) S.a_ready(nxt);
            if constexpr (SP2) {
            PG8_LDB(B0, 0, 0); PG8_LDB(B1, 0, 1); PG8_SCHED; PG8_LDA(At, 0, 0); PG8_STAGE(PG8_SA(1, 1), a1 + hstepA, voffA);
            PG8_WAIT_V(8); PG8_WAIT_L(0); PG8_BAR; PG8_MMA(0, 0, At, B0); PG8_MMA(0, 1, At, B1); PG8_BAR; PG8_SCHED;
            PG8_LDA(At, 0, 1); PG8_STAGE(PG8_SB(0, 0), b2, voffB); PG8_STAGE(PG8_SB(0, 1), b2 + hstepB, voffB); PG8_STAGE(PG8_SA(0, 0), a2, voffA);
            PG8_WAIT_V(8); PG8_WAIT_L(0); PG8_BAR; PG8_MMA(1, 0, At, B0); PG8_MMA(1, 1, At, B1); PG8_BAR; PG8_SCHED;
            PG8_LDB(B0, 1, 0); PG8_LDB(B1, 1, 1); PG8_SCHED; PG8_LDA(At, 1, 0); PG8_STAGE(PG8_SA(0, 1), a2 + hstepA, voffA);
            PG8_WAIT_V(8); PG8_WAIT_L(0); PG8_BAR; PG8_MMA(0, 0, At, B0); PG8_MMA(0, 1, At, B1); PG8_BAR; PG8_SCHED;
            PG8_LDA(At, 1, 1); PG8_STAGE(PG8_SB(1, 0), b3, voffB); PG8_STAGE(PG8_SB(1, 1), b3 + hstepB, voffB); PG8_STAGE(PG8_SA(1, 0), a3, voffA);
            PG8_WAIT_V(8); PG8_WAIT_L(0); PG8_BAR; PG8_MMA(1, 0, At, B0); PG8_MMA(1, 1, At, B1); PG8_BAR; PG8_SCHED;
            } else {
            PG8_LDB(B0, 0, 0); PG8_SCHED; PG8_LDA(At, 0, 0); PG8_STAGE(PG8_SA(1, 1), a1 + hstepA, voffA);
            PG8_WAIT_L(8); PG8_BAR; PG8_WAIT_L(0); PG8_MMA(0, 0, At, B0); PG8_BAR; PG8_SCHED;
            PG8_LDB(B1, 0, 1); PG8_STAGE(PG8_SB(0, 0), b2, voffB);
            PG8_BAR; PG8_WAIT_L(0); PG8_MMA(0, 1, At, B1); PG8_BAR;
            PG8_LDA(At, 0, 1); PG8_STAGE(PG8_SA(0, 0), a2, voffA);
            PG8_BAR; PG8_WAIT_L(0); PG8_MMA(1, 0, At, B0); PG8_BAR; PG8_SCHED;
            PG8_STAGE(PG8_SB(0, 1), b2 + hstepB, voffB);
            PG8_WAIT_V(6); PG8_BAR; PG8_MMA(1, 1, At, B1); PG8_BAR;
            PG8_LDB(B0, 1, 0); PG8_SCHED; PG8_LDA(At, 1, 0); PG8_STAGE(PG8_SA(0, 1), a2 + hstepA, voffA);
            PG8_WAIT_L(8); PG8_BAR; PG8_WAIT_L(0); PG8_MMA(0, 0, At, B0); PG8_BAR; PG8_SCHED;
            PG8_LDB(B1, 1, 1); PG8_STAGE(PG8_SB(1, 0), b3, voffB);
            PG8_BAR; PG8_WAIT_L(0); PG8_MMA(0, 1, At, B1); PG8_BAR;
            PG8_LDA(At, 1, 1); PG8_STAGE(PG8_SA(1, 0), a3, voffA);
            PG8_BAR; PG8_WAIT_L(0); PG8_MMA(1, 0, At, B0); PG8_BAR; PG8_SCHED;
            PG8_STAGE(PG8_SB(1, 1), b3 + hstepB, voffB);
            PG8_WAIT_V(6); PG8_BAR; PG8_MMA(1, 1, At, B1); PG8_BAR;
            }
        }
        if constexpr (ALIGN_EPI) { if (wr == 0) PG8_BAR; }
        if constexpr (!Epi::AFTER_DRAIN) { E(acc, cur, wr, wc, fr, fq); S.done(cur); }
        if (!has_next) break;
#pragma unroll
        for (int a = 0; a < 2; ++a)
#pragma unroll
            for (int b = 0; b < 2; ++b)
#pragma unroll
                for (int m = 0; m < 4; ++m)
#pragma unroll
                    for (int n = 0; n < 2; ++n) acc[a][b][m][n] = (f32x4){0.f, 0.f, 0.f, 0.f};
        cur = nxt; cA = nA; cB = nB; ++ui;
        if constexpr (ALIGN_EPI) { if (wr == 1) PG8_BAR; }
    }
    PG8_WAIT_V(0);
    if constexpr (!ALIGN_EPI) { if (wr == 0) PG8_BAR; }
    PG8_BAR;
    if constexpr (Epi::AFTER_DRAIN) { E.fused(acc, cur, wr, wc, fr, fq, lds, wid, lane); S.done(cur); }
#undef PG8_SA
#undef PG8_SB
#undef PG8_STAGE
#undef PG8_LDA
#undef PG8_LDB
#undef PG8_MMA
#undef PG8_WAIT_V
#undef PG8_WAIT_L
#undef PG8_BAR
#undef PG8_SCHED
}
}

using pg8::bf16_t; using pg8::f32x4; using pg8::u32x4; using pg8::Unit; using pg8::cvt_pk_bf16;
constexpr int D = 1024, NBATCH = 8, SEQ = 2048, MP = NBATCH * SEQ, MS = 128, MV = MP + MS  , MALL = MP + 256  ;
constexpr int NIN = 7168, DFF = 2816, NUP = 2 * DFF, PD = 256;
constexpr float EPS = 1e-6f;
constexpr int LDS_BYTES = 131072;

constexpr size_t O_Y = 0;
constexpr size_t O_CAP = (size_t)MV * D;
constexpr size_t O_CAS = O_CAP + (size_t)NBATCH * 2 * D;
constexpr size_t O_CVP = O_CAS + (size_t)MS * 2 * D;
constexpr size_t O_CVS = O_CVP + (size_t)NBATCH * 128 * D;
constexpr size_t O_CFP = O_CVS + (size_t)MS * D;
constexpr size_t O_CFS = O_CFP + (size_t)NBATCH * 2 * NUP;
constexpr size_t O_END = O_CFS + (size_t)MS * 2 * NUP;

__device__ __forceinline__ float gelu_tanh(float x) {
    const float t = x * x;
    const float u2 = x * (2.3022082f + 0.10294324f * t);
    const float e = __builtin_amdgcn_exp2f(-u2);
    return x * __builtin_amdgcn_rcpf(1.0f + e);
}
__device__ __forceinline__ float sigmoid_f(float x) { return __builtin_amdgcn_rcpf(1.0f + __builtin_amdgcn_exp2f(-1.4426950409f * x)); }
__device__ __forceinline__ float bf2f(unsigned short b) { return __uint_as_float(((unsigned)b) << 16); }
__device__ __forceinline__ void store8_bf16(bf16_t* p, f32x4 v0, f32x4 v1) {
    u32x4 w; w.x = cvt_pk_bf16(v0[0], v0[1]); w.y = cvt_pk_bf16(v0[2], v0[3]); w.z = cvt_pk_bf16(v1[0], v1[1]); w.w = cvt_pk_bf16(v1[2], v1[3]);
    *(u32x4*)p = w;
}
__device__ __forceinline__ void load8_bf16(const bf16_t* p, f32x4& v0, f32x4& v1) {
    const u32x4 w = *(const u32x4*)p;
    v0 = (f32x4){__uint_as_float(w.x << 16), __uint_as_float(w.x & 0xffff0000u), __uint_as_float(w.y << 16), __uint_as_float(w.y & 0xffff0000u)};
    v1 = (f32x4){__uint_as_float(w.z << 16), __uint_as_float(w.z & 0xffff0000u), __uint_as_float(w.w << 16), __uint_as_float(w.w & 0xffff0000u)};
}
__device__ __forceinline__ float sum4sq(f32x4 v) { return (v[0] * v[0] + v[1] * v[1]) + (v[2] * v[2] + v[3] * v[3]); }

#define EPI_ROW(ai, m) (u.pm * 256 + (ai) * 128 + wr * 64 + (m) * 16 + fr)
typedef const f32x4 (&AccRef)[2][2][4][2];

struct EpiIn {
    static constexpr bool AFTER_DRAIN = false;
    const float* rstd0; bf16_t *ca, *ba, *uu, *vp, *sga, *sgb; float* vssq; float* out;
    __device__ __forceinline__ void operator()(AccRef acc, const Unit& u, int wr, int wc, int fr, int fq) const {
        const int tile = u.pn, hc = wc * 32 + 8 * fq;
        if (tile < 8) {
#pragma unroll
            for (int ai = 0; ai < 2; ++ai)
#pragma unroll
                for (int m = 0; m < 4; ++m) {
                    const int r = EPI_ROW(ai, m); const float rs = rstd0[r];
                    const f32x4 p0 = (acc[ai][0][m][0] * rs) * (acc[ai][1][m][0] * rs), p1 = (acc[ai][0][m][1] * rs) * (acc[ai][1][m][1] * rs);
                    store8_bf16(ca + (size_t)r * D + 128 * tile + hc, p0, p1);
                    if (r < MP) { const int t = r & (SEQ - 1); if (t >= SEQ - 2) { float* o = out + O_CAP + ((size_t)((r >> 11) * 2 + (t - (SEQ - 2)))) * D + 128 * tile + hc; *(f32x4*)o = p0; *(f32x4*)(o + 4) = p1; } }
                    else if (r < MV) { float* o = out + O_CAS + ((size_t)((r - MP) * 2 + 1)) * D + 128 * tile + hc; *(f32x4*)o = p0; *(f32x4*)(o + 4) = p1; }
                }
        } else {
            const int type = (tile - 8) >> 2, tl = (tile - 8) & 3;
            bf16_t* dst = type == 0 ? ba : type == 1 ? uu : type == 2 ? vp : type == 3 ? sga : sgb;
            dst += 256 * tl + hc;
            if (type == 0) {
#pragma unroll
                for (int ai = 0; ai < 2; ++ai)
#pragma unroll
                    for (int m = 0; m < 4; ++m) { const int r = EPI_ROW(ai, m); const float rs = rstd0[r];
#pragma unroll
                        for (int bj = 0; bj < 2; ++bj) store8_bf16(dst + (size_t)r * D + 128 * bj, acc[ai][bj][m][0] * rs, acc[ai][bj][m][1] * rs); }
            } else if (type <= 2) {
#pragma unroll
                for (int ai = 0; ai < 2; ++ai)
#pragma unroll
                    for (int m = 0; m < 4; ++m) { const int r = EPI_ROW(ai, m); const float rs = rstd0[r]; float s = 0.f;
#pragma unroll
                        for (int bj = 0; bj < 2; ++bj) { f32x4 v0 = acc[ai][bj][m][0] * rs, v1 = acc[ai][bj][m][1] * rs;
#pragma unroll
                            for (int j = 0; j < 4; ++j) { v0[j] = gelu_tanh(v0[j]); v1[j] = gelu_tanh(v1[j]); }
                            s += sum4sq(v0) + sum4sq(v1);
                            store8_bf16(dst + (size_t)r * D + 128 * bj, v0, v1); }
                        if (type == 2) { s += __shfl_xor(s, 16); s += __shfl_xor(s, 32); if (fq == 0) vssq[(size_t)r * 16 + tl * 4 + wc] = s; } }
            } else {
#pragma unroll
                for (int ai = 0; ai < 2; ++ai)
#pragma unroll
                    for (int m = 0; m < 4; ++m) { const int r = EPI_ROW(ai, m); const float rs = rstd0[r];
#pragma unroll
                        for (int bj = 0; bj < 2; ++bj) { f32x4 v0 = acc[ai][bj][m][0] * rs, v1 = acc[ai][bj][m][1] * rs;
#pragma unroll
                            for (int j = 0; j < 4; ++j) { v0[j] = sigmoid_f(v0[j]); v1[j] = sigmoid_f(v1[j]); }
                            store8_bf16(dst + (size_t)r * D + 128 * bj, v0, v1); } }
            }
        }
    }
};
struct EpiYa {
    static constexpr bool AFTER_DRAIN = false;
    const bf16_t* sga; float* t1;
    __device__ __forceinline__ void operator()(AccRef acc, const Unit& u, int wr, int wc, int fr, int fq) const {
        const int hc = u.pn * 256 + wc * 32 + 8 * fq;
#pragma unroll
        for (int ai = 0; ai < 2; ++ai)
#pragma unroll
            for (int m = 0; m < 4; ++m) { const int r = EPI_ROW(ai, m);
#pragma unroll
                for (int bj = 0; bj < 2; ++bj) { const size_t o = (size_t)r * D + hc + 128 * bj; f32x4 g0, g1; load8_bf16(sga + o, g0, g1);
                    *(f32x4*)(t1 + o) = g0 * acc[ai][bj][m][0]; *(f32x4*)(t1 + o + 4) = g1 * acc[ai][bj][m][1]; } }
    }
};
struct EpiYb {
    static constexpr bool AFTER_DRAIN = false;
    const bf16_t* sgb; const float* t1; bf16_t* mm;
    __device__ __forceinline__ void operator()(AccRef acc, const Unit& u, int wr, int wc, int fr, int fq) const {
        const int hc = u.pn * 256 + wc * 32 + 8 * fq;
#pragma unroll
        for (int ai = 0; ai < 2; ++ai)
#pragma unroll
            for (int m = 0; m < 4; ++m) { const int r = EPI_ROW(ai, m);
#pragma unroll
                for (int bj = 0; bj < 2; ++bj) { const size_t o = (size_t)r * D + hc + 128 * bj; f32x4 g0, g1; load8_bf16(sgb + o, g0, g1);
                    const f32x4 a0 = *(const f32x4*)(t1 + o), a1 = *(const f32x4*)(t1 + o + 4);
                    store8_bf16(mm + o, a0 + g0 * acc[ai][bj][m][0], a1 + g1 * acc[ai][bj][m][1]); } }
    }
};
template <int SRC> struct EpiRes {
    static constexpr bool AFTER_DRAIN = false;
    const float* xp; const float* xs; float* h; bf16_t* hb; float* ssq;
    __device__ __forceinline__ void operator()(AccRef acc, const Unit& u, int wr, int wc, int fr, int fq) const {
        const int hc = u.pn * 256 + wc * 32 + 8 * fq;
#pragma unroll
        for (int ai = 0; ai < 2; ++ai)
#pragma unroll
            for (int m = 0; m < 4; ++m) { const int r = EPI_ROW(ai, m); float s = 0.f; const bool valid = r < MV;
                const float* base = SRC == 1 ? h + (size_t)r * D : (r < MP ? xp + (size_t)r * D : xs + (size_t)(r - MP) * D);
#pragma unroll
                for (int bj = 0; bj < 2; ++bj) { const int c = hc + 128 * bj;
                    f32x4 b0 = (f32x4){0.f, 0.f, 0.f, 0.f}, b1 = b0; if (valid) { b0 = *(const f32x4*)(base + c); b1 = *(const f32x4*)(base + c + 4); }
                    const f32x4 v0 = b0 + acc[ai][bj][m][0], v1 = b1 + acc[ai][bj][m][1];
                    if (valid) { *(f32x4*)(h + (size_t)r * D + c) = v0; *(f32x4*)(h + (size_t)r * D + c + 4) = v1; }
                    store8_bf16(hb + (size_t)r * D + c, v0, v1);
                    s += sum4sq(v0) + sum4sq(v1); }
                s += __shfl_xor(s, 16); s += __shfl_xor(s, 32); if (fq == 0) ssq[(size_t)r * 16 + u.pn * 4 + wc] = s; }
    }
};
struct EpiUp {
    static constexpr bool AFTER_DRAIN = false;
    const float* rstd1; bf16_t* uph; float* out; int half; int pad;
    __device__ __forceinline__ void operator()(AccRef acc, const Unit& u, int wr, int wc, int fr, int fq) const {
        const int hc = wc * 32 + 8 * fq;
#pragma unroll
        for (int ai = 0; ai < 2; ++ai)
#pragma unroll
            for (int m = 0; m < 4; ++m) { const int r = EPI_ROW(ai, m); const float rs = rstd1[r];
#pragma unroll
                for (int bj = 0; bj < 2; ++bj) { const f32x4 v0 = acc[ai][bj][m][0] * rs, v1 = acc[ai][bj][m][1] * rs;
                    store8_bf16(uph + (size_t)r * DFF + 256 * u.pn + 128 * bj + hc, v0, v1);
                    const int col = (bj ? DFF : 0) + 1408 * half + 128 * u.pn + hc;
                    if (r < MP) { const int t = r & (SEQ - 1); if (t >= SEQ - 2) { float* o = out + O_CFP + ((size_t)((r >> 11) * 2 + (t - (SEQ - 2)))) * NUP + col; *(f32x4*)o = v0; *(f32x4*)(o + 4) = v1; } }
                    else if (r < MV) { float* o = out + O_CFS + ((size_t)((r - MP) * 2 + 1)) * NUP + col; *(f32x4*)o = v0; *(f32x4*)(o + 4) = v1; } } }
    }
};
struct EpiPe {
    static constexpr bool AFTER_DRAIN = false;
    float* pe;
    __device__ __forceinline__ void operator()(AccRef acc, const Unit& u, int wr, int wc, int fr, int fq) const {
        const int hc = u.pn * 256 + wc * 32 + 8 * fq;
#pragma unroll
        for (int ai = 0; ai < 2; ++ai)
#pragma unroll
            for (int m = 0; m < 4; ++m) { const int r = EPI_ROW(ai, m);
#pragma unroll
                for (int bj = 0; bj < 2; ++bj) { const size_t o = (size_t)r * D + hc + 128 * bj; *(f32x4*)(pe + o) = acc[ai][bj][m][0]; *(f32x4*)(pe + o + 4) = acc[ai][bj][m][1]; } }
    }
};
struct EpiGate {
    static constexpr bool AFTER_DRAIN = false;
    const float* rstd2; const float* pe; float* h;
    __device__ __forceinline__ void operator()(AccRef acc, const Unit& u, int wr, int wc, int fr, int fq) const {
        const int hc = u.pn * 256 + wc * 32 + 8 * fq;
#pragma unroll
        for (int ai = 0; ai < 2; ++ai)
#pragma unroll
            for (int m = 0; m < 4; ++m) { const int r = EPI_ROW(ai, m); if (r >= MV) continue; const float rs = rstd2[r];
#pragma unroll
                for (int bj = 0; bj < 2; ++bj) { const size_t o = (size_t)r * D + hc + 128 * bj;
                    f32x4 g0 = acc[ai][bj][m][0] * rs, g1 = acc[ai][bj][m][1] * rs;
#pragma unroll
                    for (int j = 0; j < 4; ++j) { g0[j] = sigmoid_f(g0[j]); g1[j] = sigmoid_f(g1[j]); }
                    const f32x4 p0 = *(const f32x4*)(pe + o), p1 = *(const f32x4*)(pe + o + 4);
                    const f32x4 h0 = *(const f32x4*)(h + o), h1 = *(const f32x4*)(h + o + 4);
                    *(f32x4*)(h + o) = h0 + g0 * p0; *(f32x4*)(h + o + 4) = h1 + g1 * p1; } }
    }
};

template <class Epi> __global__ __launch_bounds__(512, 2) void k_gemm(pg8::Gemm g, Epi E) {
    extern __shared__ __attribute__((aligned(16))) unsigned char shm[];
    pg8::StaticOrder S; S.init(g.M, g.N, (int)gridDim.x, (int)blockIdx.x);
    pg8::gemm_phase<Epi, pg8::StaticOrder, true, true>((PG8_LAS unsigned char*)shm, g, S, E);
}

__device__ __forceinline__ float wave_sum(float v) {
#pragma unroll
    for (int o = 1; o < 64; o <<= 1) v += __shfl_xor(v, o);
    return v;
}
__global__ __launch_bounds__(256) void k_prep_x(const float* xp, const float* xs, bf16_t* xb, float* rstd0) {
    const int r = blockIdx.x * 4 + (threadIdx.x >> 6), lane = threadIdx.x & 63;
    if (r >= MALL) return;
    f32x4 v[4];
    if (r < MV) { const f32x4* src = (const f32x4*)(r < MP ? xp + (size_t)r * D : xs + (size_t)(r - MP) * D) + lane;
#pragma unroll
        for (int j = 0; j < 4; ++j) v[j] = src[64 * j]; }
    else {
#pragma unroll
        for (int j = 0; j < 4; ++j) v[j] = (f32x4){0.f, 0.f, 0.f, 0.f}; }
    float s = 0.f;
#pragma unroll
    for (int j = 0; j < 4; ++j) s += sum4sq(v[j]);
    s = wave_sum(s);
    if (lane == 0) rstd0[r] = 1.0f / sqrtf(s * (1.0f / D) + EPS);
    unsigned long long* o8 = (unsigned long long*)(xb + (size_t)r * D) + lane;
#pragma unroll
    for (int j = 0; j < 4; ++j) o8[64 * j] = (unsigned long long)cvt_pk_bf16(v[j][0], v[j][1]) | ((unsigned long long)cvt_pk_bf16(v[j][2], v[j][3]) << 32);
}
__global__ __launch_bounds__(256) void k_prep_p(const float* pp, const float* ps, bf16_t* pb) {
    const size_t i = ((size_t)blockIdx.x * 256 + threadIdx.x) * 4;
    if (i >= (size_t)MALL * PD) return;
    const size_t r = i / PD;
    f32x4 v = (f32x4){0.f, 0.f, 0.f, 0.f};
    if (r < (size_t)MP) v = *(const f32x4*)(pp + i); else if (r < (size_t)MV) v = *(const f32x4*)(ps + (i - (size_t)MP * PD));
    *(unsigned long long*)(pb + i) = (unsigned long long)cvt_pk_bf16(v[0], v[1]) | ((unsigned long long)cvt_pk_bf16(v[2], v[3]) << 32);
}
__device__ __forceinline__ int colmap(int mode, int R) {
    const int hc = (R & 96) + pg8::perm32(R & 31);
    const int bj = (R >> 7) & 1, tile = R >> 8;
    if (mode == 0) return (R & ~127) + hc;
    if (mode == 1) { if (tile < 8) return (bj ? 2048 : 0) + 128 * tile + hc;
        const int type = (tile - 8) >> 2, tl = (tile - 8) & 3; const int base = type == 0 ? 1024 : type == 1 ? 3072 : type == 2 ? 4096 : type == 3 ? 5120 : 6144;
        return base + 256 * tl + 128 * bj + hc; }
    return (bj ? DFF : 0) + 128 * tile + hc;
}
__global__ __launch_bounds__(256) void k_wt(const float* W, const float* scale, bf16_t* out, int K, int Nw, int mode) {
    __shared__ float t[64][65];
    const int R0 = blockIdx.x * 64, k0 = blockIdx.y * 64, tx = threadIdx.x & 63, ty = threadIdx.x >> 6;
    const int col = colmap(mode, R0 + tx);
#pragma unroll
    for (int i = 0; i < 16; ++i) { const int k = k0 + ty + 4 * i; t[ty + 4 * i][tx] = W[(size_t)k * Nw + col] * (scale ? scale[k] : 1.0f); }
    __syncthreads();
    const int Rl = threadIdx.x >> 2, kq = threadIdx.x & 3;
    u32x4 w0, w1;
    w0.x = cvt_pk_bf16(t[kq * 16 + 0][Rl], t[kq * 16 + 1][Rl]); w0.y = cvt_pk_bf16(t[kq * 16 + 2][Rl], t[kq * 16 + 3][Rl]);
    w0.z = cvt_pk_bf16(t[kq * 16 + 4][Rl], t[kq * 16 + 5][Rl]); w0.w = cvt_pk_bf16(t[kq * 16 + 6][Rl], t[kq * 16 + 7][Rl]);
    w1.x = cvt_pk_bf16(t[kq * 16 + 8][Rl], t[kq * 16 + 9][Rl]); w1.y = cvt_pk_bf16(t[kq * 16 + 10][Rl], t[kq * 16 + 11][Rl]);
    w1.z = cvt_pk_bf16(t[kq * 16 + 12][Rl], t[kq * 16 + 13][Rl]); w1.w = cvt_pk_bf16(t[kq * 16 + 14][Rl], t[kq * 16 + 15][Rl]);
    bf16_t* o = out + (size_t)(R0 + Rl) * K + k0 + kq * 16;
    *(u32x4*)o = w0; *(u32x4*)(o + 8) = w1;
}
__global__ __launch_bounds__(256) void k_rstd(const float* ssq, float* rstd) {
    const int r = blockIdx.x * 256 + threadIdx.x; if (r >= MALL) return;
    const f32x4* p = (const f32x4*)(ssq + (size_t)r * 16); const f32x4 a = p[0], b = p[1], c = p[2], d = p[3];
    const float s = ((a[0] + a[1]) + (a[2] + a[3])) + ((b[0] + b[1]) + (b[2] + b[3])) + ((c[0] + c[1]) + (c[2] + c[3])) + ((d[0] + d[1]) + (d[2] + d[3]));
    rstd[r] = 1.0f / sqrtf(s * (1.0f / D) + EPS);
}
__global__ __launch_bounds__(256) void k_copy_state(const float* sa, const float* sf, float* out) {
    const int i = blockIdx.x;
    for (int c = threadIdx.x; c < D; c += 256) out[O_CAS + (size_t)(i * 2) * D + c] = sa[(size_t)(i * 2 + 1) * D + c];
    for (int c = threadIdx.x; c < NUP; c += 256) out[O_CFS + (size_t)(i * 2) * NUP + c] = sf[(size_t)(i * 2 + 1) * NUP + c];
}
__global__ __launch_bounds__(256) void k_convA(const bf16_t* ca, bf16_t* ba, const float* wc, const float* sa) {
    const size_t idx = (size_t)blockIdx.x * 256 + threadIdx.x;
    const int r = (int)(idx >> 7), j = (int)(idx & 127) * 8;
    if (r >= MV) return;
    f32x4 c0a, c0b, c1a, c1b, c2a, c2b;
    load8_bf16(ca + (size_t)r * D + j, c0a, c0b);
    const f32x4 z = (f32x4){0.f, 0.f, 0.f, 0.f};
    if (r < MP) { const int t = r & (SEQ - 1);
        if (t >= 1) load8_bf16(ca + (size_t)(r - 1) * D + j, c1a, c1b); else { c1a = z; c1b = z; }
        if (t >= 2) load8_bf16(ca + (size_t)(r - 2) * D + j, c2a, c2b); else { c2a = z; c2b = z; } }
    else { const int i = r - MP; const float* s0 = sa + (size_t)(i * 2) * D + j; const float* s1 = s0 + D;
        c2a = *(const f32x4*)s0; c2b = *(const f32x4*)(s0 + 4); c1a = *(const f32x4*)s1; c1b = *(const f32x4*)(s1 + 4); }
    const f32x4 w0a = *(const f32x4*)(wc + j), w0b = *(const f32x4*)(wc + j + 4), w1a = *(const f32x4*)(wc + D + j), w1b = *(const f32x4*)(wc + D + j + 4),
                w2a = *(const f32x4*)(wc + 2 * D + j), w2b = *(const f32x4*)(wc + 2 * D + j + 4);
    f32x4 b0, b1; load8_bf16(ba + (size_t)r * D + j, b0, b1);
    const f32x4 o0 = b0 * (w0a * c2a + w1a * c1a + w2a * c0a), o1 = b1 * (w0b * c2b + w1b * c1b + w2b * c0b);
    store8_bf16(ba + (size_t)r * D + j, o0, o1);
}
__global__ __launch_bounds__(256) void k_spatial(const bf16_t* vp, bf16_t* uu, const float* vssq, const float* gv, const float* ws, const float* bs, float* out) {
    __shared__ float vn[128][64];
    __shared__ float rs[128];
    const int c = blockIdx.x >> 4, g = (blockIdx.x >> 1) & 7, dh = blockIdx.x & 1, r0 = c * 128, d0 = g * 128 + dh * 64, tid = threadIdx.x;
    if (tid < 128) { const f32x4* p = (const f32x4*)(vssq + (size_t)(r0 + tid) * 16); float s = 0.f;
#pragma unroll
        for (int q = 0; q < 4; ++q) { const f32x4 a = p[q]; s += (a[0] + a[1]) + (a[2] + a[3]); }
        rs[tid] = 1.0f / sqrtf(s * (1.0f / D) + EPS); }
    __syncthreads();
    const int d = tid & 63, th = tid >> 6;
    const float gvd = gv[d0 + d];
    for (int s = th; s < 128; s += 4) vn[s][d] = bf2f(vp[(size_t)(r0 + s) * D + d0 + d]) * rs[s] * gvd;
    __syncthreads();
    const bool last = (c & 15) == 15; const int b = c >> 4;
    if (last) for (int s = th; s < 128; s += 4) out[O_CVP + ((size_t)(b * 128 + s)) * D + d0 + d] = vn[s][d];
    const float* W = ws + (size_t)g * 128 * 128;
    for (int t = th; t < 128; t += 4) {
        const float* wrow = W + t * 128; float a = 0.f;
        for (int s = 0; s <= t; ++s) a += wrow[s] * vn[s][d];
        a += bs[g * 128 + t];
        const size_t o = (size_t)(r0 + t) * D + d0 + d;
        uu[o] = (bf16_t)(cvt_pk_bf16(bf2f(uu[o]) * a, 0.f) & 0xffffu);
    }
}
__global__ __launch_bounds__(256) void k_spatial_s(const bf16_t* vp, bf16_t* uu, const float* vssq, const float* gv, const float* ws, const float* bs, float* out) {
    const int i = blockIdx.x, r = MP + i;
    const f32x4* p = (const f32x4*)(vssq + (size_t)r * 16); float s = 0.f;
#pragma unroll
    for (int q = 0; q < 4; ++q) { const f32x4 a = p[q]; s += (a[0] + a[1]) + (a[2] + a[3]); }
    const float rsv = 1.0f / sqrtf(s * (1.0f / D) + EPS);
    for (int d = threadIdx.x; d < D; d += 256) { const int g = d >> 7;
        const float vnv = bf2f(vp[(size_t)r * D + d]) * rsv * gv[d];
        out[O_CVS + (size_t)i * D + d] = vnv;
        const float sv = ws[(size_t)g * 128 * 128] * vnv + bs[g * 128];
        const size_t o = (size_t)r * D + d;
        uu[o] = (bf16_t)(cvt_pk_bf16(bf2f(uu[o]) * sv, 0.f) & 0xffffu); }
}
__global__ __launch_bounds__(256) void k_convF(const bf16_t* uph, bf16_t* a3, const float* wcf, const float* sf, int half) {
    const size_t idx = (size_t)blockIdx.x * 256 + threadIdx.x;
    const int c8 = (int)(idx & 15), t = (int)((idx >> 4) % 11), r = (int)(idx / (16 * 11));
    if (r >= MV) return;
    const int c = c8 * 8, ja = 1408 * half + 128 * t + c, jb = DFF + ja;
    const bf16_t* pa = uph + (size_t)r * DFF + 256 * t + c; const bf16_t* pb = pa + 128;
    f32x4 a0[2], a1[2], a2[2], b0[2], b1[2], b2[2];
    load8_bf16(pa, a0[0], a0[1]); load8_bf16(pb, b0[0], b0[1]);
    const f32x4 z = (f32x4){0.f, 0.f, 0.f, 0.f};
    if (r < MP) { const int tt = r & (SEQ - 1);
        if (tt >= 1) { load8_bf16(pa - DFF, a1[0], a1[1]); load8_bf16(pb - DFF, b1[0], b1[1]); } else { a1[0] = a1[1] = b1[0] = b1[1] = z; }
        if (tt >= 2) { load8_bf16(pa - 2 * DFF, a2[0], a2[1]); load8_bf16(pb - 2 * DFF, b2[0], b2[1]); } else { a2[0] = a2[1] = b2[0] = b2[1] = z; } }
    else { const int i = r - MP; const float* s0 = sf + (size_t)(i * 2) * NUP; const float* s1 = s0 + NUP;
        a2[0] = *(const f32x4*)(s0 + ja); a2[1] = *(const f32x4*)(s0 + ja + 4); b2[0] = *(const f32x4*)(s0 + jb); b2[1] = *(const f32x4*)(s0 + jb + 4);
        a1[0] = *(const f32x4*)(s1 + ja); a1[1] = *(const f32x4*)(s1 + ja + 4); b1[0] = *(const f32x4*)(s1 + jb); b1[1] = *(const f32x4*)(s1 + jb + 4); }
    f32x4 o[2];
#pragma unroll
    for (int q = 0; q < 2; ++q) {
        const f32x4 wa0 = *(const f32x4*)(wcf + ja + 4 * q), wa1 = *(const f32x4*)(wcf + NUP + ja + 4 * q), wa2 = *(const f32x4*)(wcf + 2 * NUP + ja + 4 * q);
        const f32x4 wb0 = *(const f32x4*)(wcf + jb + 4 * q), wb1 = *(const f32x4*)(wcf + NUP + jb + 4 * q), wb2 = *(const f32x4*)(wcf + 2 * NUP + jb + 4 * q);
        f32x4 ca = wa0 * a2[q] + wa1 * a1[q] + wa2 * a0[q]; const f32x4 cb = wb0 * b2[q] + wb1 * b1[q] + wb2 * b0[q];
#pragma unroll
        for (int j = 0; j < 4; ++j) ca[j] = gelu_tanh(ca[j]);
        o[q] = ca * cb; }
    store8_bf16(a3 + (size_t)r * DFF + ja, o[0], o[1]);
}
__global__ __launch_bounds__(256) void k_final(float* h, const float* gf) {
    const int r = blockIdx.x * 4 + (threadIdx.x >> 6), lane = threadIdx.x & 63;
    if (r >= MV) return;
    f32x4* p = (f32x4*)(h + (size_t)r * D) + lane; f32x4 v[4]; float s = 0.f;
#pragma unroll
    for (int j = 0; j < 4; ++j) { v[j] = p[64 * j]; s += sum4sq(v[j]); }
    s = wave_sum(s); const float rs = 1.0f / sqrtf(s * (1.0f / D) + EPS);
#pragma unroll
    for (int j = 0; j < 4; ++j) { const f32x4 g = *((const f32x4*)gf + lane + 64 * j); p[64 * j] = v[j] * rs * g; }
}

template <class Epi> static void launch_gemm(hipStream_t st, const bf16_t* A, int lda, const bf16_t* Bt, int ldb, int M, int N, int K, const Epi& E) {
    static bool attr = false;
    if (!attr) { (void)hipFuncSetAttribute((const void*)k_gemm<Epi>, hipFuncAttributeMaxDynamicSharedMemorySize, LDS_BYTES); attr = true; }
    pg8::Gemm g{}; g.A = A; g.Bt = Bt; g.M = M; g.N = N; g.K = K; g.lda = lda; g.ldb = ldb; g.pad = 0;
    hipLaunchKernelGGL((k_gemm<Epi>), dim3(256), dim3(512), LDS_BYTES, st, g, E);
}

extern "C" void kernel_launch(void* const* d_in, const int* in_sizes, int n_in, void* d_out, int out_size, void* d_ws, size_t ws_size, hipStream_t stream) {
    (void)in_sizes; (void)n_in; (void)out_size; (void)ws_size;
    const float* x_p = (const float*)d_in[0]; const float* x_s = (const float*)d_in[1]; const float* p_p = (const float*)d_in[2]; const float* p_s = (const float*)d_in[3];
    const float* st_a = (const float*)d_in[4]; const float* st_f = (const float*)d_in[5]; const float* g_mix = (const float*)d_in[6]; const float* w_in = (const float*)d_in[7];
    const float* w_conv_a = (const float*)d_in[8]; const float* w_out_a = (const float*)d_in[9]; const float* g_v = (const float*)d_in[10]; const float* w_sp = (const float*)d_in[11];
    const float* b_sp = (const float*)d_in[12]; const float* w_out_b = (const float*)d_in[13]; const float* w_o = (const float*)d_in[14]; const float* g_ffn = (const float*)d_in[15];
    const float* w_up = (const float*)d_in[16]; const float* w_conv_f = (const float*)d_in[17]; const float* w_down = (const float*)d_in[18]; const float* g_ple = (const float*)d_in[19];
    const float* w_pg = (const float*)d_in[20]; const float* w_ple = (const float*)d_in[21]; const float* g_final = (const float*)d_in[22];
    float* out = (float*)d_out; unsigned char* ws = (unsigned char*)d_ws;
    constexpr size_t MiB = 1u << 20;
    bf16_t* Wt_up = (bf16_t*)(ws + 0 * MiB); bf16_t* Wt_down = (bf16_t*)(ws + 11 * MiB); bf16_t* Wt_pg = (bf16_t*)(ws + 16 * MiB + MiB / 2); bf16_t* Wt_ple = (bf16_t*)(ws + 18 * MiB + MiB / 2);
    float* rstd0 = (float*)(ws + 19 * MiB); float* rstd1 = rstd0 + 32768; float* rstd2 = rstd1 + 32768;
    float* vssq = (float*)(ws + 20 * MiB); float* ssq1 = (float*)(ws + 21 * MiB + MiB / 4); float* ssq2 = (float*)(ws + 22 * MiB + MiB / 2);
    bf16_t* pb = (bf16_t*)(ws + 24 * MiB);
    bf16_t* Wt_in = (bf16_t*)(ws + 33 * MiB); bf16_t* Wt_oa = (bf16_t*)(ws + 47 * MiB); bf16_t* Wt_ob = (bf16_t*)(ws + 49 * MiB); bf16_t* Wt_o = (bf16_t*)(ws + 51 * MiB);
    bf16_t* xb = (bf16_t*)(ws + 53 * MiB); bf16_t* mm = xb;
    bf16_t* ca = (bf16_t*)(ws + 86 * MiB); bf16_t* vp = (bf16_t*)(ws + 86 * MiB + 65 * MiB / 2); float* t1 = (float*)ca;
    bf16_t* ba = (bf16_t*)(ws + 151 * MiB); bf16_t* uu = (bf16_t*)(ws + 184 * MiB); bf16_t* sga = (bf16_t*)(ws + 217 * MiB);
    bf16_t* sgb = (bf16_t*)d_out;
    float* h = out;
    bf16_t* h1b = (bf16_t*)(ws + 222 * MiB);
    bf16_t* uph = (bf16_t*)(ws + 33 * MiB);
    bf16_t* a3 = (bf16_t*)(ws + 123 * MiB);
    bf16_t* h2b = (bf16_t*)(ws + 33 * MiB);
    float* pe = (float*)(ws + 123 * MiB);

    hipLaunchKernelGGL(k_prep_x, dim3(MALL / 4), dim3(256), 0, stream, x_p, x_s, xb, rstd0);
    hipLaunchKernelGGL(k_prep_p, dim3((MALL * PD / 4 + 255) / 256), dim3(256), 0, stream, p_p, p_s, pb);
    hipLaunchKernelGGL(k_copy_state, dim3(MS), dim3(256), 0, stream, st_a, st_f, out);
    hipLaunchKernelGGL(k_wt, dim3(NIN / 64, D / 64), dim3(256), 0, stream, w_in, g_mix, Wt_in, D, NIN, 1);
    hipLaunchKernelGGL(k_wt, dim3(D / 64, D / 64), dim3(256), 0, stream, w_out_a, (const float*)nullptr, Wt_oa, D, D, 0);
    hipLaunchKernelGGL(k_wt, dim3(D / 64, D / 64), dim3(256), 0, stream, w_out_b, (const float*)nullptr, Wt_ob, D, D, 0);
    hipLaunchKernelGGL(k_wt, dim3(D / 64, D / 64), dim3(256), 0, stream, w_o, (const float*)nullptr, Wt_o, D, D, 0);
    hipLaunchKernelGGL(k_wt, dim3(NUP / 64, D / 64), dim3(256), 0, stream, w_up, g_ffn, Wt_up, D, NUP, 2);
    hipLaunchKernelGGL(k_wt, dim3(D / 64, DFF / 64), dim3(256), 0, stream, w_down, (const float*)nullptr, Wt_down, DFF, D, 0);
    hipLaunchKernelGGL(k_wt, dim3(D / 64, D / 64), dim3(256), 0, stream, w_pg, g_ple, Wt_pg, D, D, 0);
    hipLaunchKernelGGL(k_wt, dim3(D / 64, PD / 64), dim3(256), 0, stream, w_ple, (const float*)nullptr, Wt_ple, PD, D, 0);
    { EpiIn E{}; E.rstd0 = rstd0; E.ca = ca; E.ba = ba; E.uu = uu; E.vp = vp; E.sga = sga; E.sgb = sgb; E.vssq = vssq; E.out = out;
      launch_gemm(stream, xb, D, Wt_in, D, MALL, NIN, D, E); }
    hipLaunchKernelGGL(k_convA, dim3(MV * 128 / 256), dim3(256), 0, stream, (const bf16_t*)ca, ba, w_conv_a, st_a);
    hipLaunchKernelGGL(k_spatial, dim3((MP / 128) * 16), dim3(256), 0, stream, (const bf16_t*)vp, uu, (const float*)vssq, g_v, w_sp, b_sp, out);
    hipLaunchKernelGGL(k_spatial_s, dim3(MS), dim3(256), 0, stream, (const bf16_t*)vp, uu, (const float*)vssq, g_v, w_sp, b_sp, out);
    { EpiYa E{}; E.sga = sga; E.t1 = t1; launch_gemm(stream, ba, D, Wt_oa, D, MALL, D, D, E); }
    { EpiYb E{}; E.sgb = sgb; E.t1 = t1; E.mm = mm; launch_gemm(stream, uu, D, Wt_ob, D, MALL, D, D, E); }
    { EpiRes<0> E{}; E.xp = x_p; E.xs = x_s; E.h = h; E.hb = h1b; E.ssq = ssq1; launch_gemm(stream, mm, D, Wt_o, D, MALL, D, D, E); }
    hipLaunchKernelGGL(k_rstd, dim3(MALL / 256), dim3(256), 0, stream, (const float*)ssq1, rstd1);
    for (int half = 0; half < 2; ++half) {
        EpiUp E{}; E.rstd1 = rstd1; E.uph = uph; E.out = out; E.half = half; E.pad = 0;
        launch_gemm(stream, h1b, D, Wt_up + (size_t)half * DFF * D, D, MALL, DFF, D, E);
        hipLaunchKernelGGL(k_convF, dim3((MV * 11 * 16 + 255) / 256), dim3(256), 0, stream, (const bf16_t*)uph, a3, w_conv_f, st_f, half);
    }
    { EpiRes<1> E{}; E.xp = nullptr; E.xs = nullptr; E.h = h; E.hb = h2b; E.ssq = ssq2; launch_gemm(stream, a3, DFF, Wt_down, DFF, MALL, D, DFF, E); }
    hipLaunchKernelGGL(k_rstd, dim3(MALL / 256), dim3(256), 0, stream, (const float*)ssq2, rstd2);
    { EpiPe E{}; E.pe = pe; launch_gemm(stream, pb, PD, Wt_ple, PD, MALL, D, PD, E); }
    { EpiGate E{}; E.rstd2 = rstd2; E.pe = pe; E.h = h; launch_gemm(stream, h2b, D, Wt_pg, D, MALL, D, D, E); }
    hipLaunchKernelGGL(k_final, dim3(MV / 4), dim3(256), 0, stream, h, g_final);
}
```

```cpp
#include <hip/hip_runtime.h>
#include <cstdio>
#include <cstdint>
namespace pg8 {
#define PG8_LAS __attribute__((address_space(3)))
typedef unsigned short bf16_t;
typedef short bf16x8 __attribute__((ext_vector_type(8)));
typedef float f32x4 __attribute__((ext_vector_type(4)));
typedef unsigned u32x4 __attribute__((ext_vector_type(4)));
constexpr int BM = 256, BK = 64, HALF = 128, HTB = HALF * BK * 2  , STAGE_BYTES = 8 * HTB, NXCD = 8, WGM = 8;

__host__ __device__ __forceinline__ int lds_byte(int r, int c) { const int st = (r >> 4) * 2 + (c >> 5), rr = r & 15, cc = c & 31, ob = rr * 64 + cc * 2; return st * 1024 + (ob ^ (((ob >> 9) & 1) << 5)); }
__host__ __device__ __forceinline__ void stage_rc(int b, int& R, int& C) { const int st = b / 1024, sb = b % 1024, swz = sb ^ (((sb >> 9) & 1) << 5); R = (st >> 1) * 16 + swz / 64; C = (st & 1) * 32 + (swz % 64) / 2; }
__host__ __device__ __forceinline__ int perm32(int rho) { const int n = rho >> 4, i = rho & 15; return 8 * (i >> 2) + 4 * n + (i & 3); }

struct Unit { int pm, pn; };
struct Gemm { const bf16_t* A; const bf16_t* Bt; int M, N, K, lda, ldb, pad; };

struct StaticOrder {
    int nM, nN, nwg, G, c;
    __host__ __device__ void init(int M, int N, int G_, int c_) { nM = M / BM; nN = N / BM; nwg = nM * nN; G = G_; c = c_; }
    __host__ __device__ bool next(int i, Unit& u) const {
        const long L = (long)i * G + c; if (L >= nwg) return false;
        int wgid = (int)L; { const int q = nwg / NXCD, r = nwg % NXCD, xcd = wgid % NXCD, off = wgid / NXCD; wgid = (xcd < r ? xcd * (q + 1) : r * (q + 1) + (xcd - r) * q) + off; }
        const int nig = WGM * nN, gid = wgid / nig, fm = gid * WGM, gsz = (nM - fm) < WGM ? (nM - fm) : WGM;
        u.pm = fm + ((wgid % nig) % gsz); u.pn = (wgid % nig) / gsz; return true;
    }
    __device__ __forceinline__ void a_ready(const Unit&) const {}
    __device__ __forceinline__ void done(const Unit&) const {}
};


typedef __bf16 bf16x2_nat __attribute__((ext_vector_type(2)));
typedef float f32x2_nat __attribute__((ext_vector_type(2)));
__device__ __forceinline__ unsigned cvt_pk_bf16(float lo, float hi) { const f32x2_nat v = {lo, hi}; return __builtin_bit_cast(unsigned, __builtin_convertvector(v, bf16x2_nat)); }
template <class Epi, class Sched, bool ALIGN_EPI = false, bool SP2 = false>
__device__ __forceinline__ void gemm_phase(PG8_LAS unsigned char* lds, const Gemm g, const Sched& S, const Epi& E) {
    int tid_ = threadIdx.x; asm volatile("" : "+v"(tid_));
    const int tid = tid_, wid = __builtin_amdgcn_readfirstlane(tid >> 6), lane = tid & 63, wr = wid >> 2, wc = wid & 3, fr = lane & 15, fq = lane >> 4;
    const int K = g.K, nt = K / BK;
    unsigned voffA[2], voffB[2];
#pragma unroll
    for (int i = 0; i < 2; ++i) { int R, C; stage_rc(tid * 16 + i * 8192, R, C); voffA[i] = (unsigned)(R * g.lda + C) * 2u; voffB[i] = (unsigned)(R * g.ldb + C) * 2u; }
    const size_t kstep = (size_t)(BK * 2);
    const size_t hstepA = (size_t)HALF * g.lda * 2, hstepB = (size_t)HALF * g.ldb * 2;
    const size_t tstepA = 2 * hstepA, tstepB = 2 * hstepB;
    const unsigned ldsw = (unsigned)wid * 1024u;
    const int aoff = lds_byte(wr * 64 + fr, fq * 8), boff = lds_byte(wc * 32 + fr, fq * 8);
#define PG8_SA(b, h) (((b) * 2 + (h)) * HTB)
#define PG8_SB(b, h) ((4 + (b) * 2 + (h)) * HTB)
#define PG8_STAGE(bufoff, gbase, voff) do { _Pragma("unroll") for (int _i = 0; _i < 2; ++_i) \
        __builtin_amdgcn_global_load_lds((const unsigned*)((const char*)(gbase) + (voff)[_i]), (PG8_LAS unsigned*)(lds + (bufoff) + ldsw + _i * 8192), 16, 0, 0); } while (0)
#define PG8_LDA(dst, b, h) do { _Pragma("unroll") for (int m = 0; m < 4; ++m) _Pragma("unroll") for (int k = 0; k < 2; ++k) dst[m][k] = *(const PG8_LAS bf16x8*)(lds + PG8_SA(b, h) + aoff + m * 2048 + k * 1024); } while (0)
#define PG8_LDB(dst, b, h) do { _Pragma("unroll") for (int n = 0; n < 2; ++n) _Pragma("unroll") for (int k = 0; k < 2; ++k) dst[n][k] = *(const PG8_LAS bf16x8*)(lds + PG8_SB(b, h) + boff + n * 2048 + k * 1024); } while (0)
#define PG8_MMA(ai, bj, At, Bt) do { __builtin_amdgcn_s_setprio(1); _Pragma("unroll") for (int m = 0; m < 4; ++m) _Pragma("unroll") for (int n = 0; n < 2; ++n) _Pragma("unroll") for (int k = 0; k < 2; ++k) \
        acc[ai][bj][m][n] = __builtin_amdgcn_mfma_f32_16x16x32_bf16(Bt[n][k], At[m][k], acc[ai][bj][m][n], 0, 0, 0); __builtin_amdgcn_s_setprio(0); } while (0)
#define PG8_WAIT_V(n) asm volatile("s_waitcnt vmcnt(" #n ")" ::: "memory")
#define PG8_WAIT_L(n) asm volatile("s_waitcnt lgkmcnt(" #n ")" ::: "memory")
#define PG8_BAR __builtin_amdgcn_s_barrier()
#define PG8_SCHED __builtin_amdgcn_sched_barrier(0)
    Unit cur, nxt; int ui = 0;
    if (!S.next(0, cur)) return;
    f32x4 acc[2][2][4][2];
#pragma unroll
    for (int a = 0; a < 2; ++a)
#pragma unroll
        for (int b = 0; b < 2; ++b)
#pragma unroll
            for (int m = 0; m < 4; ++m)
#pragma unroll
                for (int n = 0; n < 2; ++n) acc[a][b][m][n] = (f32x4){0.f, 0.f, 0.f, 0.f};
    bf16x8 At[4][2], B0[2][2], B1[2][2];
    const char* cA = (const char*)g.A + (size_t)cur.pm * tstepA; const char* cB = (const char*)g.Bt + (size_t)cur.pn * tstepB;
    S.a_ready(cur);
    if constexpr (SP2) {
        PG8_STAGE(PG8_SB(0, 0), cB, voffB); PG8_STAGE(PG8_SB(0, 1), cB + hstepB, voffB); PG8_STAGE(PG8_SA(0, 0), cA, voffA); PG8_STAGE(PG8_SA(0, 1), cA + hstepA, voffA);
        if (wr == 1) PG8_BAR;
        PG8_WAIT_V(2); PG8_BAR;
        PG8_STAGE(PG8_SB(1, 0), cB + kstep, voffB); PG8_STAGE(PG8_SA(1, 0), cA + kstep, voffA); PG8_STAGE(PG8_SB(1, 1), cB + hstepB + kstep, voffB);
        PG8_WAIT_V(6); PG8_BAR;
    } else {
        PG8_STAGE(PG8_SB(0, 0), cB, voffB); PG8_STAGE(PG8_SA(0, 0), cA, voffA); PG8_STAGE(PG8_SB(0, 1), cB + hstepB, voffB); PG8_STAGE(PG8_SA(0, 1), cA + hstepA, voffA);
        if (wr == 1) PG8_BAR;
        PG8_WAIT_V(4); PG8_BAR;
        PG8_STAGE(PG8_SB(1, 0), cB + kstep, voffB); PG8_STAGE(PG8_SA(1, 0), cA + kstep, voffA); PG8_STAGE(PG8_SB(1, 1), cB + hstepB + kstep, voffB);
        PG8_WAIT_V(6); PG8_BAR;
    }
    for (;;) {
        const bool has_next = S.next(ui + 1, nxt);
        const char* nA = has_next ? (const char*)g.A + (size_t)nxt.pm * tstepA : cA; const char* nB = has_next ? (const char*)g.Bt + (size_t)nxt.pn * tstepB : cB;
        for (int t = 0; t < nt; t += 2) {
            const bool last = (t == nt - 2);
            const char* a1 = cA + (size_t)(t + 1) * kstep;
            const char* a2 = last ? nA : cA + (size_t)(t + 2) * kstep; const char* b2 = last ? nB : cB + (size_t)(t + 2) * kstep;
            const char* a3 = a2 + kstep; const char* b3 = b2 + kstep;
            if (last && has_next) S.a_ready(nxt);
            if constexpr (SP2) {
            PG8_LDB(B0, 0, 0); PG8_LDB(B1, 0, 1); PG8_SCHED; PG8_LDA(At, 0, 0); PG8_STAGE(PG8_SA(1, 1), a1 + hstepA, voffA);
            PG8_WAIT_V(8); PG8_WAIT_L(0); PG8_BAR; PG8_MMA(0, 0, At, B0); PG8_MMA(0, 1, At, B1); PG8_BAR; PG8_SCHED;
            PG8_LDA(At, 0, 1); PG8_STAGE(PG8_SB(0, 0), b2, voffB); PG8_STAGE(PG8_SB(0, 1), b2 + hstepB, voffB); PG8_STAGE(PG8_SA(0, 0), a2, voffA);
            PG8_WAIT_V(8); PG8_WAIT_L(0); PG8_BAR; PG8_MMA(1, 0, At, B0); PG8_MMA(1, 1, At, B1); PG8_BAR; PG8_SCHED;
            PG8_LDB(B0, 1, 0); PG8_LDB(B1, 1, 1); PG8_SCHED; PG8_LDA(At, 1, 0); PG8_STAGE(PG8_SA(0, 1), a2 + hstepA, voffA);
            PG8_WAIT_V(8); PG8_WAIT_L(0); PG8_BAR; PG8_MMA(0, 0, At, B0); PG8_MMA(0, 1, At, B1); PG8_BAR; PG8_SCHED;
            PG8_LDA(At, 1, 1); PG8_STAGE(PG8_SB(1, 0), b3, voffB); PG8_STAGE(PG8_SB(1, 1), b3 + hstepB, voffB); PG8_STAGE(PG8_SA(1, 0), a3, voffA);
            PG8_WAIT_V(8); PG8_WAIT_L(0); PG8_BAR; PG8_MMA(1, 0, At, B0); PG8_MMA(1, 1, At, B1); PG8_BAR; PG8_SCHED;
            } else {
            PG8_LDB(B0, 0, 0); PG8_SCHED; PG8_LDA(At, 0, 0); PG8_STAGE(PG8_SA(1, 1), a1 + hstepA, voffA);
            PG8_WAIT_L(8); PG8_BAR; PG8_WAIT_L(0); PG8_MMA(0, 0, At, B0); PG8_BAR; PG8_SCHED;
            PG8_LDB(B1, 0, 1); PG8_STAGE(PG8_SB(0, 0), b2, voffB);
            PG8_BAR; PG8_WAIT_L(0); PG8_MMA(0, 1, At, B1); PG8_BAR;
            PG8_LDA(At, 0, 1); PG8_STAGE(PG8_SA(0, 0), a2, voffA);
            PG8_BAR; PG8_WAIT_L(0); PG8_MMA(1, 0, At, B0); PG8_BAR; PG8_SCHED;
            PG8_STAGE(PG8_SB(0, 1), b2 + hstepB, voffB);
            PG8_WAIT_V(6); PG8_BAR; PG8_MMA(1, 1, At, B1); PG8_BAR;
            PG8_LDB(B0, 1, 0); PG8_SCHED; PG8_LDA(At, 1, 0); PG8_STAGE(PG8_SA(0, 1), a2 + hstepA, voffA);
            PG8_WAIT_L(8); PG8_BAR; PG8_WAIT_L(0); PG8_MMA(0, 0, At, B0); PG8_BAR; PG8_SCHED;
            PG8_LDB(B1, 1, 1); PG8_STAGE(PG8_SB(1, 0), b3, voffB);
            PG8_BAR; PG8_WAIT_L(0); PG8_MMA(0, 1, At, B1); PG8_BAR;
            PG8_LDA(At, 1, 1); PG8_STAGE(PG8_SA(1, 0), a3, voffA);
            PG8_BAR; PG8_WAIT_L(0); PG8_MMA(1, 0, At, B0); PG8_BAR; PG8_SCHED;
            PG8_STAGE(PG8_SB(1, 1), b3 + hstepB, voffB);
            PG8_WAIT_V(6); PG8_BAR; PG8_MMA(1, 1, At, B1); PG8_BAR;
            }
        }
        if constexpr (ALIGN_EPI) { if (wr == 0) PG8_BAR; }
        if constexpr (!Epi::AFTER_DRAIN) { E(acc, cur, wr, wc, fr, fq); S.done(cur); }
        if (!has_next) break;
#pragma unroll
        for (int a = 0; a < 2; ++a)
#pragma unroll
            for (int b = 0; b < 2; ++b)
#pragma unroll
                for (int m = 0; m < 4; ++m)
#pragma unroll
                    for (int n = 0; n < 2; ++n) acc[a][b][m][n] = (f32x4){0.f, 0.f, 0.f, 0.f};
        cur = nxt; cA = nA; cB = nB; ++ui;
        if constexpr (ALIGN_EPI) { if (wr == 1) PG8_BAR; }
    }
    PG8_WAIT_V(0);
    if constexpr (!ALIGN_EPI) { if (wr == 0) PG8_BAR; }
    PG8_BAR;
    if constexpr (Epi::AFTER_DRAIN) { E.fused(acc, cur, wr, wc, fr, fq, lds, wid, lane); S.done(cur); }
#undef PG8_SA
#undef PG8_SB
#undef PG8_STAGE
#undef PG8_LDA
#undef PG8_LDB
#undef PG8_MMA
#undef PG8_WAIT_V
#undef PG8_WAIT_L
#undef PG8_BAR
#undef PG8_SCHED
}
}

using pg8::bf16_t; using pg8::f32x4; using pg8::u32x4; using pg8::Unit; using pg8::cvt_pk_bf16;
constexpr int D = 1024, NBATCH = 8, SEQ = 2048, MP = NBATCH * SEQ, MS = 128, MV = MP + MS  , MALL = MP + 256  ;
constexpr int NIN = 7168, DFF = 2816, NUP = 2 * DFF, PD = 256;
constexpr float EPS = 1e-6f;
constexpr int LDS_BYTES = 131072;

constexpr size_t O_Y = 0;
constexpr size_t O_CAP = (size_t)MV * D;
constexpr size_t O_CAS = O_CAP + (size_t)NBATCH * 2 * D;
constexpr size_t O_CVP = O_CAS + (size_t)MS * 2 * D;
constexpr size_t O_CVS = O_CVP + (size_t)NBATCH * 128 * D;
constexpr size_t O_CFP = O_CVS + (size_t)MS * D;
constexpr size_t O_CFS = O_CFP + (size_t)NBATCH * 2 * NUP;
constexpr size_t O_END = O_CFS + (size_t)MS * 2 * NUP;

__device__ __forceinline__ float gelu_tanh(float x) {
    const float t = x * x;
    const float u2 = x * (2.3022082f + 0.10294324f * t);
    const float e = __builtin_amdgcn_exp2f(-u2);
    return x * __builtin_amdgcn_rcpf(1.0f + e);
}
__device__ __forceinline__ float sigmoid_f(float x) { return __builtin_amdgcn_rcpf(1.0f + __builtin_amdgcn_exp2f(-1.4426950409f * x)); }
__device__ __forceinline__ float bf2f(unsigned short b) { return __uint_as_float(((unsigned)b) << 16); }
__device__ __forceinline__ void store8_bf16(bf16_t* p, f32x4 v0, f32x4 v1) {
    u32x4 w; w.x = cvt_pk_bf16(v0[0], v0[1]); w.y = cvt_pk_bf16(v0[2], v0[3]); w.z = cvt_pk_bf16(v1[0], v1[1]); w.w = cvt_pk_bf16(v1[2], v1[3]);
    *(u32x4*)p = w;
}
__device__ __forceinline__ void load8_bf16(const bf16_t* p, f32x4& v0, f32x4& v1) {
    const u32x4 w = *(const u32x4*)p;
    v0 = (f32x4){__uint_as_float(w.x << 16), __uint_as_float(w.x & 0xffff0000u), __uint_as_float(w.y << 16), __uint_as_float(w.y & 0xffff0000u)};
    v1 = (f32x4){__uint_as_float(w.z << 16), __uint_as_float(w.z & 0xffff0000u), __uint_as_float(w.w << 16), __uint_as_float(w.w & 0xffff0000u)};
}
__device__ __forceinline__ float sum4sq(f32x4 v) { return (v[0] * v[0] + v[1] * v[1]) + (v[2] * v[2] + v[3] * v[3]); }

__device__ __forceinline__ float row_rstd16(const float* ssq, int r, int fq) {
    const f32x4 a = *(const f32x4*)(ssq + (size_t)r * 16 + 4 * fq);
    float s = (a[0] + a[1]) + (a[2] + a[3]); s += __shfl_xor(s, 16); s += __shfl_xor(s, 32);
    return 1.0f / sqrtf(s * (1.0f / D) + EPS);
}
#define EPI_ROW(ai, m) (u.pm * 256 + (ai) * 128 + wr * 64 + (m) * 16 + fr)
typedef const f32x4 (&AccRef)[2][2][4][2];

struct EpiIn {
    static constexpr bool AFTER_DRAIN = false;
    const float* rstd0; bf16_t *ca, *ba, *uu, *vp, *sga, *sgb; float* vssq; float* out;
    __device__ __forceinline__ void operator()(AccRef acc, const Unit& u, int wr, int wc, int fr, int fq) const {
        const int tile = u.pn, hc = wc * 32 + 8 * fq;
        if (tile < 8) {
#pragma unroll
            for (int ai = 0; ai < 2; ++ai)
#pragma unroll
                for (int m = 0; m < 4; ++m) {
                    const int r = EPI_ROW(ai, m); const float rs = rstd0[r];
                    const f32x4 p0 = (acc[ai][0][m][0] * rs) * (acc[ai][1][m][0] * rs), p1 = (acc[ai][0][m][1] * rs) * (acc[ai][1][m][1] * rs);
                    store8_bf16(ca + (size_t)r * D + 128 * tile + hc, p0, p1);
                    if (r < MP) { const int t = r & (SEQ - 1); if (t >= SEQ - 2) { float* o = out + O_CAP + ((size_t)((r >> 11) * 2 + (t - (SEQ - 2)))) * D + 128 * tile + hc; *(f32x4*)o = p0; *(f32x4*)(o + 4) = p1; } }
                    else if (r < MV) { float* o = out + O_CAS + ((size_t)((r - MP) * 2 + 1)) * D + 128 * tile + hc; *(f32x4*)o = p0; *(f32x4*)(o + 4) = p1; }
                }
        } else {
            const int type = (tile - 8) >> 2, tl = (tile - 8) & 3;
            bf16_t* dst = type == 0 ? ba : type == 1 ? uu : type == 2 ? vp : type == 3 ? sga : sgb;
            dst += 256 * tl + hc;
            if (type == 0) {
#pragma unroll
                for (int ai = 0; ai < 2; ++ai)
#pragma unroll
                    for (int m = 0; m < 4; ++m) { const int r = EPI_ROW(ai, m); const float rs = rstd0[r];
#pragma unroll
                        for (int bj = 0; bj < 2; ++bj) store8_bf16(dst + (size_t)r * D + 128 * bj, acc[ai][bj][m][0] * rs, acc[ai][bj][m][1] * rs); }
            } else if (type <= 2) {
#pragma unroll
                for (int ai = 0; ai < 2; ++ai)
#pragma unroll
                    for (int m = 0; m < 4; ++m) { const int r = EPI_ROW(ai, m); const float rs = rstd0[r]; float s = 0.f;
#pragma unroll
                        for (int bj = 0; bj < 2; ++bj) { f32x4 v0 = acc[ai][bj][m][0] * rs, v1 = acc[ai][bj][m][1] * rs;
#pragma unroll
                            for (int j = 0; j < 4; ++j) { v0[j] = gelu_tanh(v0[j]); v1[j] = gelu_tanh(v1[j]); }
                            s += sum4sq(v0) + sum4sq(v1);
                            store8_bf16(dst + (size_t)r * D + 128 * bj, v0, v1); }
                        if (type == 2) { s += __shfl_xor(s, 16); s += __shfl_xor(s, 32); if (fq == 0) vssq[(size_t)r * 16 + tl * 4 + wc] = s; } }
            } else {
#pragma unroll
                for (int ai = 0; ai < 2; ++ai)
#pragma unroll
                    for (int m = 0; m < 4; ++m) { const int r = EPI_ROW(ai, m); const float rs = rstd0[r];
#pragma unroll
                        for (int bj = 0; bj < 2; ++bj) { f32x4 v0 = acc[ai][bj][m][0] * rs, v1 = acc[ai][bj][m][1] * rs;
#pragma unroll
                            for (int j = 0; j < 4; ++j) { v0[j] = sigmoid_f(v0[j]); v1[j] = sigmoid_f(v1[j]); }
                            store8_bf16(dst + (size_t)r * D + 128 * bj, v0, v1); } }
            }
        }
    }
};
struct EpiYa {
    static constexpr bool AFTER_DRAIN = false;
    const bf16_t* sga; float* t1;
    __device__ __forceinline__ void operator()(AccRef acc, const Unit& u, int wr, int wc, int fr, int fq) const {
        const int hc = u.pn * 256 + wc * 32 + 8 * fq;
#pragma unroll
        for (int ai = 0; ai < 2; ++ai)
#pragma unroll
            for (int m = 0; m < 4; ++m) { const int r = EPI_ROW(ai, m);
#pragma unroll
                for (int bj = 0; bj < 2; ++bj) { const size_t o = (size_t)r * D + hc + 128 * bj; f32x4 g0, g1; load8_bf16(sga + o, g0, g1);
                    *(f32x4*)(t1 + o) = g0 * acc[ai][bj][m][0]; *(f32x4*)(t1 + o + 4) = g1 * acc[ai][bj][m][1]; } }
    }
};
struct EpiYb {
    static constexpr bool AFTER_DRAIN = false;
    const bf16_t* sgb; const float* t1; bf16_t* mm;
    __device__ __forceinline__ void operator()(AccRef acc, const Unit& u, int wr, int wc, int fr, int fq) const {
        const int hc = u.pn * 256 + wc * 32 + 8 * fq;
#pragma unroll
        for (int ai = 0; ai < 2; ++ai)
#pragma unroll
            for (int m = 0; m < 4; ++m) { const int r = EPI_ROW(ai, m);
#pragma unroll
                for (int bj = 0; bj < 2; ++bj) { const size_t o = (size_t)r * D + hc + 128 * bj; f32x4 g0, g1; load8_bf16(sgb + o, g0, g1);
                    const f32x4 a0 = *(const f32x4*)(t1 + o), a1 = *(const f32x4*)(t1 + o + 4);
                    store8_bf16(mm + o, a0 + g0 * acc[ai][bj][m][0], a1 + g1 * acc[ai][bj][m][1]); } }
    }
};
template <int SRC> struct EpiRes {
    static constexpr bool AFTER_DRAIN = false;
    const float* xp; const float* xs; float* h; bf16_t* hb; float* ssq;
    __device__ __forceinline__ void operator()(AccRef acc, const Unit& u, int wr, int wc, int fr, int fq) const {
        const int hc = u.pn * 256 + wc * 32 + 8 * fq;
#pragma unroll
        for (int ai = 0; ai < 2; ++ai)
#pragma unroll
            for (int m = 0; m < 4; ++m) { const int r = EPI_ROW(ai, m); float s = 0.f; const bool valid = r < MV;
                const float* base = SRC == 1 ? h + (size_t)r * D : (r < MP ? xp + (size_t)r * D : xs + (size_t)(r - MP) * D);
#pragma unroll
                for (int bj = 0; bj < 2; ++bj) { const int c = hc + 128 * bj;
                    f32x4 b0 = (f32x4){0.f, 0.f, 0.f, 0.f}, b1 = b0; if (valid) { b0 = *(const f32x4*)(base + c); b1 = *(const f32x4*)(base + c + 4); }
                    const f32x4 v0 = b0 + acc[ai][bj][m][0], v1 = b1 + acc[ai][bj][m][1];
                    if (valid) { *(f32x4*)(h + (size_t)r * D + c) = v0; *(f32x4*)(h + (size_t)r * D + c + 4) = v1; }
                    store8_bf16(hb + (size_t)r * D + c, v0, v1);
                    s += sum4sq(v0) + sum4sq(v1); }
                s += __shfl_xor(s, 16); s += __shfl_xor(s, 32); if (fq == 0) ssq[(size_t)r * 16 + u.pn * 4 + wc] = s; }
    }
};
struct EpiUp {
    static constexpr bool AFTER_DRAIN = false;
    const float* ssq1; bf16_t* uph; float* out; int half; int pad;
    __device__ __forceinline__ void operator()(AccRef acc, const Unit& u, int wr, int wc, int fr, int fq) const {
        const int hc = wc * 32 + 8 * fq;
#pragma unroll
        for (int ai = 0; ai < 2; ++ai)
#pragma unroll
            for (int m = 0; m < 4; ++m) { const int r = EPI_ROW(ai, m); const float rs = row_rstd16(ssq1, r, fq);
#pragma unroll
                for (int bj = 0; bj < 2; ++bj) { const f32x4 v0 = acc[ai][bj][m][0] * rs, v1 = acc[ai][bj][m][1] * rs;
                    store8_bf16(uph + (size_t)r * DFF + 256 * u.pn + 128 * bj + hc, v0, v1);
                    const int col = (bj ? DFF : 0) + 1408 * half + 128 * u.pn + hc;
                    if (r < MP) { const int t = r & (SEQ - 1); if (t >= SEQ - 2) { float* o = out + O_CFP + ((size_t)((r >> 11) * 2 + (t - (SEQ - 2)))) * NUP + col; *(f32x4*)o = v0; *(f32x4*)(o + 4) = v1; } }
                    else if (r < MV) { float* o = out + O_CFS + ((size_t)((r - MP) * 2 + 1)) * NUP + col; *(f32x4*)o = v0; *(f32x4*)(o + 4) = v1; } } }
    }
};
struct EpiPe {
    static constexpr bool AFTER_DRAIN = false;
    float* pe;
    __device__ __forceinline__ void operator()(AccRef acc, const Unit& u, int wr, int wc, int fr, int fq) const {
        const int hc = u.pn * 256 + wc * 32 + 8 * fq;
#pragma unroll
        for (int ai = 0; ai < 2; ++ai)
#pragma unroll
            for (int m = 0; m < 4; ++m) { const int r = EPI_ROW(ai, m);
#pragma unroll
                for (int bj = 0; bj < 2; ++bj) { const size_t o = (size_t)r * D + hc + 128 * bj; *(f32x4*)(pe + o) = acc[ai][bj][m][0]; *(f32x4*)(pe + o + 4) = acc[ai][bj][m][1]; } }
    }
};
struct EpiGate {
    static constexpr bool AFTER_DRAIN = false;
    const float* ssq2; const float* pe; float* h;
    __device__ __forceinline__ void operator()(AccRef acc, const Unit& u, int wr, int wc, int fr, int fq) const {
        const int hc = u.pn * 256 + wc * 32 + 8 * fq;
#pragma unroll
        for (int ai = 0; ai < 2; ++ai)
#pragma unroll
            for (int m = 0; m < 4; ++m) { const int r = EPI_ROW(ai, m); const float rs = row_rstd16(ssq2, r, fq);
#pragma unroll
                for (int bj = 0; bj < 2; ++bj) { const size_t o = (size_t)r * D + hc + 128 * bj;
                    f32x4 g0 = acc[ai][bj][m][0] * rs, g1 = acc[ai][bj][m][1] * rs;
#pragma unroll
                    for (int j = 0; j < 4; ++j) { g0[j] = sigmoid_f(g0[j]); g1[j] = sigmoid_f(g1[j]); }
                    const f32x4 p0 = *(const f32x4*)(pe + o), p1 = *(const f32x4*)(pe + o + 4);
                    const f32x4 h0 = *(const f32x4*)(h + o), h1 = *(const f32x4*)(h + o + 4);
                    *(f32x4*)(h + o) = h0 + g0 * p0; *(f32x4*)(h + o + 4) = h1 + g1 * p1; } }
    }
};


#define LAS __attribute__((address_space(3)))
typedef pg8::bf16x8 bf16x8;
constexpr int LDS_STAGE = 131072, LDS_XTRA_OFF = LDS_STAGE, LDS_XTRA = 8192, LDS_CTL_OFF = LDS_STAGE + LDS_XTRA, LDS_TOTAL = 147456;
#define BLK_BAR() do { asm volatile("s_waitcnt lgkmcnt(0)" ::: "memory"); __builtin_amdgcn_s_barrier(); asm volatile("" ::: "memory"); } while (0)

#define XB_TMO      128
#define XB_XCNT(j)  (256  + 64 * (j))
#define XB_XSUB(j)  (1280 + 64 * (j))
#define XB_XGEN(j)  (2304 + 64 * (j))
#define XB_TOP      3328
#define XB_TOPGEN   3392
#define XCD_BAR_WORDS 3456
#define XB_SPIN_CAP (1u << 18)

__device__ __forceinline__ unsigned xb_ld(unsigned* p)              { return __hip_atomic_load(p, __ATOMIC_RELAXED, __HIP_MEMORY_SCOPE_AGENT); }
__device__ __forceinline__ unsigned xb_add(unsigned* p, unsigned v) { return __hip_atomic_fetch_add(p, v, __ATOMIC_RELAXED, __HIP_MEMORY_SCOPE_AGENT); }
__device__ __forceinline__ unsigned xb_xcc_id() { return (unsigned)__builtin_amdgcn_s_getreg((3 << 11) | 20) & 0xFu; }
#define XB_SPIN(cond, bar) do { unsigned _sp = 0; while (cond) { __builtin_amdgcn_s_sleep(1); \
    if ((++_sp & 255u) == 0u) { if (xb_ld(&(bar)[XB_TMO])) break; if (_sp > XB_SPIN_CAP) { atomicAdd(&(bar)[XB_TMO], 1u); break; } } } } while (0)

struct XcdBarrier {
    unsigned* bar; unsigned x;
    volatile LAS unsigned* st;
};

__device__ __forceinline__ XcdBarrier xcd_barrier_post(unsigned* bar, volatile LAS unsigned* st) {
    XcdBarrier b; b.bar = bar; b.x = xb_xcc_id(); b.st = st;
    if (threadIdx.x == 0) (void)xb_add(&bar[XB_XCNT(b.x)], 1u);
    return b;
}
__device__ __forceinline__ void xcd_barrier_complete(unsigned* bar, unsigned x, unsigned& nloc, unsigned& nx) {
    const unsigned G = gridDim.x * gridDim.y * gridDim.z;
    unsigned sum, cnt, mine, sp = 0u;
    for (;;) {
        sum = 0u; cnt = 0u; mine = 0u;
#pragma unroll
        for (unsigned j = 0; j < 16; ++j) { const unsigned c = xb_ld(&bar[XB_XCNT(j)]); sum += c; cnt += (c > 0u) ? 1u : 0u; mine = (j == x) ? c : mine; }
        if (sum == G) break;
        __builtin_amdgcn_s_sleep(1);
        if ((++sp & 255u) == 0u) { if (xb_ld(&bar[XB_TMO])) break; if (sp > XB_SPIN_CAP) { atomicAdd(&bar[XB_TMO], 1u); break; } }
    }
    nloc = mine > 0u ? mine : 1u; nx = cnt > 0u ? cnt : 1u;
}

__device__ __forceinline__ void xcd_barrier(const XcdBarrier& b) {
    asm volatile("s_waitcnt vmcnt(0)" ::: "memory");
    __syncthreads();
    if (threadIdx.x == 0) {
        unsigned* bar = b.bar;
        __builtin_amdgcn_s_waitcnt(0);
        unsigned nloc = b.st[0], nx = b.st[1];
        if (nloc == 0u) { xcd_barrier_complete(bar, b.x, nloc, nx); b.st[0] = nloc; b.st[1] = nx; }
        const unsigned old = xb_add(&bar[XB_XSUB(b.x)], 1u);
        const unsigned gen = old / nloc;
        if (old + 1u == (gen + 1u) * nloc) {
            __builtin_amdgcn_fence(__ATOMIC_RELEASE, "agent");
            asm volatile("s_waitcnt vmcnt(0)" ::: "memory");
            const unsigned og = xb_add(&bar[XB_TOP], 1u);
            const unsigned tg = og / nx;
            if (og + 1u == (tg + 1u) * nx) xb_add(&bar[XB_TOPGEN], 1u);
            else XB_SPIN(xb_ld(&bar[XB_TOPGEN]) == tg, bar);
            __builtin_amdgcn_fence(__ATOMIC_ACQUIRE, "agent");
            xb_add(&bar[XB_XGEN(b.x)], 1u);
            asm volatile("s_waitcnt vmcnt(0)" ::: "memory");
        } else {
            XB_SPIN(xb_ld(&bar[XB_XGEN(b.x)]) == gen, bar);
            __builtin_amdgcn_fence(__ATOMIC_ACQUIRE, "agent");
            asm volatile("s_waitcnt vmcnt(0)" ::: "memory");
        }
    }
    __syncthreads();
}


__device__ __forceinline__ float wave_sum(float v) {
#pragma unroll
    for (int o = 1; o < 64; o <<= 1) v += __shfl_xor(v, o);
    return v;
}
__device__ __forceinline__ bf16_t f2bf(float x) { return (bf16_t)(cvt_pk_bf16(x, 0.f) & 0xffffu); }

__device__ __forceinline__ int colmap(int mode, int R) {
    const int hc = (R & 96) + pg8::perm32(R & 31);
    const int bj = (R >> 7) & 1, tile = R >> 8;
    if (mode == 0) return (R & ~127) + hc;
    if (mode == 1) { if (tile < 8) return (bj ? 2048 : 0) + 128 * tile + hc;
        const int type = (tile - 8) >> 2, tl = (tile - 8) & 3; const int base = type == 0 ? 1024 : type == 1 ? 3072 : type == 2 ? 4096 : type == 3 ? 5120 : 6144;
        return base + 256 * tl + 128 * bj + hc; }
    return (bj ? DFF : 0) + 128 * tile + hc;
}

template <int RT, int NG, class F>
__device__ __forceinline__ void sample_item(LAS unsigned char* lds, const bf16_t* A, int lda, int rt0, const bf16_t* Bt, int ldb, const int (&gr)[NG], int K, const F& f) {
    static_assert(8 * RT * NG * 1024 <= LDS_STAGE, "sample_item: the eight partial tiles must fit the stage region");
    int tid_ = threadIdx.x; asm volatile("" : "+v"(tid_));
    const int tid = tid_, w = __builtin_amdgcn_readfirstlane(tid >> 6), lane = tid & 63, fr = lane & 15, fq = lane >> 4;
    const int kper = K >> 3, nks = kper >> 5;
    f32x4 acc[RT][NG];
#pragma unroll
    for (int rt = 0; rt < RT; ++rt)
#pragma unroll
        for (int g = 0; g < NG; ++g) acc[rt][g] = (f32x4){0.f, 0.f, 0.f, 0.f};
    const bf16_t* ap = A + (size_t)(16 * rt0 + fr) * lda + w * kper + 8 * fq;
    const bf16_t* bp[NG];
#pragma unroll
    for (int g = 0; g < NG; ++g) bp[g] = Bt + (size_t)(gr[g] + fr) * ldb + w * kper + 8 * fq;
#pragma unroll 2
    for (int ks = 0; ks < nks; ++ks) {
        bf16x8 a[RT], b[NG];
#pragma unroll
        for (int rt = 0; rt < RT; ++rt) a[rt] = *(const bf16x8*)(ap + (size_t)(16 * rt) * lda + 32 * ks);
#pragma unroll
        for (int g = 0; g < NG; ++g) b[g] = *(const bf16x8*)(bp[g] + 32 * ks);
#pragma unroll
        for (int rt = 0; rt < RT; ++rt)
#pragma unroll
            for (int g = 0; g < NG; ++g) acc[rt][g] = __builtin_amdgcn_mfma_f32_16x16x32_bf16(b[g], a[rt], acc[rt][g], 0, 0, 0);
    }
    LAS float* P = (LAS float*)lds;
#pragma unroll
    for (int rt = 0; rt < RT; ++rt)
#pragma unroll
        for (int g = 0; g < NG; ++g) *(LAS f32x4*)(P + ((w * RT + rt) * NG + g) * 256 + fr * 16 + 4 * fq) = acc[rt][g];
    BLK_BAR();
#pragma unroll
    for (int q = 0; q < RT * 256 / 512; ++q) {
        const int e = tid + 512 * q, rt = e >> 8, rc = e & 255;
        float v[NG];
#pragma unroll
        for (int g = 0; g < NG; ++g) { float s = 0.f;
#pragma unroll
            for (int w8 = 0; w8 < 8; ++w8) s += P[((w8 * RT + rt) * NG + g) * 256 + rc];
            v[g] = s; }
        f(16 * (rt0 + rt) + (rc >> 4), rc & 15, v);
    }
    BLK_BAR();
}
__device__ __forceinline__ float grp16_sum(float s) {
    s += __shfl_xor(s, 1); s += __shfl_xor(s, 2); s += __shfl_xor(s, 4); s += __shfl_xor(s, 8); return s;
}
__device__ __forceinline__ void sample_rstd_table(LAS float* tab, const float* ssq_s) {
    const int tid = threadIdx.x;
    if (tid < MS) { const f32x4* p = (const f32x4*)(ssq_s + (size_t)tid * 32); float s = 0.f;
#pragma unroll
        for (int q = 0; q < 8; ++q) { const f32x4 a = p[q]; s += (a[0] + a[1]) + (a[2] + a[3]); }
        tab[tid] = 1.0f / sqrtf(s * (1.0f / D) + EPS); }
    BLK_BAR();
}

struct SfInA {
    const float *rstd0, *wca, *sa; bf16_t* ba; float* out; int R0;
    __device__ __forceinline__ void operator()(int i, int c, const float (&v)[3]) const {
        const int ch = colmap(1, R0 + c); const float rs = rstd0[MP + i];
        const float cav = (v[0] * rs) * (v[1] * rs), bb = v[2] * rs;
        out[O_CAS + (size_t)(i * 2 + 1) * D + ch] = cav;
        const float conv = wca[ch] * sa[(size_t)(i * 2) * D + ch] + wca[D + ch] * sa[(size_t)(i * 2 + 1) * D + ch] + wca[2 * D + ch] * cav;
        ba[(size_t)(MP + i) * D + ch] = f2bf(bb * conv);
    }
};
struct SfInB {
    const float* rstd0; bf16_t* dst; float* vssq_s; int R0, type, slot, base;
    __device__ __forceinline__ void operator()(int i, int c, const float (&v)[2]) const {
        const float rs = rstd0[MP + i]; float s = 0.f;
#pragma unroll
        for (int g = 0; g < 2; ++g) { const int col = colmap(1, R0 + 16 * g + c) - base; float x = v[g] * rs;
            x = type <= 1 ? gelu_tanh(x) : sigmoid_f(x); s += x * x;
            dst[(size_t)(MP + i) * D + col] = f2bf(x); }
        if (type == 1) { s = grp16_sum(s); if (c == 0) vssq_s[i * 32 + slot] = s; }
    }
};
struct SfYa { const bf16_t* sga; float* t1s; int R0;
    __device__ __forceinline__ void operator()(int i, int c, const float (&v)[2]) const {
#pragma unroll
        for (int g = 0; g < 2; ++g) { const int col = colmap(0, R0 + 16 * g + c); t1s[i * D + col] = bf2f(sga[(size_t)(MP + i) * D + col]) * v[g]; }
    }
};
struct SfYb { const bf16_t* sgb; const float* t1s; bf16_t* mm; int R0;
    __device__ __forceinline__ void operator()(int i, int c, const float (&v)[2]) const {
#pragma unroll
        for (int g = 0; g < 2; ++g) { const int col = colmap(0, R0 + 16 * g + c); mm[(size_t)(MP + i) * D + col] = f2bf(t1s[i * D + col] + bf2f(sgb[(size_t)(MP + i) * D + col]) * v[g]); }
    }
};
struct SfRes {
    const float* base; float* h; bf16_t* hb; float* ssq_s; int R0, slot;
    __device__ __forceinline__ void operator()(int i, int c, const float (&v)[2]) const {
        float s = 0.f;
#pragma unroll
        for (int g = 0; g < 2; ++g) { const int col = colmap(0, R0 + 16 * g + c); const float x = base[(size_t)i * D + col] + v[g];
            h[(size_t)(MP + i) * D + col] = x; hb[(size_t)(MP + i) * D + col] = f2bf(x); s += x * x; }
        s = grp16_sum(s); if (c == 0) ssq_s[i * 32 + slot] = s;
    }
};
struct SfUp {
    const LAS float* rs; const float *wcf, *sf; bf16_t* a3; float* out; int R0;
    __device__ __forceinline__ void operator()(int i, int c, const float (&v)[2]) const {
        const int ja = colmap(2, R0 + c), jb = ja + DFF; const float r = rs[i];
        const float ua = v[0] * r, ub = v[1] * r;
        float* o = out + O_CFS + (size_t)(i * 2 + 1) * NUP; o[ja] = ua; o[jb] = ub;
        const float* s0 = sf + (size_t)(i * 2) * NUP; const float* s1 = s0 + NUP;
        const float ca = wcf[ja] * s0[ja] + wcf[NUP + ja] * s1[ja] + wcf[2 * NUP + ja] * ua;
        const float cb = wcf[jb] * s0[jb] + wcf[NUP + jb] * s1[jb] + wcf[2 * NUP + jb] * ub;
        a3[(size_t)(MP + i) * DFF + ja] = f2bf(gelu_tanh(ca) * cb);
    }
};
struct SfPe { float* pes; int R0;
    __device__ __forceinline__ void operator()(int i, int c, const float (&v)[2]) const {
#pragma unroll
        for (int g = 0; g < 2; ++g) pes[i * D + colmap(0, R0 + 16 * g + c)] = v[g];
    }
};
struct SfGate { const LAS float* rs; const float* pes; float* h; int R0;
    __device__ __forceinline__ void operator()(int i, int c, const float (&v)[2]) const {
        const float r = rs[i];
#pragma unroll
        for (int g = 0; g < 2; ++g) { const int col = colmap(0, R0 + 16 * g + c); float* hp = h + (size_t)(MP + i) * D + col; *hp = *hp + sigmoid_f(r * v[g]) * pes[i * D + col]; }
    }
};

struct Ptrs {
    const float *x_p, *x_s, *p_p, *p_s, *st_a, *st_f, *g_mix, *w_in, *w_conv_a, *w_out_a, *g_v, *w_sp, *b_sp, *w_out_b, *w_o, *g_ffn, *w_up, *w_conv_f, *w_down, *g_ple, *w_pg, *w_ple, *g_final;
    float* out; unsigned char* ws;
};
constexpr size_t MiB = 1u << 20;
constexpr size_t WS_WUP = 0, WS_WDOWN = 11 * MiB, WS_WPG = 16 * MiB + MiB / 2, WS_WPLE = 18 * MiB + MiB / 2;
constexpr size_t WS_SMALL = 19 * MiB, WS_CTL = WS_SMALL, CTL_BYTES = 65536;
constexpr size_t WS_RSTD0 = WS_SMALL + 65536, WS_VSSQS = WS_RSTD0 + 131072, WS_SSQ1S = WS_VSSQS + 16384, WS_SSQ2S = WS_SSQ1S + 16384, WS_T1S = WS_SSQ2S + 16384, WS_PES = WS_T1S + 524288;
constexpr size_t WS_VSSQ = 20 * MiB + MiB / 2, WS_SSQ1 = 21 * MiB + 3 * MiB / 4, WS_SSQ2 = 23 * MiB;
constexpr size_t WS_PB = 24 * MiB + MiB / 2;
constexpr size_t WS_WIN = 33 * MiB, WS_WOA = 47 * MiB, WS_WOB = 49 * MiB, WS_WO = 51 * MiB;
constexpr size_t WS_XB = 53 * MiB, WS_CA = 86 * MiB, WS_VP = WS_CA + 65 * MiB / 2, WS_BA = 151 * MiB, WS_UU = 184 * MiB, WS_SGA = 217 * MiB;
constexpr size_t WS_H1B = 222 * MiB, WS_UPH = 33 * MiB, WS_A3 = 123 * MiB, WS_H2B = 33 * MiB, WS_PE = 123 * MiB;

__device__ __forceinline__ void p0_rows(const Ptrs& P, bf16_t* xb, float* rstd0, bf16_t* pb) {
    const int tid = threadIdx.x, lane = tid & 63, gw = blockIdx.x * 8 + (tid >> 6), NGW = gridDim.x * 8;
    for (int r = gw; r < MV; r += NGW) {
        const f32x4* src = (const f32x4*)(r < MP ? P.x_p + (size_t)r * D : P.x_s + (size_t)(r - MP) * D) + lane;
        f32x4 v[4]; float s = 0.f;
#pragma unroll
        for (int j = 0; j < 4; ++j) { v[j] = src[64 * j]; s += sum4sq(v[j]); }
        s = wave_sum(s);
        if (lane == 0) rstd0[r] = 1.0f / sqrtf(s * (1.0f / D) + EPS);
        unsigned long long* o8 = (unsigned long long*)(xb + (size_t)r * D) + lane;
#pragma unroll
        for (int j = 0; j < 4; ++j) o8[64 * j] = (unsigned long long)cvt_pk_bf16(v[j][0], v[j][1]) | ((unsigned long long)cvt_pk_bf16(v[j][2], v[j][3]) << 32);
    }
    const size_t gt = (size_t)blockIdx.x * 512 + tid, gs = (size_t)gridDim.x * 512;
    for (size_t i4 = gt; i4 < (size_t)MV * PD / 4; i4 += gs) { const size_t i = i4 * 4;
        const f32x4 v = i < (size_t)MP * PD ? *(const f32x4*)(P.p_p + i) : *(const f32x4*)(P.p_s + (i - (size_t)MP * PD));
        *(unsigned long long*)(pb + i) = (unsigned long long)cvt_pk_bf16(v[0], v[1]) | ((unsigned long long)cvt_pk_bf16(v[2], v[3]) << 32); }
    for (size_t e = gt; e < (size_t)MS * (D + NUP); e += gs) { const int i = (int)(e / (D + NUP)), c = (int)(e % (D + NUP));
        if (c < D) P.out[O_CAS + (size_t)(i * 2) * D + c] = P.st_a[(size_t)(i * 2 + 1) * D + c];
        else P.out[O_CFS + (size_t)(i * 2) * NUP + (c - D)] = P.st_f[(size_t)(i * 2 + 1) * NUP + (c - D)]; }
}
__device__ __forceinline__ void wt_tile_load(const float* W, const float* scale, int Nw, int mode, int R0, int k0, LAS float* t, int ht) {
    const int tx = ht & 63, ty = ht >> 6; const int col = colmap(mode, R0 + tx);
#pragma unroll
    for (int i = 0; i < 16; ++i) { const int k = k0 + ty + 4 * i; t[(ty + 4 * i) * 65 + tx] = W[(size_t)k * Nw + col] * (scale ? scale[k] : 1.0f); }
}
__device__ __forceinline__ void wt_tile_store(bf16_t* out, int K, int R0, int k0, const LAS float* t, int ht) {
    const int Rl = ht >> 2, kq = ht & 3; const LAS float* s = t + (kq * 16) * 65 + Rl;
    u32x4 w0, w1;
    w0.x = cvt_pk_bf16(s[0 * 65], s[1 * 65]); w0.y = cvt_pk_bf16(s[2 * 65], s[3 * 65]); w0.z = cvt_pk_bf16(s[4 * 65], s[5 * 65]); w0.w = cvt_pk_bf16(s[6 * 65], s[7 * 65]);
    w1.x = cvt_pk_bf16(s[8 * 65], s[9 * 65]); w1.y = cvt_pk_bf16(s[10 * 65], s[11 * 65]); w1.z = cvt_pk_bf16(s[12 * 65], s[13 * 65]); w1.w = cvt_pk_bf16(s[14 * 65], s[15 * 65]);
    bf16_t* o = out + (size_t)(R0 + Rl) * K + k0 + kq * 16;
    *(u32x4*)o = w0; *(u32x4*)(o + 8) = w1;
}
struct WtJob { const float* W; const float* scale; bf16_t* out; int K, Nw, mode, R0, k0; };
__device__ __forceinline__ bool wt_decode(const Ptrs& P, int it, WtJob& j) {
    unsigned char* ws = P.ws;
    constexpr int T_IN = (NIN / 64) * (D / 64), T_SQ = (D / 64) * (D / 64), T_UP = (NUP / 64) * (D / 64), T_DN = (D / 64) * (DFF / 64), T_PL = (D / 64) * (PD / 64);
    int nk;
    if (it < T_IN) { j.W = P.w_in; j.scale = P.g_mix; j.out = (bf16_t*)(ws + WS_WIN); j.K = D; j.Nw = NIN; j.mode = 1; nk = D / 64; }
    else if ((it -= T_IN) < T_SQ) { j.W = P.w_out_a; j.scale = nullptr; j.out = (bf16_t*)(ws + WS_WOA); j.K = D; j.Nw = D; j.mode = 0; nk = D / 64; }
    else if ((it -= T_SQ) < T_SQ) { j.W = P.w_out_b; j.scale = nullptr; j.out = (bf16_t*)(ws + WS_WOB); j.K = D; j.Nw = D; j.mode = 0; nk = D / 64; }
    else if ((it -= T_SQ) < T_SQ) { j.W = P.w_o; j.scale = nullptr; j.out = (bf16_t*)(ws + WS_WO); j.K = D; j.Nw = D; j.mode = 0; nk = D / 64; }
    else if ((it -= T_SQ) < T_SQ) { j.W = P.w_pg; j.scale = P.g_ple; j.out = (bf16_t*)(ws + WS_WPG); j.K = D; j.Nw = D; j.mode = 0; nk = D / 64; }
    else if ((it -= T_SQ) < T_UP) { j.W = P.w_up; j.scale = P.g_ffn; j.out = (bf16_t*)(ws + WS_WUP); j.K = D; j.Nw = NUP; j.mode = 2; nk = D / 64; }
    else if ((it -= T_UP) < T_DN) { j.W = P.w_down; j.scale = nullptr; j.out = (bf16_t*)(ws + WS_WDOWN); j.K = DFF; j.Nw = D; j.mode = 0; nk = DFF / 64; }
    else if ((it -= T_DN) < T_PL) { j.W = P.w_ple; j.scale = nullptr; j.out = (bf16_t*)(ws + WS_WPLE); j.K = PD; j.Nw = D; j.mode = 0; nk = PD / 64; }
    else return false;
    j.R0 = (it / nk) * 64; j.k0 = (it % nk) * 64; return true;
}
constexpr int WT_TILES = (NIN / 64) * (D / 64) + 4 * (D / 64) * (D / 64) + (NUP / 64) * (D / 64) + (D / 64) * (DFF / 64) + (D / 64) * (PD / 64);
__device__ __forceinline__ void p0_weights(const Ptrs& P, LAS unsigned char* lds) {
    const int tid = threadIdx.x, half = tid >> 8, ht = tid & 255;
    LAS float* t = (LAS float*)lds + half * (64 * 65);
    for (int base = blockIdx.x * 2; base < WT_TILES; base += gridDim.x * 2) {
        WtJob j; const bool ok = wt_decode(P, base + half, j);
        if (ok) wt_tile_load(j.W, j.scale, j.Nw, j.mode, j.R0, j.k0, t, ht);
        BLK_BAR();
        if (ok) wt_tile_store(j.out, j.K, j.R0, j.k0, t, ht);
        BLK_BAR();
    }
}
__device__ __forceinline__ void p2_convA(const bf16_t* ca, bf16_t* ba, const float* wc) {
    const f32x4 z = (f32x4){0.f, 0.f, 0.f, 0.f};
    for (size_t idx = (size_t)blockIdx.x * 512 + threadIdx.x; idx < (size_t)MP * 128; idx += (size_t)gridDim.x * 512) {
        const int r = (int)(idx >> 7), j = (int)(idx & 127) * 8, t = r & (SEQ - 1);
        f32x4 c0a, c0b, c1a = z, c1b = z, c2a = z, c2b = z;
        load8_bf16(ca + (size_t)r * D + j, c0a, c0b);
        if (t >= 1) load8_bf16(ca + (size_t)(r - 1) * D + j, c1a, c1b);
        if (t >= 2) load8_bf16(ca + (size_t)(r - 2) * D + j, c2a, c2b);
        const f32x4 w0a = *(const f32x4*)(wc + j), w0b = *(const f32x4*)(wc + j + 4), w1a = *(const f32x4*)(wc + D + j), w1b = *(const f32x4*)(wc + D + j + 4),
                    w2a = *(const f32x4*)(wc + 2 * D + j), w2b = *(const f32x4*)(wc + 2 * D + j + 4);
        f32x4 b0, b1; load8_bf16(ba + (size_t)r * D + j, b0, b1);
        store8_bf16(ba + (size_t)r * D + j, b0 * (w0a * c2a + w1a * c1a + w2a * c0a), b1 * (w0b * c2b + w1b * c1b + w2b * c0b));
    }
}
__device__ __forceinline__ void p2_spatial(const Ptrs& P, LAS unsigned char* lds, const bf16_t* vp, bf16_t* uu, const float* vssq) {
    LAS float* vn = (LAS float*)lds;
    LAS float* rs = (LAS float*)(lds + 65536);
    const int tid = threadIdx.x, d = tid & 127, th = tid >> 7;
    for (int it = blockIdx.x; it < (MP / 128) * 8; it += gridDim.x) {
        const int c = it >> 3, g = it & 7, r0 = c * 128, d0 = g * 128;
        if (tid < 128) { const f32x4* p = (const f32x4*)(vssq + (size_t)(r0 + tid) * 16); float s = 0.f;
#pragma unroll
            for (int q = 0; q < 4; ++q) { const f32x4 a = p[q]; s += (a[0] + a[1]) + (a[2] + a[3]); }
            rs[tid] = 1.0f / sqrtf(s * (1.0f / D) + EPS); }
        BLK_BAR();
        const float gvd = P.g_v[d0 + d];
        for (int s = th; s < 128; s += 4) vn[s * 128 + d] = bf2f(vp[(size_t)(r0 + s) * D + d0 + d]) * rs[s] * gvd;
        BLK_BAR();
        if ((c & 15) == 15) for (int s = th; s < 128; s += 4) P.out[O_CVP + ((size_t)((c >> 4) * 128 + s)) * D + d0 + d] = vn[s * 128 + d];
        const float* W = P.w_sp + (size_t)g * 128 * 128;
        for (int t = th; t < 128; t += 4) {
            const float* wrow = W + t * 128; float a = 0.f;
            for (int s = 0; s <= t; ++s) a += wrow[s] * vn[s * 128 + d];
            a += P.b_sp[g * 128 + t];
            const size_t o = (size_t)(r0 + t) * D + d0 + d;
            uu[o] = f2bf(bf2f(uu[o]) * a);
        }
        BLK_BAR();
    }
}
__device__ __forceinline__ void p2_spatial_s(const Ptrs& P, const bf16_t* vp, bf16_t* uu, const float* vssq_s) {
    const int tid = threadIdx.x, lane = tid & 63, gw = blockIdx.x * 8 + (tid >> 6), NGW = gridDim.x * 8;
    for (int i = gw; i < MS; i += NGW) {
        float s = lane < 32 ? vssq_s[i * 32 + lane] : 0.f; s = wave_sum(s);
        const float rsv = 1.0f / sqrtf(s * (1.0f / D) + EPS); const size_t r = (size_t)(MP + i) * D;
        for (int d = lane; d < D; d += 64) { const int g = d >> 7;
            const float vnv = bf2f(vp[r + d]) * rsv * P.g_v[d];
            P.out[O_CVS + (size_t)i * D + d] = vnv;
            uu[r + d] = f2bf(bf2f(uu[r + d]) * (P.w_sp[(size_t)g * 128 * 128] * vnv + P.b_sp[g * 128])); }
    }
}
__device__ __forceinline__ void p5_convF(const bf16_t* uph, bf16_t* a3, const float* wcf, int half) {
    const f32x4 z = (f32x4){0.f, 0.f, 0.f, 0.f};
    for (size_t idx = (size_t)blockIdx.x * 512 + threadIdx.x; idx < (size_t)MP * 176; idx += (size_t)gridDim.x * 512) {
        const int c8 = (int)(idx & 15), t = (int)((idx >> 4) % 11), r = (int)(idx / 176), tt = r & (SEQ - 1);
        const int c = c8 * 8, ja = 1408 * half + 128 * t + c, jb = DFF + ja;
        const bf16_t* pa = uph + (size_t)r * DFF + 256 * t + c; const bf16_t* pb = pa + 128;
        f32x4 a0[2], a1[2], a2[2], b0[2], b1[2], b2[2];
        load8_bf16(pa, a0[0], a0[1]); load8_bf16(pb, b0[0], b0[1]);
        if (tt >= 1) { load8_bf16(pa - DFF, a1[0], a1[1]); load8_bf16(pb - DFF, b1[0], b1[1]); } else { a1[0] = a1[1] = b1[0] = b1[1] = z; }
        if (tt >= 2) { load8_bf16(pa - 2 * DFF, a2[0], a2[1]); load8_bf16(pb - 2 * DFF, b2[0], b2[1]); } else { a2[0] = a2[1] = b2[0] = b2[1] = z; }
        f32x4 o[2];
#pragma unroll
        for (int q = 0; q < 2; ++q) {
            const f32x4 wa0 = *(const f32x4*)(wcf + ja + 4 * q), wa1 = *(const f32x4*)(wcf + NUP + ja + 4 * q), wa2 = *(const f32x4*)(wcf + 2 * NUP + ja + 4 * q);
            const f32x4 wb0 = *(const f32x4*)(wcf + jb + 4 * q), wb1 = *(const f32x4*)(wcf + NUP + jb + 4 * q), wb2 = *(const f32x4*)(wcf + 2 * NUP + jb + 4 * q);
            f32x4 cav = wa0 * a2[q] + wa1 * a1[q] + wa2 * a0[q]; const f32x4 cbv = wb0 * b2[q] + wb1 * b1[q] + wb2 * b0[q];
#pragma unroll
            for (int j = 0; j < 4; ++j) cav[j] = gelu_tanh(cav[j]);
            o[q] = cav * cbv; }
        store8_bf16(a3 + (size_t)r * DFF + ja, o[0], o[1]);
    }
}
__device__ __forceinline__ void p8_final(float* h, const float* gf) {
    const int tid = threadIdx.x, lane = tid & 63, gw = blockIdx.x * 8 + (tid >> 6), NGW = gridDim.x * 8;
    for (int r = gw; r < MV; r += NGW) {
        f32x4* p = (f32x4*)(h + (size_t)r * D) + lane; f32x4 v[4]; float s = 0.f;
#pragma unroll
        for (int j = 0; j < 4; ++j) { v[j] = p[64 * j]; s += sum4sq(v[j]); }
        s = wave_sum(s); const float rs = 1.0f / sqrtf(s * (1.0f / D) + EPS);
#pragma unroll
        for (int j = 0; j < 4; ++j) { const f32x4 g = *((const f32x4*)gf + lane + 64 * j); p[64 * j] = v[j] * rs * g; }
    }
}

template <class Epi> __device__ __forceinline__ void run_gemm(LAS unsigned char* lds, const bf16_t* A, int lda, const bf16_t* Bt, int ldb, int N, int K, const Epi& E) {
    pg8::Gemm g; g.A = A; g.Bt = Bt; g.M = MP; g.N = N; g.K = K; g.lda = lda; g.ldb = ldb; g.pad = 0;
    pg8::StaticOrder S; S.init(MP, N, (int)gridDim.x, (int)blockIdx.x);
    pg8::gemm_phase<Epi, pg8::StaticOrder, true, true>(lds, g, S, E);
}

__global__ void __launch_bounds__(512, 2) mega_fwd(Ptrs P) {
    extern __shared__ __attribute__((aligned(16))) unsigned char lds_raw[];
    LAS unsigned char* lds = (LAS unsigned char*)lds_raw;
    const int tid = threadIdx.x;
    volatile LAS unsigned* MISC = (volatile LAS unsigned*)(lds + LDS_CTL_OFF);
    if (tid < 64) MISC[tid] = 0u;
    __syncthreads();
    unsigned char* ws = P.ws; float* out = P.out;
    XcdBarrier bar = xcd_barrier_post((unsigned*)(ws + WS_CTL), MISC + 8);
#define GRID_BAR() xcd_barrier(bar)
    bf16_t* Wt_up = (bf16_t*)(ws + WS_WUP); bf16_t* Wt_down = (bf16_t*)(ws + WS_WDOWN); bf16_t* Wt_pg = (bf16_t*)(ws + WS_WPG); bf16_t* Wt_ple = (bf16_t*)(ws + WS_WPLE);
    bf16_t* Wt_in = (bf16_t*)(ws + WS_WIN); bf16_t* Wt_oa = (bf16_t*)(ws + WS_WOA); bf16_t* Wt_ob = (bf16_t*)(ws + WS_WOB); bf16_t* Wt_o = (bf16_t*)(ws + WS_WO);
    float* rstd0 = (float*)(ws + WS_RSTD0); float* vssq_s = (float*)(ws + WS_VSSQS); float* ssq1_s = (float*)(ws + WS_SSQ1S); float* ssq2_s = (float*)(ws + WS_SSQ2S);
    float* t1s = (float*)(ws + WS_T1S); float* pes = (float*)(ws + WS_PES);
    float* vssq = (float*)(ws + WS_VSSQ); float* ssq1 = (float*)(ws + WS_SSQ1); float* ssq2 = (float*)(ws + WS_SSQ2);
    bf16_t* pb = (bf16_t*)(ws + WS_PB); bf16_t* xb = (bf16_t*)(ws + WS_XB); bf16_t* mm = xb;
    bf16_t* ca = (bf16_t*)(ws + WS_CA); bf16_t* vp = (bf16_t*)(ws + WS_VP); float* t1 = (float*)ca;
    bf16_t* ba = (bf16_t*)(ws + WS_BA); bf16_t* uu = (bf16_t*)(ws + WS_UU); bf16_t* sga = (bf16_t*)(ws + WS_SGA); bf16_t* sgb = (bf16_t*)out;
    float* h = out; bf16_t* h1b = (bf16_t*)(ws + WS_H1B); bf16_t* uph = (bf16_t*)(ws + WS_UPH); bf16_t* a3 = (bf16_t*)(ws + WS_A3); bf16_t* h2b = (bf16_t*)(ws + WS_H2B); float* pe = (float*)(ws + WS_PE);
    LAS float* rstab = (LAS float*)(lds + LDS_XTRA_OFF);
    const int G = gridDim.x, bid = blockIdx.x;

    p0_rows(P, xb, rstd0, pb);
    p0_weights(P, lds);
    GRID_BAR();
    { EpiIn E; E.rstd0 = rstd0; E.ca = ca; E.ba = ba; E.uu = uu; E.vp = vp; E.sga = sga; E.sgb = sgb; E.vssq = vssq; E.out = out;
      run_gemm(lds, xb, D, Wt_in, D, NIN, D, E); }
    for (int it = bid; it < 256; it += G) {
        if (it < 128) { const int rh = it >> 6, i6 = it & 63, t = i6 >> 3, wc = (i6 >> 1) & 3, n = i6 & 1, Rx = t * 256 + wc * 32 + n * 16;
            const int gr[3] = {Rx, Rx + 128, (8 + (t >> 1)) * 256 + (t & 1) * 128 + wc * 32 + n * 16};
            SfInA f; f.rstd0 = rstd0; f.wca = P.w_conv_a; f.sa = P.st_a; f.ba = ba; f.out = out; f.R0 = Rx;
            sample_item<4, 3>(lds, xb + (size_t)MP * D, D, 4 * rh, Wt_in, D, gr, D, f);
        } else { const int j = it - 128, tile = 12 + (j >> 3), bj = (j >> 2) & 1, wc = j & 3, R0 = tile * 256 + bj * 128 + wc * 32, type = (tile - 12) >> 2;
            const int gr[2] = {R0, R0 + 16};
            SfInB f; f.rstd0 = rstd0; f.dst = type == 0 ? uu : type == 1 ? vp : type == 2 ? sga : sgb; f.vssq_s = vssq_s; f.R0 = R0; f.type = type; f.slot = ((tile - 16) & 3) * 8 + bj * 4 + wc;
            f.base = type == 0 ? 3072 : type == 1 ? 4096 : type == 2 ? 5120 : 6144;
            sample_item<8, 2>(lds, xb + (size_t)MP * D, D, 0, Wt_in, D, gr, D, f); }
    }
    GRID_BAR();
    p2_convA(ca, ba, P.w_conv_a);
    p2_spatial(P, lds, vp, uu, vssq);
    p2_spatial_s(P, vp, uu, vssq_s);
    GRID_BAR();
    { EpiYa E; E.sga = sga; E.t1 = t1; run_gemm(lds, ba, D, Wt_oa, D, D, D, E); }
    for (int it = bid; it < 32; it += G) { const int gr[2] = {it * 32, it * 32 + 16}; SfYa f; f.sga = sga; f.t1s = t1s; f.R0 = it * 32;
        sample_item<8, 2>(lds, ba + (size_t)MP * D, D, 0, Wt_oa, D, gr, D, f); }
    GRID_BAR();
    { EpiYb E; E.sgb = sgb; E.t1 = t1; E.mm = mm; run_gemm(lds, uu, D, Wt_ob, D, D, D, E); }
    for (int it = bid; it < 32; it += G) { const int gr[2] = {it * 32, it * 32 + 16}; SfYb f; f.sgb = sgb; f.t1s = t1s; f.mm = mm; f.R0 = it * 32;
        sample_item<8, 2>(lds, uu + (size_t)MP * D, D, 0, Wt_ob, D, gr, D, f); }
    GRID_BAR();
    { EpiRes<0> E; E.xp = P.x_p; E.xs = P.x_s; E.h = h; E.hb = h1b; E.ssq = ssq1; run_gemm(lds, mm, D, Wt_o, D, D, D, E); }
    for (int it = bid; it < 32; it += G) { const int gr[2] = {it * 32, it * 32 + 16}; SfRes f; f.base = P.x_s; f.h = h; f.hb = h1b; f.ssq_s = ssq1_s; f.R0 = it * 32; f.slot = it;
        sample_item<8, 2>(lds, mm + (size_t)MP * D, D, 0, Wt_o, D, gr, D, f); }
    GRID_BAR();
    { EpiUp E; E.ssq1 = ssq1; E.uph = uph; E.out = out; E.half = 0; E.pad = 0; run_gemm(lds, h1b, D, Wt_up, D, DFF, D, E); }
    if (bid < 176) sample_rstd_table(rstab, ssq1_s);
    for (int it = bid; it < 176; it += G) { const int T = it >> 3, wc = (it >> 1) & 3, n = it & 1, Ra = T * 256 + wc * 32 + n * 16; const int gr[2] = {Ra, Ra + 128};
        SfUp f; f.rs = rstab; f.wcf = P.w_conv_f; f.sf = P.st_f; f.a3 = a3; f.out = out; f.R0 = Ra;
        sample_item<8, 2>(lds, h1b + (size_t)MP * D, D, 0, Wt_up, D, gr, D, f); }
    GRID_BAR();
    p5_convF(uph, a3, P.w_conv_f, 0);
    GRID_BAR();
    { EpiUp E; E.ssq1 = ssq1; E.uph = uph; E.out = out; E.half = 1; E.pad = 0; run_gemm(lds, h1b, D, Wt_up + (size_t)DFF * D, D, DFF, D, E); }
    GRID_BAR();
    p5_convF(uph, a3, P.w_conv_f, 1);
    GRID_BAR();
    { EpiRes<1> E; E.xp = nullptr; E.xs = nullptr; E.h = h; E.hb = h2b; E.ssq = ssq2; run_gemm(lds, a3, DFF, Wt_down, DFF, D, DFF, E); }
    for (int it = bid; it < 128; it += G) { const int rg = it >> 5, cg = it & 31; const int gr[2] = {cg * 32, cg * 32 + 16};
        SfRes f; f.base = h + (size_t)MP * D; f.h = h; f.hb = h2b; f.ssq_s = ssq2_s; f.R0 = cg * 32; f.slot = cg;
        sample_item<2, 2>(lds, a3 + (size_t)MP * DFF, DFF, 2 * rg, Wt_down, DFF, gr, DFF, f); }
    GRID_BAR();
    { EpiPe E; E.pe = pe; run_gemm(lds, pb, PD, Wt_ple, PD, D, PD, E); }
    { EpiGate E; E.ssq2 = ssq2; E.pe = pe; E.h = h; run_gemm(lds, h2b, D, Wt_pg, D, D, D, E); }
    if (bid < 32) sample_rstd_table(rstab, ssq2_s);
    for (int it = bid; it < 32; it += G) { const int gr[2] = {it * 32, it * 32 + 16};
        { SfPe f; f.pes = pes; f.R0 = it * 32; sample_item<8, 2>(lds, pb + (size_t)MP * PD, PD, 0, Wt_ple, PD, gr, PD, f); }
        { SfGate f; f.rs = rstab; f.pes = pes; f.h = h; f.R0 = it * 32; sample_item<8, 2>(lds, h2b + (size_t)MP * D, D, 0, Wt_pg, D, gr, D, f); } }
    GRID_BAR();
    p8_final(h, P.g_final);
}

extern "C" void kernel_launch(void* const* d_in, const int* in_sizes, int n_in, void* d_out, int out_size, void* d_ws, size_t ws_size, hipStream_t stream) {
    (void)in_sizes; (void)n_in; (void)out_size; (void)ws_size;
    static int grid = 0;
    if (grid == 0) {
        int dev = 0, cus = 0, per_cu = 0;
        (void)hipGetDevice(&dev); (void)hipDeviceGetAttribute(&cus, hipDeviceAttributeMultiprocessorCount, dev);
        (void)hipFuncSetAttribute((const void*)mega_fwd, hipFuncAttributeMaxDynamicSharedMemorySize, LDS_TOTAL);
        if (hipOccupancyMaxActiveBlocksPerMultiprocessor(&per_cu, (const void*)mega_fwd, 512, LDS_TOTAL) != hipSuccess || per_cu < 1) { per_cu = 1; (void)hipGetLastError(); }
        grid = cus * (per_cu > 1 ? 1 : per_cu);
        if (grid <= 0) grid = 256;
    }
    (void)hipMemsetAsync((char*)d_ws + WS_CTL, 0, CTL_BYTES, stream);
    Ptrs P{};
    const float** pf = (const float**)&P;
    for (int i = 0; i < 23; ++i) pf[i] = (const float*)d_in[i];
    P.out = (float*)d_out; P.ws = (unsigned char*)d_ws;
    void* args[] = {&P};
    hipError_t e = hipLaunchCooperativeKernel((const void*)mega_fwd, dim3(grid), dim3(512), args, LDS_TOTAL, stream);
    if (e != hipSuccess) { fprintf(stderr, "cooperative launch failed: %s (grid %d)\n", hipGetErrorString(e), grid); (void)hipGetLastError();
        hipLaunchKernelGGL(mega_fwd, dim3(grid), dim3(512), LDS_TOTAL, stream, P); }
}
```

```cpp
#include <hip/hip_runtime.h>
#include <cstdio>
#include <cstdint>
namespace pg8 {
#define PG8_LAS __attribute__((address_space(3)))
typedef unsigned short bf16_t;
typedef short bf16x8 __attribute__((ext_vector_type(8)));
typedef float f32x4 __attribute__((ext_vector_type(4)));
typedef unsigned u32x4 __attribute__((ext_vector_type(4)));
constexpr int BM = 256, BK = 64, HALF = 128, HTB = HALF * BK * 2  , STAGE_BYTES = 8 * HTB, NXCD = 8, WGM = 8;

__host__ __device__ __forceinline__ int lds_byte(int r, int c) { const int st = (r >> 4) * 2 + (c >> 5), rr = r & 15, cc = c & 31, ob = rr * 64 + cc * 2; return st * 1024 + (ob ^ (((ob >> 9) & 1) << 5)); }
__host__ __device__ __forceinline__ void stage_rc(int b, int& R, int& C) { const int st = b / 1024, sb = b % 1024, swz = sb ^ (((sb >> 9) & 1) << 5); R = (st >> 1) * 16 + swz / 64; C = (st & 1) * 32 + (swz % 64) / 2; }
__host__ __device__ __forceinline__ int perm32(int rho) { const int n = rho >> 4, i = rho & 15; return 8 * (i >> 2) + 4 * n + (i & 3); }

struct Unit { int pm, pn; };
struct Gemm { const bf16_t* A; const bf16_t* Bt; int M, N, K, lda, ldb, pad; };

struct StaticOrder {
    int nM, nN, nwg, G, c;
    __host__ __device__ void init(int M, int N, int G_, int c_) { nM = M / BM; nN = N / BM; nwg = nM * nN; G = G_; c = c_; }
    __host__ __device__ bool next(int i, Unit& u) const {
        const long L = (long)i * G + c; if (L >= nwg) return false;
        int wgid = (int)L; { const int q = nwg / NXCD, r = nwg % NXCD, xcd = wgid % NXCD, off = wgid / NXCD; wgid = (xcd < r ? xcd * (q + 1) : r * (q + 1) + (xcd - r) * q) + off; }
        const int nig = WGM * nN, gid = wgid / nig, fm = gid * WGM, gsz = (nM - fm) < WGM ? (nM - fm) : WGM;
        u.pm = fm + ((wgid % nig) % gsz); u.pn = (wgid % nig) / gsz; return true;
    }
    __device__ __forceinline__ void a_ready(const Unit&) const {}
    __device__ __forceinline__ void done(const Unit&) const {}
};


typedef __bf16 bf16x2_nat __attribute__((ext_vector_type(2)));
typedef float f32x2_nat __attribute__((ext_vector_type(2)));
__device__ __forceinline__ unsigned cvt_pk_bf16(float lo, float hi) { const f32x2_nat v = {lo, hi}; return __builtin_bit_cast(unsigned, __builtin_convertvector(v, bf16x2_nat)); }
template <class Epi, class Sched, bool ALIGN_EPI = false, bool SP2 = false>
__device__ __forceinline__ void gemm_phase(PG8_LAS unsigned char* lds, const Gemm g, const Sched& S, const Epi& E) {
    int tid_ = threadIdx.x; asm volatile("" : "+v"(tid_));
    const int tid = tid_, wid = __builtin_amdgcn_readfirstlane(tid >> 6), lane = tid & 63, wr = wid >> 2, wc = wid & 3, fr = lane & 15, fq = lane >> 4;
    const int K = g.K, nt = K / BK;
    unsigned voffA[2], voffB[2];
#pragma unroll
    for (int i = 0; i < 2; ++i) { int R, C; stage_rc(tid * 16 + i * 8192, R, C); voffA[i] = (unsigned)(R * g.lda + C) * 2u; voffB[i] = (unsigned)(R * g.ldb + C) * 2u; }
    const size_t kstep = (size_t)(BK * 2);
    const size_t hstepA = (size_t)HALF * g.lda * 2, hstepB = (size_t)HALF * g.ldb * 2;
    const size_t tstepA = 2 * hstepA, tstepB = 2 * hstepB;
    const unsigned ldsw = (unsigned)wid * 1024u;
    const int aoff = lds_byte(wr * 64 + fr, fq * 8), boff = lds_byte(wc * 32 + fr, fq * 8);
#define PG8_SA(b, h) (((b) * 2 + (h)) * HTB)
#define PG8_SB(b, h) ((4 + (b) * 2 + (h)) * HTB)
#define PG8_STAGE(bufoff, gbase, voff) do { _Pragma("unroll") for (int _i = 0; _i < 2; ++_i) \
        __builtin_amdgcn_global_load_lds((const unsigned*)((const char*)(gbase) + (voff)[_i]), (PG8_LAS unsigned*)(lds + (bufoff) + ldsw + _i * 8192), 16, 0, 0); } while (0)
#define PG8_LDA(dst, b, h) do { _Pragma("unroll") for (int m = 0; m < 4; ++m) _Pragma("unroll") for (int k = 0; k < 2; ++k) dst[m][k] = *(const PG8_LAS bf16x8*)(lds + PG8_SA(b, h) + aoff + m * 2048 + k * 1024); } while (0)
#define PG8_LDB(dst, b, h) do { _Pragma("unroll") for (int n = 0; n < 2; ++n) _Pragma("unroll") for (int k = 0; k < 2; ++k) dst[n][k] = *(const PG8_LAS bf16x8*)(lds + PG8_SB(b, h) + boff + n * 2048 + k * 1024); } while (0)
#define PG8_MMA(ai, bj, At, Bt) do { __builtin_amdgcn_s_setprio(1); _Pragma("unroll") for (int m = 0; m < 4; ++m) _Pragma("unroll") for (int n = 0; n < 2; ++n) _Pragma("unroll") for (int k = 0; k < 2; ++k) \
        acc[ai][bj][m][n] = __builtin_amdgcn_mfma_f32_16x16x32_bf16(Bt[n][k], At[m][k], acc[ai][bj][m][n], 0, 0, 0); __builtin_amdgcn_s_setprio(0); } while (0)
#define PG8_WAIT_V(n) asm volatile("s_waitcnt vmcnt(" #n ")" ::: "memory")
#define PG8_WAIT_L(n) asm volatile("s_waitcnt lgkmcnt(" #n ")" ::: "memory")
#define PG8_BAR __builtin_amdgcn_s_barrier()
#define PG8_SCHED __builtin_amdgcn_sched_barrier(0)
    Unit cur, nxt; int ui = 0;
    if (!S.next(0, cur)) return;
    f32x4 acc[2][2][4][2];
#pragma unroll
    for (int a = 0; a < 2; ++a)
#pragma unroll
        for (int b = 0; b < 2; ++b)
#pragma unroll
            for (int m = 0; m < 4; ++m)
#pragma unroll
                for (int n = 0; n < 2; ++n) acc[a][b][m][n] = (f32x4){0.f, 0.f, 0.f, 0.f};
    bf16x8 At[4][2], B0[2][2], B1[2][2];
    const char* cA = (const char*)g.A + (size_t)cur.pm * tstepA; const char* cB = (const char*)g.Bt + (size_t)cur.pn * tstepB;
    S.a_ready(cur);
    if constexpr (SP2) {
        PG8_STAGE(PG8_SB(0, 0), cB, voffB); PG8_STAGE(PG8_SB(0, 1), cB + hstepB, voffB); PG8_STAGE(PG8_SA(0, 0), cA, voffA); PG8_STAGE(PG8_SA(0, 1), cA + hstepA, voffA);
        if (wr == 1) PG8_BAR;
        PG8_WAIT_V(2); PG8_BAR;
        PG8_STAGE(PG8_SB(1, 0), cB + kstep, voffB); PG8_STAGE(PG8_SA(1, 0), cA + kstep, voffA); PG8_STAGE(PG8_SB(1, 1), cB + hstepB + kstep, voffB);
        PG8_WAIT_V(6); PG8_BAR;
    } else {
        PG8_STAGE(PG8_SB(0, 0), cB, voffB); PG8_STAGE(PG8_SA(0, 0), cA, voffA); PG8_STAGE(PG8_SB(0, 1), cB + hstepB, voffB); PG8_STAGE(PG8_SA(0, 1), cA + hstepA, voffA);
        if (wr == 1) PG8_BAR;
        PG8_WAIT_V(4); PG8_BAR;
        PG8_STAGE(PG8_SB(1, 0), cB + kstep, voffB); PG8_STAGE(PG8_SA(1, 0), cA + kstep, voffA); PG8_STAGE(PG8_SB(1, 1), cB + hstepB + kstep, voffB);
        PG8_WAIT_V(6); PG8_BAR;
    }
    for (;;) {
        const bool has_next = S.next(ui + 1, nxt);
        const char* nA = has_next ? (const char*)g.A + (size_t)nxt.pm * tstepA : cA; const char* nB = has_next ? (const char*)g.Bt + (size_t)nxt.pn * tstepB : cB;
        for (int t = 0; t < nt; t += 2) {
            const bool last = (t == nt - 2);
            const char* a1 = cA + (size_t)(t + 1) * kstep;
            const char* a2 = last ? nA : cA + (size_t)(t + 2) * kstep; const char* b2 = last ? nB : cB + (size_t)(t + 2) * kstep;
            const char* a3 = a2 + kstep; const char* b3 = b2 + kstep;
            if (last && has_next) S.a_ready(nxt);
            if constexpr (SP2) {
            PG8_LDB(B0, 0, 0); PG8_LDB(B1, 0, 1); PG8_SCHED; PG8_LDA(At, 0, 0); PG8_STAGE(PG8_SA(1, 1), a1 + hstepA, voffA);
            PG8_WAIT_V(8); PG8_WAIT_L(0); PG8_BAR; PG8_MMA(0, 0, At, B0); PG8_MMA(0, 1, At, B1); PG8_BAR; PG8_SCHED;
            PG8_LDA(At, 0, 1); PG8_STAGE(PG8_SB(0, 0), b2, voffB); PG8_STAGE(PG8_SB(0, 1), b2 + hstepB, voffB); PG8_STAGE(PG8_SA(0, 0), a2, voffA);
            PG8_WAIT_V(8); PG8_WAIT_L(0); PG8_BAR; PG8_MMA(1, 0, At, B0); PG8_MMA(1, 1, At, B1); PG8_BAR; PG8_SCHED;
            PG8_LDB(B0, 1, 0); PG8_LDB(B1, 1, 1); PG8_SCHED; PG8_LDA(At, 1, 0); PG8_STAGE(PG8_SA(0, 1), a2 + hstepA, voffA);
            PG8_WAIT_V(8); PG8_WAIT_L(0); PG8_BAR; PG8_MMA(0, 0, At, B0); PG8_MMA(0, 1, At, B1); PG8_BAR; PG8_SCHED;
            PG8_LDA(At, 1, 1); PG8_STAGE(PG8_SB(1, 0), b3, voffB); PG8_STAGE(PG8_SB(1, 1), b3 + hstepB, voffB); PG8_STAGE(PG8_SA(1, 0), a3, voffA);
            PG8_WAIT_V(8); PG8_WAIT_L(0); PG8_BAR; PG8_MMA(1, 0, At, B0); PG8_MMA(1, 1, At, B1); PG8_BAR; PG8_SCHED;
            } else {
            PG8_LDB(B0, 0, 0); PG8_SCHED; PG8_LDA(At, 0, 0); PG8_STAGE(PG8_SA(1, 1), a1 + hstepA, voffA);
            PG8_WAIT_L(8); PG8_BAR; PG8_WAIT_L(0); PG8_MMA(0, 0, At, B0); PG8_BAR; PG8_SCHED;
            PG8_LDB(B1, 0, 1); PG8_STAGE(PG8_SB(0, 0), b2, voffB);
            PG8_BAR; PG8_WAIT_L(0); PG8_MMA(0, 1, At, B1); PG8_BAR;
            PG8_LDA(At, 0, 1); PG8_STAGE(PG8_SA(0, 0), a2, voffA);
            PG8_BAR; PG8_WAIT_L(0); PG8_MMA(1, 0, At, B0); PG8_BAR; PG8_SCHED;
            PG8_STAGE(PG8_SB(0, 1), b2 + hstepB, voffB);
            PG8_WAIT_V(6); PG8_BAR; PG8_MMA(1, 1, At, B1); PG8_BAR;
            PG8_LDB(B0, 1, 0); PG8_SCHED; PG8_LDA(At, 1, 0); PG8_STAGE(PG8_SA(0, 1), a2 + hstepA, voffA);
            PG8_WAIT_L(8); PG8_BAR; PG8_WAIT_L(0); PG8_MMA(0, 0, At, B0); PG8_BAR; PG8_SCHED;
            PG8_LDB(B1, 1, 1); PG8_STAGE(PG8_SB(1, 0), b3, voffB);
            PG8_BAR; PG8_WAIT_L(0); PG8_MMA(0, 1, At, B1); PG8_BAR;
            PG8_LDA(At, 1, 1); PG8_STAGE(PG8_SA(1, 0), a3, voffA);
            PG8_BAR; PG8_WAIT_L(0); PG8_MMA(1, 0, At, B0); PG8_BAR; PG8_SCHED;
            PG8_STAGE(PG8_SB(1, 1), b3 + hstepB, voffB);
            PG8_WAIT_V(6); PG8_BAR; PG8_MMA(1, 1, At, B1); PG8_BAR;
            }
        }
        if constexpr (ALIGN_EPI) { if (wr == 0) PG8_BAR; }
        if constexpr (!Epi::AFTER_DRAIN) { E(acc, cur, wr, wc, fr, fq); S.done(cur); }
        if (!has_next) break;
#pragma unroll
        for (int a = 0; a < 2; ++a)
#pragma unroll
            for (int b = 0; b < 2; ++b)
#pragma unroll
                for (int m = 0; m < 4; ++m)
#pragma unroll
                    for (int n = 0; n < 2; ++n) acc[a][b][m][n] = (f32x4){0.f, 0.f, 0.f, 0.f};
        cur = nxt; cA = nA; cB = nB; ++ui;
        if constexpr (ALIGN_EPI) { if (wr == 1) PG8_BAR; }
    }
    PG8_WAIT_V(0);
    if constexpr (!ALIGN_EPI) { if (wr == 0) PG8_BAR; }
    PG8_BAR;
    if constexpr (Epi::AFTER_DRAIN) { E.fused(acc, cur, wr, wc, fr, fq, lds, wid, lane); S.done(cur); }
#undef PG8_SA
#undef PG8_SB
#undef PG8_STAGE
#undef PG8_LDA
#undef PG8_LDB
#undef PG8_MMA
#undef PG8_WAIT_V
#undef PG8_WAIT_L
#undef PG8_BAR
#undef PG8_SCHED
}
}

using pg8::bf16_t; using pg8::f32x4; using pg8::u32x4; using pg8::Unit; using pg8::cvt_pk_bf16;
constexpr int D = 1024, NBATCH = 8, SEQ = 2048, MP = NBATCH * SEQ, MS = 128, MV = MP + MS  , MALL = MP + 256  ;
constexpr int NIN = 7168, DFF = 2816, NUP = 2 * DFF, PD = 256;
constexpr float EPS = 1e-6f;
constexpr int LDS_BYTES = 131072;

constexpr size_t O_Y = 0;
constexpr size_t O_CAP = (size_t)MV * D;
constexpr size_t O_CAS = O_CAP + (size_t)NBATCH * 2 * D;
constexpr size_t O_CVP = O_CAS + (size_t)MS * 2 * D;
constexpr size_t O_CVS = O_CVP + (size_t)NBATCH * 128 * D;
constexpr size_t O_CFP = O_CVS + (size_t)MS * D;
constexpr size_t O_CFS = O_CFP + (size_t)NBATCH * 2 * NUP;
constexpr size_t O_END = O_CFS + (size_t)MS * 2 * NUP;

struct Ptrs {
    const float *x_p, *x_s, *p_p, *p_s, *st_a, *st_f, *g_mix, *w_in, *w_conv_a, *w_out_a, *g_v, *w_sp, *b_sp, *w_out_b, *w_o, *g_ffn, *w_up, *w_conv_f, *w_down, *g_ple, *w_pg, *w_ple, *g_final;
    float* out; unsigned char* ws;
};
constexpr size_t MiB = 1u << 20;
constexpr size_t WS_WUP = 0, WS_WDOWN = 11 * MiB, WS_WPG = 16 * MiB + MiB / 2, WS_WPLE = 18 * MiB + MiB / 2;
constexpr size_t WS_SMALL = 19 * MiB, WS_CTL = WS_SMALL, CTL_BYTES = 65536;
constexpr size_t WS_RSTD0 = WS_SMALL + 65536, WS_VSSQS = WS_RSTD0 + 131072, WS_SSQ1S = WS_VSSQS + 16384, WS_SSQ2S = WS_SSQ1S + 16384, WS_T1S = WS_SSQ2S + 16384, WS_PES = WS_T1S + 524288;
constexpr size_t WS_VSSQ = 20 * MiB + MiB / 2, WS_SSQ1 = 21 * MiB + 3 * MiB / 4, WS_SSQ2 = 23 * MiB;
constexpr size_t WS_PB = 24 * MiB + MiB / 2;
constexpr size_t WS_WIN = 33 * MiB, WS_WOA = 47 * MiB, WS_WOB = 49 * MiB, WS_WO = 51 * MiB;
constexpr size_t WS_XB = 53 * MiB, WS_CA = 86 * MiB, WS_VP = WS_CA + 65 * MiB / 2, WS_BA = 151 * MiB, WS_UU = 184 * MiB, WS_SGA = 217 * MiB;
constexpr size_t WS_H1B = 222 * MiB, WS_UPH = 33 * MiB, WS_A3 = 123 * MiB, WS_H2B = 33 * MiB, WS_PE = 123 * MiB;


typedef const Ptrs __attribute__((address_space(4)))* KPtr;
__device__ __forceinline__ KPtr kargs() { KPtr p = (KPtr)__builtin_amdgcn_kernarg_segment_ptr(); asm volatile("" : "+s"(p)); return p; }
struct Ctx { unsigned char* ws; float* out; };
#define WSP(T, off) ((T*)(c.ws + (off)))
__device__ __forceinline__ float gelu_tanh(float x) {
    const float t = x * x;
    const float u2 = x * (2.3022082f + 0.10294324f * t);
    const float e = __builtin_amdgcn_exp2f(-u2);
    return x * __builtin_amdgcn_rcpf(1.0f + e);
}
__device__ __forceinline__ float sigmoid_f(float x) { return __builtin_amdgcn_rcpf(1.0f + __builtin_amdgcn_exp2f(-1.4426950409f * x)); }
__device__ __forceinline__ float bf2f(unsigned short b) { return __uint_as_float(((unsigned)b) << 16); }
__device__ __forceinline__ void store8_bf16(bf16_t* p, f32x4 v0, f32x4 v1) {
    u32x4 w; w.x = cvt_pk_bf16(v0[0], v0[1]); w.y = cvt_pk_bf16(v0[2], v0[3]); w.z = cvt_pk_bf16(v1[0], v1[1]); w.w = cvt_pk_bf16(v1[2], v1[3]);
    *(u32x4*)p = w;
}
__device__ __forceinline__ void load8_bf16(const bf16_t* p, f32x4& v0, f32x4& v1) {
    const u32x4 w = *(const u32x4*)p;
    v0 = (f32x4){__uint_as_float(w.x << 16), __uint_as_float(w.x & 0xffff0000u), __uint_as_float(w.y << 16), __uint_as_float(w.y & 0xffff0000u)};
    v1 = (f32x4){__uint_as_float(w.z << 16), __uint_as_float(w.z & 0xffff0000u), __uint_as_float(w.w << 16), __uint_as_float(w.w & 0xffff0000u)};
}
__device__ __forceinline__ float sum4sq(f32x4 v) { return (v[0] * v[0] + v[1] * v[1]) + (v[2] * v[2] + v[3] * v[3]); }

__device__ __forceinline__ float row_rstd16(const float* ssq, int r, int fq) {
    const f32x4 a = *(const f32x4*)(ssq + (size_t)r * 16 + 4 * fq);
    float s = (a[0] + a[1]) + (a[2] + a[3]); s += __shfl_xor(s, 16); s += __shfl_xor(s, 32);
    return 1.0f / sqrtf(s * (1.0f / D) + EPS);
}
#define EPI_ROW(ai, m) (u.pm * 256 + (ai) * 128 + wr * 64 + (m) * 16 + fr)
typedef const f32x4 (&AccRef)[2][2][4][2];

struct EpiIn {
    static constexpr bool AFTER_DRAIN = false;
    Ctx c;
    __device__ __forceinline__ void operator()(AccRef acc, const Unit& u, int wr, int wc, int fr, int fq) const {
        const float* rstd0 = WSP(const float, WS_RSTD0); bf16_t* ca = WSP(bf16_t, WS_CA); bf16_t* ba = WSP(bf16_t, WS_BA); bf16_t* uu = WSP(bf16_t, WS_UU); bf16_t* vp = WSP(bf16_t, WS_VP);
        bf16_t* sga = WSP(bf16_t, WS_SGA); bf16_t* sgb = (bf16_t*)c.out; float* vssq = WSP(float, WS_VSSQ); float* out = c.out;
        const int tile = u.pn, hc = wc * 32 + 8 * fq;
        if (tile < 8) {
#pragma unroll
            for (int ai = 0; ai < 2; ++ai)
#pragma unroll
                for (int m = 0; m < 4; ++m) {
                    const int r = EPI_ROW(ai, m); const float rs = rstd0[r];
                    const f32x4 p0 = (acc[ai][0][m][0] * rs) * (acc[ai][1][m][0] * rs), p1 = (acc[ai][0][m][1] * rs) * (acc[ai][1][m][1] * rs);
                    store8_bf16(ca + (size_t)r * D + 128 * tile + hc, p0, p1);
                    if (r < MP) { const int t = r & (SEQ - 1); if (t >= SEQ - 2) { float* o = out + O_CAP + ((size_t)((r >> 11) * 2 + (t - (SEQ - 2)))) * D + 128 * tile + hc; *(f32x4*)o = p0; *(f32x4*)(o + 4) = p1; } }
                    else if (r < MV) { float* o = out + O_CAS + ((size_t)((r - MP) * 2 + 1)) * D + 128 * tile + hc; *(f32x4*)o = p0; *(f32x4*)(o + 4) = p1; }
                }
        } else {
            const int type = (tile - 8) >> 2, tl = (tile - 8) & 3;
            bf16_t* dst = type == 0 ? ba : type == 1 ? uu : type == 2 ? vp : type == 3 ? sga : sgb;
            dst += 256 * tl + hc;
            if (type == 0) {
#pragma unroll
                for (int ai = 0; ai < 2; ++ai)
#pragma unroll
                    for (int m = 0; m < 4; ++m) { const int r = EPI_ROW(ai, m); const float rs = rstd0[r];
#pragma unroll
                        for (int bj = 0; bj < 2; ++bj) store8_bf16(dst + (size_t)r * D + 128 * bj, acc[ai][bj][m][0] * rs, acc[ai][bj][m][1] * rs); }
            } else if (type <= 2) {
#pragma unroll
                for (int ai = 0; ai < 2; ++ai)
#pragma unroll
                    for (int m = 0; m < 4; ++m) { const int r = EPI_ROW(ai, m); const float rs = rstd0[r]; float s = 0.f;
#pragma unroll
                        for (int bj = 0; bj < 2; ++bj) { f32x4 v0 = acc[ai][bj][m][0] * rs, v1 = acc[ai][bj][m][1] * rs;
#pragma unroll
                            for (int j = 0; j < 4; ++j) { v0[j] = gelu_tanh(v0[j]); v1[j] = gelu_tanh(v1[j]); }
                            s += sum4sq(v0) + sum4sq(v1);
                            store8_bf16(dst + (size_t)r * D + 128 * bj, v0, v1); }
                        if (type == 2) { s += __shfl_xor(s, 16); s += __shfl_xor(s, 32); if (fq == 0) vssq[(size_t)r * 16 + tl * 4 + wc] = s; } }
            } else {
#pragma unroll
                for (int ai = 0; ai < 2; ++ai)
#pragma unroll
                    for (int m = 0; m < 4; ++m) { const int r = EPI_ROW(ai, m); const float rs = rstd0[r];
#pragma unroll
                        for (int bj = 0; bj < 2; ++bj) { f32x4 v0 = acc[ai][bj][m][0] * rs, v1 = acc[ai][bj][m][1] * rs;
#pragma unroll
                            for (int j = 0; j < 4; ++j) { v0[j] = sigmoid_f(v0[j]); v1[j] = sigmoid_f(v1[j]); }
                            store8_bf16(dst + (size_t)r * D + 128 * bj, v0, v1); } }
            }
        }
    }
};
struct EpiYa {
    static constexpr bool AFTER_DRAIN = false;
    Ctx c;
    __device__ __forceinline__ void operator()(AccRef acc, const Unit& u, int wr, int wc, int fr, int fq) const {
        const bf16_t* sga = WSP(const bf16_t, WS_SGA); float* t1 = WSP(float, WS_CA);
        const int hc = u.pn * 256 + wc * 32 + 8 * fq;
#pragma unroll
        for (int ai = 0; ai < 2; ++ai)
#pragma unroll
            for (int m = 0; m < 4; ++m) { const int r = EPI_ROW(ai, m);
#pragma unroll
                for (int bj = 0; bj < 2; ++bj) { const size_t o = (size_t)r * D + hc + 128 * bj; f32x4 g0, g1; load8_bf16(sga + o, g0, g1);
                    *(f32x4*)(t1 + o) = g0 * acc[ai][bj][m][0]; *(f32x4*)(t1 + o + 4) = g1 * acc[ai][bj][m][1]; } }
    }
};
struct EpiYb {
    static constexpr bool AFTER_DRAIN = false;
    Ctx c;
    __device__ __forceinline__ void operator()(AccRef acc, const Unit& u, int wr, int wc, int fr, int fq) const {
        const bf16_t* sgb = (const bf16_t*)c.out; const float* t1 = WSP(const float, WS_CA); bf16_t* mm = WSP(bf16_t, WS_XB);
        const int hc = u.pn * 256 + wc * 32 + 8 * fq;
#pragma unroll
        for (int ai = 0; ai < 2; ++ai)
#pragma unroll
            for (int m = 0; m < 4; ++m) { const int r = EPI_ROW(ai, m);
#pragma unroll
                for (int bj = 0; bj < 2; ++bj) { const size_t o = (size_t)r * D + hc + 128 * bj; f32x4 g0, g1; load8_bf16(sgb + o, g0, g1);
                    const f32x4 a0 = *(const f32x4*)(t1 + o), a1 = *(const f32x4*)(t1 + o + 4);
                    store8_bf16(mm + o, a0 + g0 * acc[ai][bj][m][0], a1 + g1 * acc[ai][bj][m][1]); } }
    }
};
template <int SRC> struct EpiRes {
    static constexpr bool AFTER_DRAIN = false;
    Ctx c;
    __device__ __forceinline__ void operator()(AccRef acc, const Unit& u, int wr, int wc, int fr, int fq) const {
        const KPtr kp = kargs(); const float* xp = kp->x_p; const float* xs = kp->x_s; float* h = c.out; bf16_t* hb = WSP(bf16_t, SRC == 0 ? WS_H1B : WS_H2B); float* ssq = WSP(float, SRC == 0 ? WS_SSQ1 : WS_SSQ2);
        const int hc = u.pn * 256 + wc * 32 + 8 * fq;
#pragma unroll
        for (int ai = 0; ai < 2; ++ai)
#pragma unroll
            for (int m = 0; m < 4; ++m) { const int r = EPI_ROW(ai, m); float s = 0.f; const bool valid = r < MV;
                const float* base = SRC == 1 ? h + (size_t)r * D : (r < MP ? xp + (size_t)r * D : xs + (size_t)(r - MP) * D);
#pragma unroll
                for (int bj = 0; bj < 2; ++bj) { const int c = hc + 128 * bj;
                    f32x4 b0 = (f32x4){0.f, 0.f, 0.f, 0.f}, b1 = b0; if (valid) { b0 = *(const f32x4*)(base + c); b1 = *(const f32x4*)(base + c + 4); }
                    const f32x4 v0 = b0 + acc[ai][bj][m][0], v1 = b1 + acc[ai][bj][m][1];
                    if (valid) { *(f32x4*)(h + (size_t)r * D + c) = v0; *(f32x4*)(h + (size_t)r * D + c + 4) = v1; }
                    store8_bf16(hb + (size_t)r * D + c, v0, v1);
                    s += sum4sq(v0) + sum4sq(v1); }
                s += __shfl_xor(s, 16); s += __shfl_xor(s, 32); if (fq == 0) ssq[(size_t)r * 16 + u.pn * 4 + wc] = s; }
    }
};
struct EpiUp {
    static constexpr bool AFTER_DRAIN = false;
    Ctx c; int half; int pad;
    __device__ __forceinline__ void operator()(AccRef acc, const Unit& u, int wr, int wc, int fr, int fq) const {
        const float* ssq1 = WSP(const float, WS_SSQ1); bf16_t* uph = WSP(bf16_t, WS_UPH); float* out = c.out;
        const int hc = wc * 32 + 8 * fq;
#pragma unroll
        for (int ai = 0; ai < 2; ++ai)
#pragma unroll
            for (int m = 0; m < 4; ++m) { const int r = EPI_ROW(ai, m); const float rs = row_rstd16(ssq1, r, fq);
#pragma unroll
                for (int bj = 0; bj < 2; ++bj) { const f32x4 v0 = acc[ai][bj][m][0] * rs, v1 = acc[ai][bj][m][1] * rs;
                    store8_bf16(uph + (size_t)r * DFF + 256 * u.pn + 128 * bj + hc, v0, v1);
                    const int col = (bj ? DFF : 0) + 1408 * half + 128 * u.pn + hc;
                    if (r < MP) { const int t = r & (SEQ - 1); if (t >= SEQ - 2) { float* o = out + O_CFP + ((size_t)((r >> 11) * 2 + (t - (SEQ - 2)))) * NUP + col; *(f32x4*)o = v0; *(f32x4*)(o + 4) = v1; } }
                    else if (r < MV) { float* o = out + O_CFS + ((size_t)((r - MP) * 2 + 1)) * NUP + col; *(f32x4*)o = v0; *(f32x4*)(o + 4) = v1; } } }
    }
};
struct EpiPe {
    static constexpr bool AFTER_DRAIN = false;
    Ctx c;
    __device__ __forceinline__ void operator()(AccRef acc, const Unit& u, int wr, int wc, int fr, int fq) const {
        float* pe = WSP(float, WS_PE);
        const int hc = u.pn * 256 + wc * 32 + 8 * fq;
#pragma unroll
        for (int ai = 0; ai < 2; ++ai)
#pragma unroll
            for (int m = 0; m < 4; ++m) { const int r = EPI_ROW(ai, m);
#pragma unroll
                for (int bj = 0; bj < 2; ++bj) { const size_t o = (size_t)r * D + hc + 128 * bj; *(f32x4*)(pe + o) = acc[ai][bj][m][0]; *(f32x4*)(pe + o + 4) = acc[ai][bj][m][1]; } }
    }
};
struct EpiGate {
    static constexpr bool AFTER_DRAIN = false;
    Ctx c;
    __device__ __forceinline__ void operator()(AccRef acc, const Unit& u, int wr, int wc, int fr, int fq) const {
        const float* ssq2 = WSP(const float, WS_SSQ2); const float* pe = WSP(const float, WS_PE); float* h = c.out;
        const int hc = u.pn * 256 + wc * 32 + 8 * fq;
#pragma unroll
        for (int ai = 0; ai < 2; ++ai)
#pragma unroll
            for (int m = 0; m < 4; ++m) { const int r = EPI_ROW(ai, m); const float rs = row_rstd16(ssq2, r, fq);
#pragma unroll
                for (int bj = 0; bj < 2; ++bj) { const size_t o = (size_t)r * D + hc + 128 * bj;
                    f32x4 g0 = acc[ai][bj][m][0] * rs, g1 = acc[ai][bj][m][1] * rs;
#pragma unroll
                    for (int j = 0; j < 4; ++j) { g0[j] = sigmoid_f(g0[j]); g1[j] = sigmoid_f(g1[j]); }
                    const f32x4 p0 = *(const f32x4*)(pe + o), p1 = *(const f32x4*)(pe + o + 4);
                    const f32x4 h0 = *(const f32x4*)(h + o), h1 = *(const f32x4*)(h + o + 4);
                    *(f32x4*)(h + o) = h0 + g0 * p0; *(f32x4*)(h + o + 4) = h1 + g1 * p1; } }
    }
};


#define LAS __attribute__((address_space(3)))
typedef pg8::bf16x8 bf16x8;
constexpr int LDS_STAGE = 131072, LDS_XTRA_OFF = LDS_STAGE, LDS_XTRA = 8192, LDS_CTL_OFF = LDS_STAGE + LDS_XTRA, LDS_TOTAL = 147456;
#define BLK_BAR() do { asm volatile("s_waitcnt lgkmcnt(0)" ::: "memory"); __builtin_amdgcn_s_barrier(); asm volatile("" ::: "memory"); } while (0)

#define XB_TMO      128
#define XB_XCNT(j)  (256  + 64 * (j))
#define XB_XSUB(j)  (1280 + 64 * (j))
#define XB_XGEN(j)  (2304 + 64 * (j))
#define XB_TOP      3328
#define XB_TOPGEN   3392
#define XCD_BAR_WORDS 3456
#define XB_SPIN_CAP (1u << 18)

__device__ __forceinline__ unsigned xb_ld(unsigned* p)              { return __hip_atomic_load(p, __ATOMIC_RELAXED, __HIP_MEMORY_SCOPE_AGENT); }
__device__ __forceinline__ unsigned xb_add(unsigned* p, unsigned v) { return __hip_atomic_fetch_add(p, v, __ATOMIC_RELAXED, __HIP_MEMORY_SCOPE_AGENT); }
__device__ __forceinline__ unsigned xb_xcc_id() { return (unsigned)__builtin_amdgcn_s_getreg((3 << 11) | 20) & 0xFu; }
#define XB_SPIN(cond, bar) do { unsigned _sp = 0; while (cond) { __builtin_amdgcn_s_sleep(1); \
    if ((++_sp & 255u) == 0u) { if (xb_ld(&(bar)[XB_TMO])) break; if (_sp > XB_SPIN_CAP) { atomicAdd(&(bar)[XB_TMO], 1u); break; } } } } while (0)

struct XcdBarrier {
    unsigned* bar; unsigned x;
    volatile LAS unsigned* st;
};

__device__ __forceinline__ XcdBarrier xcd_barrier_post(unsigned* bar, volatile LAS unsigned* st) {
    XcdBarrier b; b.bar = bar; b.x = xb_xcc_id(); b.st = st;
    if (threadIdx.x == 0) (void)xb_add(&bar[XB_XCNT(b.x)], 1u);
    return b;
}
__device__ __forceinline__ void xcd_barrier_complete(unsigned* bar, unsigned x, unsigned& nloc, unsigned& nx) {
    const unsigned G = gridDim.x * gridDim.y * gridDim.z;
    unsigned sum, cnt, mine, sp = 0u;
    for (;;) {
        sum = 0u; cnt = 0u; mine = 0u;
#pragma unroll
        for (unsigned j = 0; j < 16; ++j) { const unsigned c = xb_ld(&bar[XB_XCNT(j)]); sum += c; cnt += (c > 0u) ? 1u : 0u; mine = (j == x) ? c : mine; }
        if (sum == G) break;
        __builtin_amdgcn_s_sleep(1);
        if ((++sp & 255u) == 0u) { if (xb_ld(&bar[XB_TMO])) break; if (sp > XB_SPIN_CAP) { atomicAdd(&bar[XB_TMO], 1u); break; } }
    }
    nloc = mine > 0u ? mine : 1u; nx = cnt > 0u ? cnt : 1u;
}

__device__ __forceinline__ void xcd_barrier(const XcdBarrier& b) {
    asm volatile("s_waitcnt vmcnt(0)" ::: "memory");
    __syncthreads();
    if (threadIdx.x == 0) {
        unsigned* bar = b.bar;
        __builtin_amdgcn_s_waitcnt(0);
        unsigned nloc = b.st[0], nx = b.st[1];
        if (nloc == 0u) { xcd_barrier_complete(bar, b.x, nloc, nx); b.st[0] = nloc; b.st[1] = nx; }
        const unsigned old = xb_add(&bar[XB_XSUB(b.x)], 1u);
        const unsigned gen = old / nloc;
        if (old + 1u == (gen + 1u) * nloc) {
            __builtin_amdgcn_fence(__ATOMIC_RELEASE, "agent");
            asm volatile("s_waitcnt vmcnt(0)" ::: "memory");
            const unsigned og = xb_add(&bar[XB_TOP], 1u);
            const unsigned tg = og / nx;
            if (og + 1u == (tg + 1u) * nx) xb_add(&bar[XB_TOPGEN], 1u);
            else XB_SPIN(xb_ld(&bar[XB_TOPGEN]) == tg, bar);
            __builtin_amdgcn_fence(__ATOMIC_ACQUIRE, "agent");
            xb_add(&bar[XB_XGEN(b.x)], 1u);
            asm volatile("s_waitcnt vmcnt(0)" ::: "memory");
        } else {
            XB_SPIN(xb_ld(&bar[XB_XGEN(b.x)]) == gen, bar);
            __builtin_amdgcn_fence(__ATOMIC_ACQUIRE, "agent");
            asm volatile("s_waitcnt vmcnt(0)" ::: "memory");
        }
    }
    __syncthreads();
}


__device__ __forceinline__ float wave_sum(float v) {
#pragma unroll
    for (int o = 1; o < 64; o <<= 1) v += __shfl_xor(v, o);
    return v;
}
__device__ __forceinline__ bf16_t f2bf(float x) { return (bf16_t)(cvt_pk_bf16(x, 0.f) & 0xffffu); }

__device__ __forceinline__ int colmap(int mode, int R) {
    const int hc = (R & 96) + pg8::perm32(R & 31);
    const int bj = (R >> 7) & 1, tile = R >> 8;
    if (mode == 0) return (R & ~127) + hc;
    if (mode == 1) { if (tile < 8) return (bj ? 2048 : 0) + 128 * tile + hc;
        const int type = (tile - 8) >> 2, tl = (tile - 8) & 3; const int base = type == 0 ? 1024 : type == 1 ? 3072 : type == 2 ? 4096 : type == 3 ? 5120 : 6144;
        return base + 256 * tl + 128 * bj + hc; }
    return (bj ? DFF : 0) + 128 * tile + hc;
}

template <int RT, int NG, class F>
__device__ __forceinline__ void sample_item(LAS unsigned char* lds, const bf16_t* A, int lda, int rt0, const bf16_t* Bt, int ldb, const int (&gr)[NG], int K, const F& f) {
    static_assert(8 * RT * NG * 1024 <= LDS_STAGE, "sample_item: the eight partial tiles must fit the stage region");
    int tid_ = threadIdx.x; asm volatile("" : "+v"(tid_));
    const int tid = tid_, w = __builtin_amdgcn_readfirstlane(tid >> 6), lane = tid & 63, fr = lane & 15, fq = lane >> 4;
    const int kper = K >> 3, nks = kper >> 5;
    f32x4 acc[RT][NG];
#pragma unroll
    for (int rt = 0; rt < RT; ++rt)
#pragma unroll
        for (int g = 0; g < NG; ++g) acc[rt][g] = (f32x4){0.f, 0.f, 0.f, 0.f};
    const bf16_t* ap = A + (size_t)(16 * rt0 + fr) * lda + w * kper + 8 * fq;
    const bf16_t* bp[NG];
#pragma unroll
    for (int g = 0; g < NG; ++g) bp[g] = Bt + (size_t)(gr[g] + fr) * ldb + w * kper + 8 * fq;
#pragma unroll 2
    for (int ks = 0; ks < nks; ++ks) {
        bf16x8 a[RT], b[NG];
#pragma unroll
        for (int rt = 0; rt < RT; ++rt) a[rt] = *(const bf16x8*)(ap + (size_t)(16 * rt) * lda + 32 * ks);
#pragma unroll
        for (int g = 0; g < NG; ++g) b[g] = *(const bf16x8*)(bp[g] + 32 * ks);
#pragma unroll
        for (int rt = 0; rt < RT; ++rt)
#pragma unroll
            for (int g = 0; g < NG; ++g) acc[rt][g] = __builtin_amdgcn_mfma_f32_16x16x32_bf16(b[g], a[rt], acc[rt][g], 0, 0, 0);
    }
    LAS float* P = (LAS float*)lds;
#pragma unroll
    for (int rt = 0; rt < RT; ++rt)
#pragma unroll
        for (int g = 0; g < NG; ++g) *(LAS f32x4*)(P + ((w * RT + rt) * NG + g) * 256 + fr * 16 + 4 * fq) = acc[rt][g];
    BLK_BAR();
#pragma unroll
    for (int q = 0; q < RT * 256 / 512; ++q) {
        const int e = tid + 512 * q, rt = e >> 8, rc = e & 255;
        float v[NG];
#pragma unroll
        for (int g = 0; g < NG; ++g) { float s = 0.f;
#pragma unroll
            for (int w8 = 0; w8 < 8; ++w8) s += P[((w8 * RT + rt) * NG + g) * 256 + rc];
            v[g] = s; }
        f(16 * (rt0 + rt) + (rc >> 4), rc & 15, v);
    }
    BLK_BAR();
}
__device__ __forceinline__ float grp16_sum(float s) {
    s += __shfl_xor(s, 1); s += __shfl_xor(s, 2); s += __shfl_xor(s, 4); s += __shfl_xor(s, 8); return s;
}
__device__ __forceinline__ void sample_rstd_table(LAS float* tab, const float* ssq_s) {
    const int tid = threadIdx.x;
    if (tid < MS) { const f32x4* p = (const f32x4*)(ssq_s + (size_t)tid * 32); float s = 0.f;
#pragma unroll
        for (int q = 0; q < 8; ++q) { const f32x4 a = p[q]; s += (a[0] + a[1]) + (a[2] + a[3]); }
        tab[tid] = 1.0f / sqrtf(s * (1.0f / D) + EPS); }
    BLK_BAR();
}

struct SfInA {
    Ctx cx; int R0;
    __device__ __forceinline__ void operator()(int i, int c, const float (&v)[3]) const {
        const KPtr kp = kargs(); const float* rstd0 = (const float*)(cx.ws + WS_RSTD0); const float* wca = kp->w_conv_a; const float* sa = kp->st_a; bf16_t* ba = (bf16_t*)(cx.ws + WS_BA); float* out = cx.out;
        const int ch = colmap(1, R0 + c); const float rs = rstd0[MP + i];
        const float cav = (v[0] * rs) * (v[1] * rs), bb = v[2] * rs;
        out[O_CAS + (size_t)(i * 2 + 1) * D + ch] = cav;
        const float conv = wca[ch] * sa[(size_t)(i * 2) * D + ch] + wca[D + ch] * sa[(size_t)(i * 2 + 1) * D + ch] + wca[2 * D + ch] * cav;
        ba[(size_t)(MP + i) * D + ch] = f2bf(bb * conv);
    }
};
struct SfInB {
    Ctx cx; int R0, type, slot;
    __device__ __forceinline__ void operator()(int i, int c, const float (&v)[2]) const {
        const float* rstd0 = (const float*)(cx.ws + WS_RSTD0); float* vssq_s = (float*)(cx.ws + WS_VSSQS);
        bf16_t* dst = type == 0 ? (bf16_t*)(cx.ws + WS_UU) : type == 1 ? (bf16_t*)(cx.ws + WS_VP) : type == 2 ? (bf16_t*)(cx.ws + WS_SGA) : (bf16_t*)cx.out;
        const int base = type == 0 ? 3072 : type == 1 ? 4096 : type == 2 ? 5120 : 6144;
        const float rs = rstd0[MP + i]; float s = 0.f;
#pragma unroll
        for (int g = 0; g < 2; ++g) { const int col = colmap(1, R0 + 16 * g + c) - base; float x = v[g] * rs;
            x = type <= 1 ? gelu_tanh(x) : sigmoid_f(x); s += x * x;
            dst[(size_t)(MP + i) * D + col] = f2bf(x); }
        if (type == 1) { s = grp16_sum(s); if (c == 0) vssq_s[i * 32 + slot] = s; }
    }
};
struct SfYa { Ctx cx; int R0;
    __device__ __forceinline__ void operator()(int i, int c, const float (&v)[2]) const {
        const bf16_t* sga = (const bf16_t*)(cx.ws + WS_SGA); float* t1s = (float*)(cx.ws + WS_T1S);
#pragma unroll
        for (int g = 0; g < 2; ++g) { const int col = colmap(0, R0 + 16 * g + c); t1s[i * D + col] = bf2f(sga[(size_t)(MP + i) * D + col]) * v[g]; }
    }
};
struct SfYb { Ctx cx; int R0;
    __device__ __forceinline__ void operator()(int i, int c, const float (&v)[2]) const {
        const bf16_t* sgb = (const bf16_t*)cx.out; const float* t1s = (const float*)(cx.ws + WS_T1S); bf16_t* mm = (bf16_t*)(cx.ws + WS_XB);
#pragma unroll
        for (int g = 0; g < 2; ++g) { const int col = colmap(0, R0 + 16 * g + c); mm[(size_t)(MP + i) * D + col] = f2bf(t1s[i * D + col] + bf2f(sgb[(size_t)(MP + i) * D + col]) * v[g]); }
    }
};
struct SfRes {
    Ctx cx; int R0, slot, which;
    __device__ __forceinline__ void operator()(int i, int c, const float (&v)[2]) const {
        float* h = cx.out; const float* base = which == 0 ? kargs()->x_s : h + (size_t)MP * D; bf16_t* hb = (bf16_t*)(cx.ws + (which == 0 ? WS_H1B : WS_H2B)); float* ssq_s = (float*)(cx.ws + (which == 0 ? WS_SSQ1S : WS_SSQ2S));
        float s = 0.f;
#pragma unroll
        for (int g = 0; g < 2; ++g) { const int col = colmap(0, R0 + 16 * g + c); const float x = base[(size_t)i * D + col] + v[g];
            h[(size_t)(MP + i) * D + col] = x; hb[(size_t)(MP + i) * D + col] = f2bf(x); s += x * x; }
        s = grp16_sum(s); if (c == 0) ssq_s[i * 32 + slot] = s;
    }
};
struct SfUp {
    Ctx cx; const LAS float* rs; int R0;
    __device__ __forceinline__ void operator()(int i, int c, const float (&v)[2]) const {
        const KPtr kp = kargs(); const float* wcf = kp->w_conv_f; const float* sf = kp->st_f; bf16_t* a3 = (bf16_t*)(cx.ws + WS_A3); float* out = cx.out;
        const int ja = colmap(2, R0 + c), jb = ja + DFF; const float r = rs[i];
        const float ua = v[0] * r, ub = v[1] * r;
        float* o = out + O_CFS + (size_t)(i * 2 + 1) * NUP; o[ja] = ua; o[jb] = ub;
        const float* s0 = sf + (size_t)(i * 2) * NUP; const float* s1 = s0 + NUP;
        const float ca = wcf[ja] * s0[ja] + wcf[NUP + ja] * s1[ja] + wcf[2 * NUP + ja] * ua;
        const float cb = wcf[jb] * s0[jb] + wcf[NUP + jb] * s1[jb] + wcf[2 * NUP + jb] * ub;
        a3[(size_t)(MP + i) * DFF + ja] = f2bf(gelu_tanh(ca) * cb);
    }
};
struct SfPe { Ctx cx; int R0;
    __device__ __forceinline__ void operator()(int i, int c, const float (&v)[2]) const {
        float* pes = (float*)(cx.ws + WS_PES);
#pragma unroll
        for (int g = 0; g < 2; ++g) pes[i * D + colmap(0, R0 + 16 * g + c)] = v[g];
    }
};
struct SfGate { Ctx cx; const LAS float* rs; int R0;
    __device__ __forceinline__ void operator()(int i, int c, const float (&v)[2]) const {
        const float* pes = (const float*)(cx.ws + WS_PES); float* h = cx.out;
        const float r = rs[i];
#pragma unroll
        for (int g = 0; g < 2; ++g) { const int col = colmap(0, R0 + 16 * g + c); float* hp = h + (size_t)(MP + i) * D + col; *hp = *hp + sigmoid_f(r * v[g]) * pes[i * D + col]; }
    }
};

__device__ __forceinline__ void p0_rows(const KPtr P, bf16_t* xb, float* rstd0, bf16_t* pb) {
    const int tid = threadIdx.x, lane = tid & 63, gw = blockIdx.x * 8 + (tid >> 6), NGW = gridDim.x * 8;
    for (int r = gw; r < MV; r += NGW) {
        const f32x4* src = (const f32x4*)(r < MP ? P->x_p + (size_t)r * D : P->x_s + (size_t)(r - MP) * D) + lane;
        f32x4 v[4]; float s = 0.f;
#pragma unroll
        for (int j = 0; j < 4; ++j) { v[j] = src[64 * j]; s += sum4sq(v[j]); }
        s = wave_sum(s);
        if (lane == 0) rstd0[r] = 1.0f / sqrtf(s * (1.0f / D) + EPS);
        unsigned long long* o8 = (unsigned long long*)(xb + (size_t)r * D) + lane;
#pragma unroll
        for (int j = 0; j < 4; ++j) o8[64 * j] = (unsigned long long)cvt_pk_bf16(v[j][0], v[j][1]) | ((unsigned long long)cvt_pk_bf16(v[j][2], v[j][3]) << 32);
    }
    const size_t gt = (size_t)blockIdx.x * 512 + tid, gs = (size_t)gridDim.x * 512;
    for (size_t i4 = gt; i4 < (size_t)MV * PD / 4; i4 += gs) { const size_t i = i4 * 4;
        const f32x4 v = i < (size_t)MP * PD ? *(const f32x4*)(P->p_p + i) : *(const f32x4*)(P->p_s + (i - (size_t)MP * PD));
        *(unsigned long long*)(pb + i) = (unsigned long long)cvt_pk_bf16(v[0], v[1]) | ((unsigned long long)cvt_pk_bf16(v[2], v[3]) << 32); }
    for (size_t e = gt; e < (size_t)MS * (D + NUP); e += gs) { const int i = (int)(e / (D + NUP)), c = (int)(e % (D + NUP));
        if (c < D) P->out[O_CAS + (size_t)(i * 2) * D + c] = P->st_a[(size_t)(i * 2 + 1) * D + c];
        else P->out[O_CFS + (size_t)(i * 2) * NUP + (c - D)] = P->st_f[(size_t)(i * 2 + 1) * NUP + (c - D)]; }
}
__device__ __forceinline__ void wt_tile_load(const float* W, const float* scale, int Nw, int mode, int R0, int k0, LAS float* t, int ht) {
    const int tx = ht & 63, ty = ht >> 6; const int col = colmap(mode, R0 + tx);
#pragma unroll
    for (int i = 0; i < 16; ++i) { const int k = k0 + ty + 4 * i; t[(ty + 4 * i) * 65 + tx] = W[(size_t)k * Nw + col] * (scale ? scale[k] : 1.0f); }
}
__device__ __forceinline__ void wt_tile_store(bf16_t* out, int K, int R0, int k0, const LAS float* t, int ht) {
    const int Rl = ht >> 2, kq = ht & 3; const LAS float* s = t + (kq * 16) * 65 + Rl;
    u32x4 w0, w1;
    w0.x = cvt_pk_bf16(s[0 * 65], s[1 * 65]); w0.y = cvt_pk_bf16(s[2 * 65], s[3 * 65]); w0.z = cvt_pk_bf16(s[4 * 65], s[5 * 65]); w0.w = cvt_pk_bf16(s[6 * 65], s[7 * 65]);
    w1.x = cvt_pk_bf16(s[8 * 65], s[9 * 65]); w1.y = cvt_pk_bf16(s[10 * 65], s[11 * 65]); w1.z = cvt_pk_bf16(s[12 * 65], s[13 * 65]); w1.w = cvt_pk_bf16(s[14 * 65], s[15 * 65]);
    bf16_t* o = out + (size_t)(R0 + Rl) * K + k0 + kq * 16;
    *(u32x4*)o = w0; *(u32x4*)(o + 8) = w1;
}
struct WtJob { const float* W; const float* scale; bf16_t* out; int K, Nw, mode, R0, k0; };
__device__ __forceinline__ bool wt_decode(const KPtr P, unsigned char* ws, int it, WtJob& j) {
    constexpr int T_IN = (NIN / 64) * (D / 64), T_SQ = (D / 64) * (D / 64), T_UP = (NUP / 64) * (D / 64), T_DN = (D / 64) * (DFF / 64), T_PL = (D / 64) * (PD / 64);
    int nk;
    if (it < T_IN) { j.W = P->w_in; j.scale = P->g_mix; j.out = (bf16_t*)(ws + WS_WIN); j.K = D; j.Nw = NIN; j.mode = 1; nk = D / 64; }
    else if ((it -= T_IN) < T_SQ) { j.W = P->w_out_a; j.scale = nullptr; j.out = (bf16_t*)(ws + WS_WOA); j.K = D; j.Nw = D; j.mode = 0; nk = D / 64; }
    else if ((it -= T_SQ) < T_SQ) { j.W = P->w_out_b; j.scale = nullptr; j.out = (bf16_t*)(ws + WS_WOB); j.K = D; j.Nw = D; j.mode = 0; nk = D / 64; }
    else if ((it -= T_SQ) < T_SQ) { j.W = P->w_o; j.scale = nullptr; j.out = (bf16_t*)(ws + WS_WO); j.K = D; j.Nw = D; j.mode = 0; nk = D / 64; }
    else if ((it -= T_SQ) < T_SQ) { j.W = P->w_pg; j.scale = P->g_ple; j.out = (bf16_t*)(ws + WS_WPG); j.K = D; j.Nw = D; j.mode = 0; nk = D / 64; }
    else if ((it -= T_SQ) < T_UP) { j.W = P->w_up; j.scale = P->g_ffn; j.out = (bf16_t*)(ws + WS_WUP); j.K = D; j.Nw = NUP; j.mode = 2; nk = D / 64; }
    else if ((it -= T_UP) < T_DN) { j.W = P->w_down; j.scale = nullptr; j.out = (bf16_t*)(ws + WS_WDOWN); j.K = DFF; j.Nw = D; j.mode = 0; nk = DFF / 64; }
    else if ((it -= T_DN) < T_PL) { j.W = P->w_ple; j.scale = nullptr; j.out = (bf16_t*)(ws + WS_WPLE); j.K = PD; j.Nw = D; j.mode = 0; nk = PD / 64; }
    else return false;
    j.R0 = (it / nk) * 64; j.k0 = (it % nk) * 64; return true;
}
constexpr int WT_TILES = (NIN / 64) * (D / 64) + 4 * (D / 64) * (D / 64) + (NUP / 64) * (D / 64) + (D / 64) * (DFF / 64) + (D / 64) * (PD / 64);
__device__ __forceinline__ void p0_weights(const KPtr P, unsigned char* ws, LAS unsigned char* lds) {
    const int tid = threadIdx.x, half = tid >> 8, ht = tid & 255;
    LAS float* t = (LAS float*)lds + half * (64 * 65);
    for (int base = blockIdx.x * 2; base < WT_TILES; base += gridDim.x * 2) {
        WtJob j; const bool ok = wt_decode(P, ws, base + half, j);
        if (ok) wt_tile_load(j.W, j.scale, j.Nw, j.mode, j.R0, j.k0, t, ht);
        BLK_BAR();
        if (ok) wt_tile_store(j.out, j.K, j.R0, j.k0, t, ht);
        BLK_BAR();
    }
}
__device__ __forceinline__ void p2_convA(const bf16_t* ca, bf16_t* ba, const float* wc) {
    const f32x4 z = (f32x4){0.f, 0.f, 0.f, 0.f};
    for (size_t idx = (size_t)blockIdx.x * 512 + threadIdx.x; idx < (size_t)MP * 128; idx += (size_t)gridDim.x * 512) {
        const int r = (int)(idx >> 7), j = (int)(idx & 127) * 8, t = r & (SEQ - 1);
        f32x4 c0a, c0b, c1a = z, c1b = z, c2a = z, c2b = z;
        load8_bf16(ca + (size_t)r * D + j, c0a, c0b);
        if (t >= 1) load8_bf16(ca + (size_t)(r - 1) * D + j, c1a, c1b);
        if (t >= 2) load8_bf16(ca + (size_t)(r - 2) * D + j, c2a, c2b);
        const f32x4 w0a = *(const f32x4*)(wc + j), w0b = *(const f32x4*)(wc + j + 4), w1a = *(const f32x4*)(wc + D + j), w1b = *(const f32x4*)(wc + D + j + 4),
                    w2a = *(const f32x4*)(wc + 2 * D + j), w2b = *(const f32x4*)(wc + 2 * D + j + 4);
        f32x4 b0, b1; load8_bf16(ba + (size_t)r * D + j, b0, b1);
        store8_bf16(ba + (size_t)r * D + j, b0 * (w0a * c2a + w1a * c1a + w2a * c0a), b1 * (w0b * c2b + w1b * c1b + w2b * c0b));
    }
}
__device__ __forceinline__ unsigned sp_off(unsigned row, unsigned ch) { return 256u * row + 16u * (ch ^ (((row & 3u) << 2) | ((row >> 2) & 3u))); }
typedef unsigned short u16x4_t __attribute__((ext_vector_type(4)));
__device__ __forceinline__ void p2_spatial(const KPtr P, LAS unsigned char* lds, const bf16_t* vp, bf16_t* uu, const float* vssq) {
    int tid_ = threadIdx.x; asm volatile("" : "+v"(tid_));
    const int tid = tid_, w = __builtin_amdgcn_readfirstlane(tid >> 6), lane = tid & 63, fr = lane & 15, fq = lane >> 4;
    LAS unsigned char* Vimg = lds; LAS unsigned char* Wimg = lds + 32768; LAS float* rs = (LAS float*)(lds + 65536);
    const float* gv = P->g_v; const float* wsp = P->w_sp; const float* bsp = P->b_sp; float* out = P->out;
    int g_loaded = -1;
    for (int it = blockIdx.x; it < (MP / 128) * 8; it += gridDim.x) {
        const int g = it & 7, c = it >> 3, r0 = c * 128, d0 = g * 128;
        if (tid < 128) { const f32x4* p = (const f32x4*)(vssq + (size_t)(r0 + tid) * 16); float s = 0.f;
#pragma unroll
            for (int q = 0; q < 4; ++q) { const f32x4 a = p[q]; s += (a[0] + a[1]) + (a[2] + a[3]); }
            rs[tid] = 1.0f / sqrtf(s * (1.0f / D) + EPS); }
        if (g != g_loaded) {
            const float* W = wsp + (size_t)g * 128 * 128;
#pragma unroll
            for (int i = 0; i < 4; ++i) { const int n = tid + 512 * i, t = n >> 4, ch = n & 15, s0 = 8 * ch;
                f32x4 a = *(const f32x4*)(W + t * 128 + s0), b = *(const f32x4*)(W + t * 128 + s0 + 4);
#pragma unroll
                for (int j = 0; j < 4; ++j) { if (s0 + j > t) a[j] = 0.f; if (s0 + 4 + j > t) b[j] = 0.f; }
                u32x4 pk; pk.x = cvt_pk_bf16(a[0], a[1]); pk.y = cvt_pk_bf16(a[2], a[3]); pk.z = cvt_pk_bf16(b[0], b[1]); pk.w = cvt_pk_bf16(b[2], b[3]);
                *(LAS u32x4*)(Wimg + sp_off(t, ch)) = pk; }
            g_loaded = g;
        }
        BLK_BAR();
        const bool last = (c & 15) == 15; const int b = c >> 4;
#pragma unroll
        for (int i = 0; i < 4; ++i) { const int n = tid + 512 * i, s = n >> 4, ch = n & 15;
            f32x4 a, bq; load8_bf16(vp + (size_t)(r0 + s) * D + d0 + 8 * ch, a, bq);
            const float r = rs[s]; const f32x4 ga = *(const f32x4*)(gv + d0 + 8 * ch), gb = *(const f32x4*)(gv + d0 + 8 * ch + 4);
            a = a * r * ga; bq = bq * r * gb;
            if (last) { float* o = out + O_CVP + ((size_t)(b * 128 + s)) * D + d0 + 8 * ch; *(f32x4*)o = a; *(f32x4*)(o + 4) = bq; }
            u32x4 pk; pk.x = cvt_pk_bf16(a[0], a[1]); pk.y = cvt_pk_bf16(a[2], a[3]); pk.z = cvt_pk_bf16(bq[0], bq[1]); pk.w = cvt_pk_bf16(bq[2], bq[3]);
            *(LAS u32x4*)(Vimg + sp_off(s, ch)) = pk; }
        BLK_BAR();
        const unsigned q4 = (unsigned)(fr >> 2), p4 = (unsigned)(fr & 3);
        const unsigned vbase = (unsigned)(size_t)Vimg;
        const unsigned a0 = vbase + sp_off(8u * fq + q4, 2u * w + (p4 >> 1)) + 8u * (p4 & 1u);
        const unsigned a1 = vbase + sp_off(8u * fq + 4u + q4, 2u * w + (p4 >> 1)) + 8u * (p4 & 1u);
        u16x4_t v00, v01, v10, v11, v20, v21, v30, v31;
        asm volatile("ds_read_b64_tr_b16 %0, %8\n\tds_read_b64_tr_b16 %1, %9\n\tds_read_b64_tr_b16 %2, %8 offset:8192\n\tds_read_b64_tr_b16 %3, %9 offset:8192\n\t"
                     "ds_read_b64_tr_b16 %4, %8 offset:16384\n\tds_read_b64_tr_b16 %5, %9 offset:16384\n\tds_read_b64_tr_b16 %6, %8 offset:24576\n\tds_read_b64_tr_b16 %7, %9 offset:24576\n\t"
                     "s_waitcnt lgkmcnt(0)"
                     : "=&v"(v00), "=&v"(v01), "=&v"(v10), "=&v"(v11), "=&v"(v20), "=&v"(v21), "=&v"(v30), "=&v"(v31) : "v"(a0), "v"(a1) : "memory");
        bf16x8 Vf[4];
        Vf[0] = (bf16x8){(short)v00[0], (short)v00[1], (short)v00[2], (short)v00[3], (short)v01[0], (short)v01[1], (short)v01[2], (short)v01[3]};
        Vf[1] = (bf16x8){(short)v10[0], (short)v10[1], (short)v10[2], (short)v10[3], (short)v11[0], (short)v11[1], (short)v11[2], (short)v11[3]};
        Vf[2] = (bf16x8){(short)v20[0], (short)v20[1], (short)v20[2], (short)v20[3], (short)v21[0], (short)v21[1], (short)v21[2], (short)v21[3]};
        Vf[3] = (bf16x8){(short)v30[0], (short)v30[1], (short)v30[2], (short)v30[3], (short)v31[0], (short)v31[1], (short)v31[2], (short)v31[3]};
        f32x4 acc[8];
#pragma unroll
        for (int tt = 0; tt < 8; ++tt) { acc[tt] = (f32x4){0.f, 0.f, 0.f, 0.f};
#pragma unroll
            for (int ks = 0; ks < 4; ++ks) if (2 * ks <= tt) {
                const bf16x8 Wf = *(const LAS bf16x8*)(Wimg + sp_off((unsigned)(16 * tt + fr), (unsigned)(4 * ks + fq)));
                acc[tt] = __builtin_amdgcn_mfma_f32_16x16x32_bf16(Vf[ks], Wf, acc[tt], 0, 0, 0); } }
#pragma unroll
        for (int tt = 0; tt < 8; ++tt) { const int t = 16 * tt + fr; const float bb = bsp[g * 128 + t];
            bf16_t* up = uu + (size_t)(r0 + t) * D + d0 + 16 * w + 4 * fq;
            const unsigned long long uw = *(const unsigned long long*)up;
            const float u0 = __uint_as_float((unsigned)(uw << 16)), u1 = __uint_as_float((unsigned)uw & 0xffff0000u), u2 = __uint_as_float((unsigned)(uw >> 32) << 16), u3 = __uint_as_float((unsigned)(uw >> 32) & 0xffff0000u);
            const f32x4 s4 = acc[tt] + bb;
            *(unsigned long long*)up = (unsigned long long)cvt_pk_bf16(u0 * s4[0], u1 * s4[1]) | ((unsigned long long)cvt_pk_bf16(u2 * s4[2], u3 * s4[3]) << 32); }
        BLK_BAR();
    }
}
__device__ __forceinline__ void p2_spatial_s(const KPtr P, const bf16_t* vp, bf16_t* uu, const float* vssq_s) {
    const int tid = threadIdx.x, lane = tid & 63, gw = blockIdx.x * 8 + (tid >> 6), NGW = gridDim.x * 8;
    for (int i = gw; i < MS; i += NGW) {
        float s = lane < 32 ? vssq_s[i * 32 + lane] : 0.f; s = wave_sum(s);
        const float rsv = 1.0f / sqrtf(s * (1.0f / D) + EPS); const size_t r = (size_t)(MP + i) * D;
        for (int d = lane; d < D; d += 64) { const int g = d >> 7;
            const float vnv = bf2f(vp[r + d]) * rsv * P->g_v[d];
            P->out[O_CVS + (size_t)i * D + d] = vnv;
            uu[r + d] = f2bf(bf2f(uu[r + d]) * (P->w_sp[(size_t)g * 128 * 128] * vnv + P->b_sp[g * 128])); }
    }
}
__device__ __forceinline__ void p5_convF(const bf16_t* uph, bf16_t* a3, const float* wcf, int half) {
    const f32x4 z = (f32x4){0.f, 0.f, 0.f, 0.f};
    for (size_t idx = (size_t)blockIdx.x * 512 + threadIdx.x; idx < (size_t)MP * 176; idx += (size_t)gridDim.x * 512) {
        const int c8 = (int)(idx & 15), t = (int)((idx >> 4) % 11), r = (int)(idx / 176), tt = r & (SEQ - 1);
        const int c = c8 * 8, ja = 1408 * half + 128 * t + c, jb = DFF + ja;
        const bf16_t* pa = uph + (size_t)r * DFF + 256 * t + c; const bf16_t* pb = pa + 128;
        f32x4 a0[2], a1[2], a2[2], b0[2], b1[2], b2[2];
        load8_bf16(pa, a0[0], a0[1]); load8_bf16(pb, b0[0], b0[1]);
        if (tt >= 1) { load8_bf16(pa - DFF, a1[0], a1[1]); load8_bf16(pb - DFF, b1[0], b1[1]); } else { a1[0] = a1[1] = b1[0] = b1[1] = z; }
        if (tt >= 2) { load8_bf16(pa - 2 * DFF, a2[0], a2[1]); load8_bf16(pb - 2 * DFF, b2[0], b2[1]); } else { a2[0] = a2[1] = b2[0] = b2[1] = z; }
        f32x4 o[2];
#pragma unroll
        for (int q = 0; q < 2; ++q) {
            const f32x4 wa0 = *(const f32x4*)(wcf + ja + 4 * q), wa1 = *(const f32x4*)(wcf + NUP + ja + 4 * q), wa2 = *(const f32x4*)(wcf + 2 * NUP + ja + 4 * q);
            const f32x4 wb0 = *(const f32x4*)(wcf + jb + 4 * q), wb1 = *(const f32x4*)(wcf + NUP + jb + 4 * q), wb2 = *(const f32x4*)(wcf + 2 * NUP + jb + 4 * q);
            f32x4 cav = wa0 * a2[q] + wa1 * a1[q] + wa2 * a0[q]; const f32x4 cbv = wb0 * b2[q] + wb1 * b1[q] + wb2 * b0[q];
#pragma unroll
            for (int j = 0; j < 4; ++j) cav[j] = gelu_tanh(cav[j]);
            o[q] = cav * cbv; }
        store8_bf16(a3 + (size_t)r * DFF + ja, o[0], o[1]);
    }
}
__device__ __forceinline__ void p8_final(float* h, const float* gf) {
    const int tid = threadIdx.x, lane = tid & 63, gw = blockIdx.x * 8 + (tid >> 6), NGW = gridDim.x * 8;
    for (int r = gw; r < MV; r += NGW) {
        f32x4* p = (f32x4*)(h + (size_t)r * D) + lane; f32x4 v[4]; float s = 0.f;
#pragma unroll
        for (int j = 0; j < 4; ++j) { v[j] = p[64 * j]; s += sum4sq(v[j]); }
        s = wave_sum(s); const float rs = 1.0f / sqrtf(s * (1.0f / D) + EPS);
#pragma unroll
        for (int j = 0; j < 4; ++j) { const f32x4 g = *((const f32x4*)gf + lane + 64 * j); p[64 * j] = v[j] * rs * g; }
    }
}

template <class Epi> __device__ __forceinline__ void run_gemm(LAS unsigned char* lds, const bf16_t* A, int lda, const bf16_t* Bt, int ldb, int N, int K, const Epi& E) {
    pg8::Gemm g; g.A = A; g.Bt = Bt; g.M = MP; g.N = N; g.K = K; g.lda = lda; g.ldb = ldb; g.pad = 0;
    pg8::StaticOrder S; S.init(MP, N, (int)gridDim.x, (int)blockIdx.x);
    pg8::gemm_phase<Epi, pg8::StaticOrder, true, true>(lds, g, S, E);
}

#ifndef PROBE_A
#define PROBE_A -1
#define PROBE_B -1
#endif
template <class Epi> __device__ __forceinline__ void run_gemm2(LAS unsigned char* lds, const Ctx c, size_t a_off, int lda, size_t b_off, int ldb, int N, int K, const Epi& E) {
    pg8::Gemm g; g.A = (const bf16_t*)(c.ws + a_off); g.Bt = (const bf16_t*)(c.ws + b_off); g.M = MP; g.N = N; g.K = K; g.lda = lda; g.ldb = ldb; g.pad = 0;
    pg8::StaticOrder S; S.init(MP, N, (int)gridDim.x, (int)blockIdx.x);
    pg8::gemm_phase<Epi, pg8::StaticOrder, true, true>(lds, g, S, E);
}
__global__ void __launch_bounds__(512, 2) mega_fwd(Ptrs P_unused) {
    extern __shared__ __attribute__((aligned(16))) unsigned char lds_raw[];
    LAS unsigned char* lds = (LAS unsigned char*)lds_raw;
    volatile LAS unsigned* MISC = (volatile LAS unsigned*)(lds + LDS_CTL_OFF);
    if (threadIdx.x < 128) MISC[threadIdx.x] = 0u;
    __syncthreads();
    Ctx c; { const KPtr kp = kargs(); c.ws = kp->ws; c.out = kp->out; }
    XcdBarrier bar = xcd_barrier_post((unsigned*)(c.ws + WS_CTL), MISC + 8);
    enum { CNT0 = __COUNTER__ };
#define STAMP(k) do { if (PROBE_A >= 0 && threadIdx.x == 0) ((volatile LAS unsigned*)(lds + LDS_CTL_OFF + 256))[k] = (unsigned)__builtin_amdgcn_s_memrealtime(); } while (0)
#define GRID_BAR() do { xcd_barrier(bar); STAMP(__COUNTER__ - CNT0); } while (0)
    STAMP(0);
    LAS float* rstab = (LAS float*)(lds + LDS_XTRA_OFF);
    const int G = gridDim.x, bid = blockIdx.x;

    { const KPtr kp = kargs();
      p0_rows(kp, WSP(bf16_t, WS_XB), WSP(float, WS_RSTD0), WSP(bf16_t, WS_PB));
      p0_weights(kp, c.ws, lds); }
    GRID_BAR();
    { EpiIn E; E.c = c; run_gemm2(lds, c, WS_XB, D, WS_WIN, D, NIN, D, E); }
    for (int it = bid; it < 256; it += G) {
        const bf16_t* As = WSP(const bf16_t, WS_XB) + (size_t)MP * D; const bf16_t* Bt = WSP(const bf16_t, WS_WIN);
        if (it < 128) { const int rh = it >> 6, i6 = it & 63, t = i6 >> 3, wc = (i6 >> 1) & 3, n = i6 & 1, Rx = t * 256 + wc * 32 + n * 16;
            const int gr[3] = {Rx, Rx + 128, (8 + (t >> 1)) * 256 + (t & 1) * 128 + wc * 32 + n * 16};
            SfInA f; f.cx = c; f.R0 = Rx;
            sample_item<4, 3>(lds, As, D, 4 * rh, Bt, D, gr, D, f);
        } else { const int j = it - 128, tile = 12 + (j >> 3), bj = (j >> 2) & 1, wc = j & 3, R0 = tile * 256 + bj * 128 + wc * 32, type = (tile - 12) >> 2;
            const int gr[2] = {R0, R0 + 16};
            SfInB f; f.cx = c; f.R0 = R0; f.type = type; f.slot = ((tile - 16) & 3) * 8 + bj * 4 + wc;
            sample_item<8, 2>(lds, As, D, 0, Bt, D, gr, D, f); }
    }
    GRID_BAR();
    { const KPtr kp = kargs();
      p2_convA(WSP(const bf16_t, WS_CA), WSP(bf16_t, WS_BA), kp->w_conv_a);
      p2_spatial(kp, lds, WSP(const bf16_t, WS_VP), WSP(bf16_t, WS_UU), WSP(const float, WS_VSSQ));
      p2_spatial_s(kp, WSP(const bf16_t, WS_VP), WSP(bf16_t, WS_UU), WSP(const float, WS_VSSQS)); }
    GRID_BAR();
    { EpiYa E; E.c = c; run_gemm2(lds, c, WS_BA, D, WS_WOA, D, D, D, E); }
    for (int it = bid; it < 32; it += G) { const int gr[2] = {it * 32, it * 32 + 16}; SfYa f; f.cx = c; f.R0 = it * 32;
        sample_item<8, 2>(lds, WSP(const bf16_t, WS_BA) + (size_t)MP * D, D, 0, WSP(const bf16_t, WS_WOA), D, gr, D, f); }
    GRID_BAR();
    { EpiYb E; E.c = c; run_gemm2(lds, c, WS_UU, D, WS_WOB, D, D, D, E); }
    for (int it = bid; it < 32; it += G) { const int gr[2] = {it * 32, it * 32 + 16}; SfYb f; f.cx = c; f.R0 = it * 32;
        sample_item<8, 2>(lds, WSP(const bf16_t, WS_UU) + (size_t)MP * D, D, 0, WSP(const bf16_t, WS_WOB), D, gr, D, f); }
    GRID_BAR();
    { EpiRes<0> E; E.c = c; run_gemm2(lds, c, WS_XB, D, WS_WO, D, D, D, E); }
    for (int it = bid; it < 32; it += G) { const int gr[2] = {it * 32, it * 32 + 16}; SfRes f; f.cx = c; f.R0 = it * 32; f.slot = it; f.which = 0;
        sample_item<8, 2>(lds, WSP(const bf16_t, WS_XB) + (size_t)MP * D, D, 0, WSP(const bf16_t, WS_WO), D, gr, D, f); }
    GRID_BAR();
    { EpiUp E; E.c = c; E.half = 0; E.pad = 0; run_gemm2(lds, c, WS_H1B, D, WS_WUP, D, DFF, D, E); }
    if (bid < 176) sample_rstd_table(rstab, WSP(const float, WS_SSQ1S));
    for (int it = bid; it < 176; it += G) { const int T = it >> 3, wc = (it >> 1) & 3, n = it & 1, Ra = T * 256 + wc * 32 + n * 16; const int gr[2] = {Ra, Ra + 128};
        SfUp f; f.cx = c; f.rs = rstab; f.R0 = Ra;
        sample_item<8, 2>(lds, WSP(const bf16_t, WS_H1B) + (size_t)MP * D, D, 0, WSP(const bf16_t, WS_WUP), D, gr, D, f); }
    GRID_BAR();
    p5_convF(WSP(const bf16_t, WS_UPH), WSP(bf16_t, WS_A3), kargs()->w_conv_f, 0);
    GRID_BAR();
    { EpiUp E; E.c = c; E.half = 1; E.pad = 0; run_gemm2(lds, c, WS_H1B, D, WS_WUP + (size_t)DFF * D * 2, D, DFF, D, E); }
    GRID_BAR();
    p5_convF(WSP(const bf16_t, WS_UPH), WSP(bf16_t, WS_A3), kargs()->w_conv_f, 1);
    GRID_BAR();
    { EpiRes<1> E; E.c = c; run_gemm2(lds, c, WS_A3, DFF, WS_WDOWN, DFF, D, DFF, E); }
    for (int it = bid; it < 128; it += G) { const int rg = it >> 5, cg = it & 31; const int gr[2] = {cg * 32, cg * 32 + 16};
        SfRes f; f.cx = c; f.R0 = cg * 32; f.slot = cg; f.which = 1;
        sample_item<2, 2>(lds, WSP(const bf16_t, WS_A3) + (size_t)MP * DFF, DFF, 2 * rg, WSP(const bf16_t, WS_WDOWN), DFF, gr, DFF, f); }
    GRID_BAR();
    { EpiPe E; E.c = c; run_gemm2(lds, c, WS_PB, PD, WS_WPLE, PD, D, PD, E); }
    { EpiGate E; E.c = c; run_gemm2(lds, c, WS_H2B, D, WS_WPG, D, D, D, E); }
    if (bid < 32) sample_rstd_table(rstab, WSP(const float, WS_SSQ2S));
    for (int it = bid; it < 32; it += G) { const int gr[2] = {it * 32, it * 32 + 16};
        { SfPe f; f.cx = c; f.R0 = it * 32; sample_item<8, 2>(lds, WSP(const bf16_t, WS_PB) + (size_t)MP * PD, PD, 0, WSP(const bf16_t, WS_WPLE), PD, gr, PD, f); }
        { SfGate f; f.cx = c; f.rs = rstab; f.R0 = it * 32; sample_item<8, 2>(lds, WSP(const bf16_t, WS_H2B) + (size_t)MP * D, D, 0, WSP(const bf16_t, WS_WPG), D, gr, D, f); } }
    GRID_BAR();
    p8_final(c.out, kargs()->g_final);
#if PROBE_A >= 0
    GRID_BAR();
    if (bid == 0) {
        volatile LAS unsigned* tsl = (volatile LAS unsigned*)(lds + LDS_CTL_OFF + 256);
        const float da = (float)(tsl[PROBE_A + 1] - tsl[PROBE_A]) * 0.01f;
        const float db = (float)(tsl[PROBE_B + 1] - tsl[PROBE_B]) * 0.01f;
        const float sc = 1.0f + da * 0.001f;
        for (int i = threadIdx.x; i < MS * D; i += 512) c.out[(size_t)MP * D + i] *= sc;
        if (threadIdx.x == 0) c.out[O_CAP] += db;
    }
#endif
}

extern "C" void kernel_launch(void* const* d_in, const int* in_sizes, int n_in, void* d_out, int out_size, void* d_ws, size_t ws_size, hipStream_t stream) {
    (void)in_sizes; (void)n_in; (void)out_size; (void)ws_size;
    static int grid = 0;
    if (grid == 0) {
        int dev = 0, cus = 0, per_cu = 0;
        (void)hipGetDevice(&dev); (void)hipDeviceGetAttribute(&cus, hipDeviceAttributeMultiprocessorCount, dev);
        (void)hipFuncSetAttribute((const void*)mega_fwd, hipFuncAttributeMaxDynamicSharedMemorySize, LDS_TOTAL);
        if (hipOccupancyMaxActiveBlocksPerMultiprocessor(&per_cu, (const void*)mega_fwd, 512, LDS_TOTAL) != hipSuccess || per_cu < 1) { per_cu = 1; (void)hipGetLastError(); }
        grid = cus * (per_cu > 1 ? 1 : per_cu);
        if (grid <= 0) grid = 256;
    }
    (void)hipMemsetAsync((char*)d_ws + WS_CTL, 0, CTL_BYTES, stream);
    Ptrs P{};
    const float** pf = (const float**)&P;
    for (int i = 0; i < 23; ++i) pf[i] = (const float*)d_in[i];
    P.out = (float*)d_out; P.ws = (unsigned char*)d_ws;
    void* args[] = {&P};
    hipError_t e = hipLaunchCooperativeKernel((const void*)mega_fwd, dim3(grid), dim3(512), args, LDS_TOTAL, stream);
    if (e != hipSuccess) { fprintf(stderr, "cooperative launch failed: %s (grid %d)\n", hipGetErrorString(e), grid); (void)hipGetLastError();
        hipLaunchKernelGGL(mega_fwd, dim3(grid), dim3(512), LDS_TOTAL, stream, P); }
}
```

```cpp
#include <hip/hip_runtime.h>
#include <cstdio>
#include <cstdint>
namespace pg8 {
#define PG8_LAS __attribute__((address_space(3)))
typedef unsigned short bf16_t;
typedef short bf16x8 __attribute__((ext_vector_type(8)));
typedef float f32x4 __attribute__((ext_vector_type(4)));
typedef unsigned u32x4 __attribute__((ext_vector_type(4)));
constexpr int BM = 256, BK = 64, HALF = 128, HTB = HALF * BK * 2  , STAGE_BYTES = 8 * HTB, NXCD = 8, WGM = 8;

__host__ __device__ __forceinline__ int lds_byte(int r, int c) { const int st = (r >> 4) * 2 + (c >> 5), rr = r & 15, cc = c & 31, ob = rr * 64 + cc * 2; return st * 1024 + (ob ^ (((ob >> 9) & 1) << 5)); }
__host__ __device__ __forceinline__ void stage_rc(int b, int& R, int& C) { const int st = b / 1024, sb = b % 1024, swz = sb ^ (((sb >> 9) & 1) << 5); R = (st >> 1) * 16 + swz / 64; C = (st & 1) * 32 + (swz % 64) / 2; }
__host__ __device__ __forceinline__ int perm32(int rho) { const int n = rho >> 4, i = rho & 15; return 8 * (i >> 2) + 4 * n + (i & 3); }

struct Unit { int pm, pn; };
struct Gemm { const bf16_t* A; const bf16_t* Bt; int M, N, K, lda, ldb, pad; };

struct StaticOrder {
    int nM, nN, nwg, G, c;
    __host__ __device__ void init(int M, int N, int G_, int c_) { nM = M / BM; nN = N / BM; nwg = nM * nN; G = G_; c = c_; }
    __host__ __device__ bool next(int i, Unit& u) const {
        const long L = (long)i * G + c; if (L >= nwg) return false;
        int wgid = (int)L; { const int q = nwg / NXCD, r = nwg % NXCD, xcd = wgid % NXCD, off = wgid / NXCD; wgid = (xcd < r ? xcd * (q + 1) : r * (q + 1) + (xcd - r) * q) + off; }
        const int nig = WGM * nN, gid = wgid / nig, fm = gid * WGM, gsz = (nM - fm) < WGM ? (nM - fm) : WGM;
        u.pm = fm + ((wgid % nig) % gsz); u.pn = (wgid % nig) / gsz; return true;
    }
    __device__ __forceinline__ void a_ready(const Unit&) const {}
    __device__ __forceinline__ void done(const Unit&) const {}
};


typedef __bf16 bf16x2_nat __attribute__((ext_vector_type(2)));
typedef float f32x2_nat __attribute__((ext_vector_type(2)));
__device__ __forceinline__ unsigned cvt_pk_bf16(float lo, float hi) { const f32x2_nat v = {lo, hi}; return __builtin_bit_cast(unsigned, __builtin_convertvector(v, bf16x2_nat)); }
template <class Epi, class Sched, bool ALIGN_EPI = false, bool SP2 = false>
__device__ __forceinline__ void gemm_phase(PG8_LAS unsigned char* lds, const Gemm g, const Sched& S, const Epi& E) {
    int tid_ = threadIdx.x; asm volatile("" : "+v"(tid_));
    const int tid = tid_, wid = __builtin_amdgcn_readfirstlane(tid >> 6), lane = tid & 63, wr = wid >> 2, wc = wid & 3, fr = lane & 15, fq = lane >> 4;
    const int K = g.K, nt = K / BK;
    unsigned voffA[2], voffB[2];
#pragma unroll
    for (int i = 0; i < 2; ++i) { int R, C; stage_rc(tid * 16 + i * 8192, R, C); voffA[i] = (unsigned)(R * g.lda + C) * 2u; voffB[i] = (unsigned)(R * g.ldb + C) * 2u; }
    const size_t kstep = (size_t)(BK * 2);
    const size_t hstepA = (size_t)HALF * g.lda * 2, hstepB = (size_t)HALF * g.ldb * 2;
    const size_t tstepA = 2 * hstepA, tstepB = 2 * hstepB;
    const unsigned ldsw = (unsigned)wid * 1024u;
    const int aoff = lds_byte(wr * 64 + fr, fq * 8), boff = lds_byte(wc * 32 + fr, fq * 8);
#define PG8_SA(b, h) (((b) * 2 + (h)) * HTB)
#define PG8_SB(b, h) ((4 + (b) * 2 + (h)) * HTB)
#define PG8_STAGE(bufoff, gbase, voff) do { _Pragma("unroll") for (int _i = 0; _i < 2; ++_i) \
        __builtin_amdgcn_global_load_lds((const unsigned*)((const char*)(gbase) + (voff)[_i]), (PG8_LAS unsigned*)(lds + (bufoff) + ldsw + _i * 8192), 16, 0, 0); } while (0)
#define PG8_LDA(dst, b, h) do { _Pragma("unroll") for (int m = 0; m < 4; ++m) _Pragma("unroll") for (int k = 0; k < 2; ++k) dst[m][k] = *(const PG8_LAS bf16x8*)(lds + PG8_SA(b, h) + aoff + m * 2048 + k * 1024); } while (0)
#define PG8_LDB(dst, b, h) do { _Pragma("unroll") for (int n = 0; n < 2; ++n) _Pragma("unroll") for (int k = 0; k < 2; ++k) dst[n][k] = *(const PG8_LAS bf16x8*)(lds + PG8_SB(b, h) + boff + n * 2048 + k * 1024); } while (0)
#define PG8_MMA(ai, bj, At, Bt) do { __builtin_amdgcn_s_setprio(1); _Pragma("unroll") for (int m = 0; m < 4; ++m) _Pragma("unroll") for (int n = 0; n < 2; ++n) _Pragma("unroll") for (int k = 0; k < 2; ++k) \
        acc[ai][bj][m][n] = __builtin_amdgcn_mfma_f32_16x16x32_bf16(Bt[n][k], At[m][k], acc[ai][bj][m][n], 0, 0, 0); __builtin_amdgcn_s_setprio(0); } while (0)
#define PG8_WAIT_V(n) asm volatile("s_waitcnt vmcnt(" #n ")" ::: "memory")
#define PG8_WAIT_L(n) asm volatile("s_waitcnt lgkmcnt(" #n ")" ::: "memory")
#define PG8_BAR __builtin_amdgcn_s_barrier()
#define PG8_SCHED __builtin_amdgcn_sched_barrier(0)
    Unit cur, nxt; int ui = 0;
    if (!S.next(0, cur)) return;
    f32x4 acc[2][2][4][2];
#pragma unroll
    for (int a = 0; a < 2; ++a)
#pragma unroll
        for (int b = 0; b < 2; ++b)
#pragma unroll
            for (int m = 0; m < 4; ++m)
#pragma unroll
                for (int n = 0; n < 2; ++n) acc[a][b][m][n] = (f32x4){0.f, 0.f, 0.f, 0.f};
    bf16x8 At[4][2], B0[2][2], B1[2][2];
    const char* cA = (const char*)g.A + (size_t)cur.pm * tstepA; const char* cB = (const char*)g.Bt + (size_t)cur.pn * tstepB;
    S.a_ready(cur);
    if constexpr (SP2) {
        PG8_STAGE(PG8_SB(0, 0), cB, voffB); PG8_STAGE(PG8_SB(0, 1), cB + hstepB, voffB); PG8_STAGE(PG8_SA(0, 0), cA, voffA); PG8_STAGE(PG8_SA(0, 1), cA + hstepA, voffA);
        if (wr == 1) PG8_BAR;
        PG8_WAIT_V(2); PG8_BAR;
        PG8_STAGE(PG8_SB(1, 0), cB + kstep, voffB); PG8_STAGE(PG8_SA(1, 0), cA + kstep, voffA); PG8_STAGE(PG8_SB(1, 1), cB + hstepB + kstep, voffB);
        PG8_WAIT_V(6); PG8_BAR;
    } else {
        PG8_STAGE(PG8_SB(0, 0), cB, voffB); PG8_STAGE(PG8_SA(0, 0), cA, voffA); PG8_STAGE(PG8_SB(0, 1), cB + hstepB, voffB); PG8_STAGE(PG8_SA(0, 1), cA + hstepA, voffA);
        if (wr == 1) PG8_BAR;
        PG8_WAIT_V(4); PG8_BAR;
        PG8_STAGE(PG8_SB(1, 0), cB + kstep, voffB); PG8_STAGE(PG8_SA(1, 0), cA + kstep, voffA); PG8_STAGE(PG8_SB(1, 1), cB + hstepB + kstep, voffB);
        PG8_WAIT_V(6); PG8_BAR;
    }
    for (;;) {
        const bool has_next = S.next(ui + 1, nxt);
        const char* nA = has_next ? (const char*)g.A + (size_t)nxt.pm * tstepA : cA; const char* nB = has_next ? (const char*)g.Bt + (size_t)nxt.pn * tstepB : cB;
        for (int t = 0; t < nt; t += 2) {
            const bool last = (t == nt - 2);
            const char* a1 = cA + (size_t)(t + 1) * kstep;
            const char* a2 = last ? nA : cA + (size_t)(t + 2) * kstep; const char* b2 = last ? nB : cB + (size_t)(t + 2) * kstep;
            const char* a3 = a2 + kstep; const char* b3 = b2 + kstep;
            if (last && has_next) S.a_ready(nxt);
            if constexpr (SP2) {
            PG8_LDB(B0, 0, 0); PG8_LDB(B1, 0, 1); PG8_SCHED; PG8_LDA(At, 0, 0); PG8_STAGE(PG8_SA(1, 1), a1 + hstepA, voffA);
            PG8_WAIT_V(8); PG8_WAIT_L(0); PG8_BAR; PG8_MMA(0, 0, At, B0); PG8_MMA(0, 1, At, B1); PG8_BAR; PG8_SCHED;
            PG8_LDA(At, 0, 1); PG8_STAGE(PG8_SB(0, 0), b2, voffB); PG8_STAGE(PG8_SB(0, 1), b2 + hstepB, voffB); PG8_STAGE(PG8_SA(0, 0), a2, voffA);
            PG8_WAIT_V(8); PG8_WAIT_L(0); PG8_BAR; PG8_MMA(1, 0, At, B0); PG8_MMA(1, 1, At, B1); PG8_BAR; PG8_SCHED;
            PG8_LDB(B0, 1, 0); PG8_LDB(B1, 1, 1); PG8_SCHED; PG8_LDA(At, 1, 0); PG8_STAGE(PG8_SA(0, 1), a2 + hstepA, voffA);
            PG8_WAIT_V(8); PG8_WAIT_L(0); PG8_BAR; PG8_MMA(0, 0, At, B0); PG8_MMA(0, 1, At, B1); PG8_BAR; PG8_SCHED;
            PG8_LDA(At, 1, 1); PG8_STAGE(PG8_SB(1, 0), b3, voffB); PG8_STAGE(PG8_SB(1, 1), b3 + hstepB, voffB); PG8_STAGE(PG8_SA(1, 0), a3, voffA);
            PG8_WAIT_V(8); PG8_WAIT_L(0); PG8_BAR; PG8_MMA(1, 0, At, B0); PG8_MMA(1, 1, At, B1); PG8_BAR; PG8_SCHED;
            } else {
            PG8_LDB(B0, 0, 0); PG8_SCHED; PG8_LDA(At, 0, 0); PG8_STAGE(PG8_SA(1, 1), a1 + hstepA, voffA);
            PG8_WAIT_L(8); PG8_BAR; PG8_WAIT_L(0); PG8_MMA(0, 0, At, B0); PG8_BAR; PG8_SCHED;
            PG8_LDB(B1, 0, 1); PG8_STAGE(PG8_SB(0, 0), b2, voffB);
            PG8_BAR; PG8_WAIT_L(0); PG8_MMA(0, 1, At, B1); PG8_BAR;
            PG8_LDA(At, 0, 1); PG8_STAGE(PG8_SA(0, 0), a2, voffA);
            PG8_BAR; PG8_WAIT_L(0); PG8_MMA(1, 0, At, B0); PG8_BAR; PG8_SCHED;
            PG8_STAGE(PG8_SB(0, 1), b2 + hstepB, voffB);
            PG8_WAIT_V(6); PG8_BAR; PG8_MMA(1, 1, At, B1); PG8_BAR;
            PG8_LDB(B0, 1, 0); PG8_SCHED; PG8_LDA(At, 1, 0); PG8_STAGE(PG8_SA(0, 1), a2 + hstepA, voffA);
            PG8_WAIT_L(8); PG8_BAR; PG8_WAIT_L(0); PG8_MMA(0, 0, At, B0); PG8_BAR; PG8_SCHED;
            PG8_LDB(B1, 1, 1); PG8_STAGE(PG8_SB(1, 0), b3, voffB);
            PG8_BAR; PG8_WAIT_L(0); PG8_MMA(0, 1, At, B1); PG8_BAR;
            PG8_LDA(At, 1, 1); PG8_STAGE(PG8_SA(1, 0), a3, voffA);
            PG8_BAR; PG8_WAIT_L(0); PG8_MMA(1, 0, At, B0); PG8_BAR; PG8_SCHED;
            PG8_STAGE(PG8_SB(1, 1), b3 + hstepB, voffB);
            PG8_WAIT_V(6); PG8_BAR; PG8_MMA(1, 1, At, B1); PG8_BAR;
            }
        }
        if constexpr (ALIGN_EPI) { if (wr == 0) PG8_BAR; }
        if constexpr (!Epi::AFTER_DRAIN) { E(acc, cur, wr, wc, fr, fq); S.done(cur); }
        if (!has_next) break;
#pragma unroll
        for (int a = 0; a < 2; ++a)
#pragma unroll
            for (int b = 0; b < 2; ++b)
#pragma unroll
                for (int m = 0; m < 4; ++m)
#pragma unroll
                    for (int n = 0; n < 2; ++n) acc[a][b][m][n] = (f32x4){0.f, 0.f, 0.f, 0.f};
        cur = nxt; cA = nA; cB = nB; ++ui;
        if constexpr (ALIGN_EPI) { if (wr == 1) PG8_BAR; }
    }
    PG8_WAIT_V(0);
    if constexpr (!ALIGN_EPI) { if (wr == 0) PG8_BAR; }
    PG8_BAR;
    if constexpr (Epi::AFTER_DRAIN) { E.fused(acc, cur, wr, wc, fr, fq, lds, wid, lane); S.done(cur); }
#undef PG8_SA
#undef PG8_SB
#undef PG8_STAGE
#undef PG8_LDA
#undef PG8_LDB
#undef PG8_MMA
#undef PG8_WAIT_V
#undef PG8_WAIT_L
#undef PG8_BAR
#undef PG8_SCHED
}
}

using pg8::bf16_t; using pg8::f32x4; using pg8::u32x4; using pg8::Unit; using pg8::cvt_pk_bf16;
constexpr int D = 1024, NBATCH = 8, SEQ = 2048, MP = NBATCH * SEQ, MS = 128, MV = MP + MS  , MALL = MP + 256  ;
constexpr int NIN = 7168, DFF = 2816, NUP = 2 * DFF, PD = 256;
constexpr float EPS = 1e-6f;
constexpr int LDS_BYTES = 131072;

constexpr size_t O_Y = 0;
constexpr size_t O_CAP = (size_t)MV * D;
constexpr size_t O_CAS = O_CAP + (size_t)NBATCH * 2 * D;
constexpr size_t O_CVP = O_CAS + (size_t)MS * 2 * D;
constexpr size_t O_CVS = O_CVP + (size_t)NBATCH * 128 * D;
constexpr size_t O_CFP = O_CVS + (size_t)MS * D;
constexpr size_t O_CFS = O_CFP + (size_t)NBATCH * 2 * NUP;
constexpr size_t O_END = O_CFS + (size_t)MS * 2 * NUP;

struct Ptrs {
    const float *x_p, *x_s, *p_p, *p_s, *st_a, *st_f, *g_mix, *w_in, *w_conv_a, *w_out_a, *g_v, *w_sp, *b_sp, *w_out_b, *w_o, *g_ffn, *w_up, *w_conv_f, *w_down, *g_ple, *w_pg, *w_ple, *g_final;
    float* out; unsigned char* ws;
};
constexpr size_t MiB = 1u << 20;
constexpr size_t WS_WUP = 0, WS_WDOWN = 11 * MiB, WS_WPG = 16 * MiB + MiB / 2, WS_WPLE = 18 * MiB + MiB / 2;
constexpr size_t WS_SMALL = 19 * MiB, WS_CTL = WS_SMALL, CTL_BYTES = 65536;
constexpr size_t WS_RSTD0 = WS_SMALL + 65536, WS_VSSQS = WS_RSTD0 + 131072, WS_SSQ1S = WS_VSSQS + 16384, WS_SSQ2S = WS_SSQ1S + 16384, WS_T1S = WS_SSQ2S + 16384, WS_PES = WS_T1S + 524288;
constexpr size_t WS_VSSQ = 20 * MiB + MiB / 2, WS_SSQ1 = 21 * MiB + 3 * MiB / 4, WS_SSQ2 = 23 * MiB;
constexpr size_t WS_PB = 24 * MiB + MiB / 2;
constexpr size_t WS_WIN = 33 * MiB, WS_WOA = 47 * MiB, WS_WOB = 49 * MiB, WS_WO = 51 * MiB;
constexpr size_t WS_XB = 53 * MiB, WS_CA = 86 * MiB, WS_VP = WS_CA + 65 * MiB / 2, WS_BA = 151 * MiB, WS_UU = 184 * MiB, WS_SGA = 217 * MiB;
constexpr size_t WS_H1B = 222 * MiB, WS_UPH = 33 * MiB, WS_A3 = 123 * MiB, WS_H2B = 33 * MiB, WS_PE = 123 * MiB, WS_HB = 213 * MiB;


typedef const Ptrs __attribute__((address_space(4)))* KPtr;
__device__ __forceinline__ KPtr kargs() { KPtr p = (KPtr)__builtin_amdgcn_kernarg_segment_ptr(); asm volatile("" : "+s"(p)); return p; }
struct Ctx { unsigned char* ws; float* out; };
#define WSP(T, off) ((T*)(c.ws + (off)))
__device__ __forceinline__ float gelu_tanh(float x) {
    const float t = x * x;
    const float u2 = x * (2.3022082f + 0.10294324f * t);
    const float e = __builtin_amdgcn_exp2f(-u2);
    return x * __builtin_amdgcn_rcpf(1.0f + e);
}
__device__ __forceinline__ float sigmoid_f(float x) { return __builtin_amdgcn_rcpf(1.0f + __builtin_amdgcn_exp2f(-1.4426950409f * x)); }
__device__ __forceinline__ float bf2f(unsigned short b) { return __uint_as_float(((unsigned)b) << 16); }
__device__ __forceinline__ void store8_bf16(bf16_t* p, f32x4 v0, f32x4 v1) {
    u32x4 w; w.x = cvt_pk_bf16(v0[0], v0[1]); w.y = cvt_pk_bf16(v0[2], v0[3]); w.z = cvt_pk_bf16(v1[0], v1[1]); w.w = cvt_pk_bf16(v1[2], v1[3]);
    *(u32x4*)p = w;
}
__device__ __forceinline__ void load8_bf16(const bf16_t* p, f32x4& v0, f32x4& v1) {
    const u32x4 w = *(const u32x4*)p;
    v0 = (f32x4){__uint_as_float(w.x << 16), __uint_as_float(w.x & 0xffff0000u), __uint_as_float(w.y << 16), __uint_as_float(w.y & 0xffff0000u)};
    v1 = (f32x4){__uint_as_float(w.z << 16), __uint_as_float(w.z & 0xffff0000u), __uint_as_float(w.w << 16), __uint_as_float(w.w & 0xffff0000u)};
}
__device__ __forceinline__ float sum4sq(f32x4 v) { return (v[0] * v[0] + v[1] * v[1]) + (v[2] * v[2] + v[3] * v[3]); }

__device__ __forceinline__ float row_rstd16(const float* ssq, int r, int fq) {
    const f32x4 a = *(const f32x4*)(ssq + (size_t)r * 16 + 4 * fq);
    float s = (a[0] + a[1]) + (a[2] + a[3]); s += __shfl_xor(s, 16); s += __shfl_xor(s, 32);
    return 1.0f / sqrtf(s * (1.0f / D) + EPS);
}
#define EPI_ROW(ai, m) (u.pm * 256 + (ai) * 128 + wr * 64 + (m) * 16 + fr)
typedef const f32x4 (&AccRef)[2][2][4][2];

struct EpiIn {
    static constexpr bool AFTER_DRAIN = false;
    Ctx c;
    __device__ __forceinline__ void operator()(AccRef acc, const Unit& u, int wr, int wc, int fr, int fq) const {
        const float* rstd0 = WSP(const float, WS_RSTD0); bf16_t* ca = WSP(bf16_t, WS_CA); bf16_t* ba = WSP(bf16_t, WS_BA); bf16_t* uu = WSP(bf16_t, WS_UU); bf16_t* vp = WSP(bf16_t, WS_VP);
        bf16_t* sga = WSP(bf16_t, WS_SGA); bf16_t* sgb = (bf16_t*)c.out; float* vssq = WSP(float, WS_VSSQ); float* out = c.out;
        const int tile = u.pn, hc = wc * 32 + 8 * fq;
        if (tile < 8) {
#pragma unroll
            for (int ai = 0; ai < 2; ++ai)
#pragma unroll
                for (int m = 0; m < 4; ++m) {
                    const int r = EPI_ROW(ai, m); const float rs = rstd0[r];
                    const f32x4 p0 = (acc[ai][0][m][0] * rs) * (acc[ai][1][m][0] * rs), p1 = (acc[ai][0][m][1] * rs) * (acc[ai][1][m][1] * rs);
                    store8_bf16(ca + (size_t)r * D + 128 * tile + hc, p0, p1);
                    if (r < MP) { const int t = r & (SEQ - 1); if (t >= SEQ - 2) { float* o = out + O_CAP + ((size_t)((r >> 11) * 2 + (t - (SEQ - 2)))) * D + 128 * tile + hc; *(f32x4*)o = p0; *(f32x4*)(o + 4) = p1; } }
                    else if (r < MV) { float* o = out + O_CAS + ((size_t)((r - MP) * 2 + 1)) * D + 128 * tile + hc; *(f32x4*)o = p0; *(f32x4*)(o + 4) = p1; }
                }
        } else {
            const int type = (tile - 8) >> 2, tl = (tile - 8) & 3;
            bf16_t* dst = type == 0 ? ba : type == 1 ? uu : type == 2 ? vp : type == 3 ? sga : sgb;
            dst += 256 * tl + hc;
            if (type == 0) {
#pragma unroll
                for (int ai = 0; ai < 2; ++ai)
#pragma unroll
                    for (int m = 0; m < 4; ++m) { const int r = EPI_ROW(ai, m); const float rs = rstd0[r];
#pragma unroll
                        for (int bj = 0; bj < 2; ++bj) store8_bf16(dst + (size_t)r * D + 128 * bj, acc[ai][bj][m][0] * rs, acc[ai][bj][m][1] * rs); }
            } else if (type <= 2) {
#pragma unroll
                for (int ai = 0; ai < 2; ++ai)
#pragma unroll
                    for (int m = 0; m < 4; ++m) { const int r = EPI_ROW(ai, m); const float rs = rstd0[r]; float s = 0.f;
#pragma unroll
                        for (int bj = 0; bj < 2; ++bj) { f32x4 v0 = acc[ai][bj][m][0] * rs, v1 = acc[ai][bj][m][1] * rs;
#pragma unroll
                            for (int j = 0; j < 4; ++j) { v0[j] = gelu_tanh(v0[j]); v1[j] = gelu_tanh(v1[j]); }
                            s += sum4sq(v0) + sum4sq(v1);
                            store8_bf16(dst + (size_t)r * D + 128 * bj, v0, v1); }
                        if (type == 2) { s += __shfl_xor(s, 16); s += __shfl_xor(s, 32); if (fq == 0) vssq[(size_t)r * 16 + tl * 4 + wc] = s; } }
            } else {
#pragma unroll
                for (int ai = 0; ai < 2; ++ai)
#pragma unroll
                    for (int m = 0; m < 4; ++m) { const int r = EPI_ROW(ai, m); const float rs = rstd0[r];
#pragma unroll
                        for (int bj = 0; bj < 2; ++bj) { f32x4 v0 = acc[ai][bj][m][0] * rs, v1 = acc[ai][bj][m][1] * rs;
#pragma unroll
                            for (int j = 0; j < 4; ++j) { v0[j] = sigmoid_f(v0[j]); v1[j] = sigmoid_f(v1[j]); }
                            store8_bf16(dst + (size_t)r * D + 128 * bj, v0, v1); } }
            }
        }
    }
};
struct EpiYa {
    static constexpr bool AFTER_DRAIN = false;
    Ctx c;
    __device__ __forceinline__ void operator()(AccRef acc, const Unit& u, int wr, int wc, int fr, int fq) const {
        const bf16_t* sga = WSP(const bf16_t, WS_SGA); float* t1 = WSP(float, WS_CA);
        const int hc = u.pn * 256 + wc * 32 + 8 * fq;
#pragma unroll
        for (int ai = 0; ai < 2; ++ai)
#pragma unroll
            for (int m = 0; m < 4; ++m) { const int r = EPI_ROW(ai, m);
#pragma unroll
                for (int bj = 0; bj < 2; ++bj) { const size_t o = (size_t)r * D + hc + 128 * bj; f32x4 g0, g1; load8_bf16(sga + o, g0, g1);
                    *(f32x4*)(t1 + o) = g0 * acc[ai][bj][m][0]; *(f32x4*)(t1 + o + 4) = g1 * acc[ai][bj][m][1]; } }
    }
};
struct EpiYb {
    static constexpr bool AFTER_DRAIN = false;
    Ctx c;
    __device__ __forceinline__ void operator()(AccRef acc, const Unit& u, int wr, int wc, int fr, int fq) const {
        const bf16_t* sgb = (const bf16_t*)c.out; const float* t1 = WSP(const float, WS_CA); bf16_t* mm = WSP(bf16_t, WS_XB);
        const int hc = u.pn * 256 + wc * 32 + 8 * fq;
#pragma unroll
        for (int ai = 0; ai < 2; ++ai)
#pragma unroll
            for (int m = 0; m < 4; ++m) { const int r = EPI_ROW(ai, m);
#pragma unroll
                for (int bj = 0; bj < 2; ++bj) { const size_t o = (size_t)r * D + hc + 128 * bj; f32x4 g0, g1; load8_bf16(sgb + o, g0, g1);
                    const f32x4 a0 = *(const f32x4*)(t1 + o), a1 = *(const f32x4*)(t1 + o + 4);
                    store8_bf16(mm + o, a0 + g0 * acc[ai][bj][m][0], a1 + g1 * acc[ai][bj][m][1]); } }
    }
};
template <int SRC> struct EpiRes {
    static constexpr bool AFTER_DRAIN = false;
    Ctx c;
    __device__ __forceinline__ void operator()(AccRef acc, const Unit& u, int wr, int wc, int fr, int fq) const {
        const KPtr kp = kargs(); const float* xp = kp->x_p; const float* xs = kp->x_s; float* h = c.out; bf16_t* hb = WSP(bf16_t, SRC == 0 ? WS_H1B : WS_H2B); float* ssq = WSP(float, SRC == 0 ? WS_SSQ1 : WS_SSQ2);
        const int hc = u.pn * 256 + wc * 32 + 8 * fq;
#pragma unroll
        for (int ai = 0; ai < 2; ++ai)
#pragma unroll
            for (int m = 0; m < 4; ++m) { const int r = EPI_ROW(ai, m); float s = 0.f; const bool valid = r < MV;
                const float* base = SRC == 1 ? h + (size_t)r * D : (r < MP ? xp + (size_t)r * D : xs + (size_t)(r - MP) * D);
#pragma unroll
                for (int bj = 0; bj < 2; ++bj) { const int c = hc + 128 * bj;
                    f32x4 b0 = (f32x4){0.f, 0.f, 0.f, 0.f}, b1 = b0; if (valid) { b0 = *(const f32x4*)(base + c); b1 = *(const f32x4*)(base + c + 4); }
                    const f32x4 v0 = b0 + acc[ai][bj][m][0], v1 = b1 + acc[ai][bj][m][1];
                    if (valid) { *(f32x4*)(h + (size_t)r * D + c) = v0; *(f32x4*)(h + (size_t)r * D + c + 4) = v1; }
                    store8_bf16(hb + (size_t)r * D + c, v0, v1);
                    s += sum4sq(v0) + sum4sq(v1); }
                s += __shfl_xor(s, 16); s += __shfl_xor(s, 32); if (fq == 0) ssq[(size_t)r * 16 + u.pn * 4 + wc] = s; }
    }
};
struct EpiUp {
    static constexpr bool AFTER_DRAIN = false;
    Ctx c; int half; int pad;
    __device__ __forceinline__ void operator()(AccRef acc, const Unit& u, int wr, int wc, int fr, int fq) const {
        const float* ssq1 = WSP(const float, WS_SSQ1); bf16_t* uph = WSP(bf16_t, WS_UPH); float* out = c.out;
        const int hc = wc * 32 + 8 * fq;
#pragma unroll
        for (int ai = 0; ai < 2; ++ai)
#pragma unroll
            for (int m = 0; m < 4; ++m) { const int r = EPI_ROW(ai, m); const float rs = row_rstd16(ssq1, r, fq);
#pragma unroll
                for (int bj = 0; bj < 2; ++bj) { const f32x4 v0 = acc[ai][bj][m][0] * rs, v1 = acc[ai][bj][m][1] * rs;
                    store8_bf16(uph + (size_t)r * DFF + 256 * u.pn + 128 * bj + hc, v0, v1);
                    const int col = (bj ? DFF : 0) + 1408 * half + 128 * u.pn + hc;
                    if (r < MP) { const int t = r & (SEQ - 1); if (t >= SEQ - 2) { float* o = out + O_CFP + ((size_t)((r >> 11) * 2 + (t - (SEQ - 2)))) * NUP + col; *(f32x4*)o = v0; *(f32x4*)(o + 4) = v1; } }
                    else if (r < MV) { float* o = out + O_CFS + ((size_t)((r - MP) * 2 + 1)) * NUP + col; *(f32x4*)o = v0; *(f32x4*)(o + 4) = v1; } } }
    }
};

__device__ __forceinline__ float dpp_ror1(float x) { return __builtin_bit_cast(float, __builtin_amdgcn_update_dpp(0, __builtin_bit_cast(int, x), 0x121, 0xf, 0xf, false)); }
__device__ __forceinline__ float dpp_ror2(float x) { return __builtin_bit_cast(float, __builtin_amdgcn_update_dpp(0, __builtin_bit_cast(int, x), 0x122, 0xf, 0xf, false)); }
__device__ __forceinline__ f32x4 dpp_ror1(f32x4 v) { return (f32x4){dpp_ror1(v[0]), dpp_ror1(v[1]), dpp_ror1(v[2]), dpp_ror1(v[3])}; }
__device__ __forceinline__ f32x4 dpp_ror2(f32x4 v) { return (f32x4){dpp_ror2(v[0]), dpp_ror2(v[1]), dpp_ror2(v[2]), dpp_ror2(v[3])}; }
#define EPI_BAR() do { asm volatile("s_waitcnt lgkmcnt(0)" ::: "memory"); __builtin_amdgcn_s_barrier(); asm volatile("" ::: "memory"); } while (0)
struct EpiUpF {
    static constexpr bool AFTER_DRAIN = false;
    Ctx c; __attribute__((address_space(3))) float* halo;
    __device__ __forceinline__ void operator()(AccRef acc, const Unit& u, int wr, int wc, int fr, int fq) const {
        const KPtr kp = kargs(); const float* wcf = kp->w_conv_f; float* out = c.out;
        const float* ssq1 = WSP(const float, WS_SSQ1); bf16_t* a3 = WSP(bf16_t, WS_A3); float* hb = WSP(float, WS_HB);
        const int hc = wc * 32 + 8 * fq, ja = 128 * u.pn + hc, jb = DFF + ja, pl = u.pm & 7;
        float rsv[2][4];
#pragma unroll
        for (int ai = 0; ai < 2; ++ai)
#pragma unroll
            for (int m = 0; m < 4; ++m) rsv[ai][m] = row_rstd16(ssq1, EPI_ROW(ai, m), fq);
        if (fr >= 14) {
#pragma unroll
            for (int ai = 0; ai < 2; ++ai)
#pragma unroll
                for (int bj = 0; bj < 2; ++bj)
#pragma unroll
                    for (int n = 0; n < 2; ++n) *(__attribute__((address_space(3))) f32x4*)(halo + ((2 * ai + wr) * 2 + (fr - 14)) * 256 + 128 * bj + hc + 4 * n) = acc[ai][bj][3][n] * rsv[ai][3]; }
        EPI_BAR();
#pragma unroll
        for (int n = 0; n < 2; ++n) {
            f32x4 w[3][2];
#pragma unroll
            for (int tap = 0; tap < 3; ++tap) { w[tap][0] = *(const f32x4*)(wcf + tap * NUP + ja + 4 * n); w[tap][1] = *(const f32x4*)(wcf + tap * NUP + jb + 4 * n); }
#pragma unroll
            for (int ai = 0; ai < 2; ++ai) {
                const int B = 2 * ai + wr;
                f32x4 y1p[2], y2p[2];
                y1p[0] = y1p[1] = y2p[0] = y2p[1] = (f32x4){0.f, 0.f, 0.f, 0.f};
                if (B > 0 && fr < 2) { const __attribute__((address_space(3))) float* hp = halo + ((B - 1) * 2) * 256 + hc + 4 * n;
#pragma unroll
                    for (int bj = 0; bj < 2; ++bj) { const f32x4 r62 = *(const __attribute__((address_space(3))) f32x4*)(hp + 128 * bj), r63 = *(const __attribute__((address_space(3))) f32x4*)(hp + 256 + 128 * bj);
                        y1p[bj] = r63; y2p[bj] = fr == 0 ? r62 : r63; } }
#pragma unroll
                for (int m = 0; m < 4; ++m) {
                    const int r = EPI_ROW(ai, m); const float rs = rsv[ai][m];
                    f32x4 x[2], cv[2];
#pragma unroll
                    for (int bj = 0; bj < 2; ++bj) { x[bj] = acc[ai][bj][m][n] * rs;
                        const f32x4 y1 = dpp_ror1(x[bj]), y2 = dpp_ror2(x[bj]);
                        const f32x4 p1 = fr == 0 ? y1p[bj] : y1, p2 = fr < 2 ? y2p[bj] : y2;
                        cv[bj] = w[0][bj] * p2 + w[1][bj] * p1 + w[2][bj] * x[bj];
                        y1p[bj] = y1; y2p[bj] = y2; }
                    f32x4 o;
#pragma unroll
                    for (int j = 0; j < 4; ++j) o[j] = gelu_tanh(cv[0][j]) * cv[1][j];
                    const bool edge_lo = (B == 0 && m == 0 && fr < 2), edge_hi = (B == 3 && m == 3 && fr >= 14);
                    if (!(edge_lo && pl != 0)) *(unsigned long long*)(a3 + (size_t)r * DFF + ja + 4 * n) = (unsigned long long)cvt_pk_bf16(o[0], o[1]) | ((unsigned long long)cvt_pk_bf16(o[2], o[3]) << 32);
                    if (edge_lo || edge_hi) { float* hrow = hb + ((size_t)u.pm * 4 + (edge_lo ? 2 + fr : fr - 14)) * NUP;
                        *(f32x4*)(hrow + ja + 4 * n) = x[0]; *(f32x4*)(hrow + jb + 4 * n) = x[1];
                        if (edge_hi && pl == 7) { float* o2 = out + O_CFP + ((size_t)((u.pm >> 3) * 2 + (fr - 14))) * NUP; *(f32x4*)(o2 + ja + 4 * n) = x[0]; *(f32x4*)(o2 + jb + 4 * n) = x[1]; } }
                }
            }
        }
    }
};
struct EpiPe {
    static constexpr bool AFTER_DRAIN = false;
    Ctx c;
    __device__ __forceinline__ void operator()(AccRef acc, const Unit& u, int wr, int wc, int fr, int fq) const {
        float* pe = WSP(float, WS_PE);
        const int hc = u.pn * 256 + wc * 32 + 8 * fq;
#pragma unroll
        for (int ai = 0; ai < 2; ++ai)
#pragma unroll
            for (int m = 0; m < 4; ++m) { const int r = EPI_ROW(ai, m);
#pragma unroll
                for (int bj = 0; bj < 2; ++bj) { const size_t o = (size_t)r * D + hc + 128 * bj; *(f32x4*)(pe + o) = acc[ai][bj][m][0]; *(f32x4*)(pe + o + 4) = acc[ai][bj][m][1]; } }
    }
};
struct EpiGate {
    static constexpr bool AFTER_DRAIN = false;
    Ctx c;
    __device__ __forceinline__ void operator()(AccRef acc, const Unit& u, int wr, int wc, int fr, int fq) const {
        const float* ssq2 = WSP(const float, WS_SSQ2); const float* pe = WSP(const float, WS_PE); float* h = c.out;
        const int hc = u.pn * 256 + wc * 32 + 8 * fq;
#pragma unroll
        for (int ai = 0; ai < 2; ++ai)
#pragma unroll
            for (int m = 0; m < 4; ++m) { const int r = EPI_ROW(ai, m); const float rs = row_rstd16(ssq2, r, fq);
#pragma unroll
                for (int bj = 0; bj < 2; ++bj) { const size_t o = (size_t)r * D + hc + 128 * bj;
                    f32x4 g0 = acc[ai][bj][m][0] * rs, g1 = acc[ai][bj][m][1] * rs;
#pragma unroll
                    for (int j = 0; j < 4; ++j) { g0[j] = sigmoid_f(g0[j]); g1[j] = sigmoid_f(g1[j]); }
                    const f32x4 p0 = *(const f32x4*)(pe + o), p1 = *(const f32x4*)(pe + o + 4);
                    const f32x4 h0 = *(const f32x4*)(h + o), h1 = *(const f32x4*)(h + o + 4);
                    *(f32x4*)(h + o) = h0 + g0 * p0; *(f32x4*)(h + o + 4) = h1 + g1 * p1; } }
    }
};


#define LAS __attribute__((address_space(3)))
typedef pg8::bf16x8 bf16x8;
constexpr int LDS_STAGE = 131072, LDS_XTRA_OFF = LDS_STAGE, LDS_XTRA = 8192, LDS_CTL_OFF = LDS_STAGE + LDS_XTRA, LDS_TOTAL = 147456;
#define BLK_BAR() do { asm volatile("s_waitcnt lgkmcnt(0)" ::: "memory"); __builtin_amdgcn_s_barrier(); asm volatile("" ::: "memory"); } while (0)

#define XB_TMO      128
#define XB_XCNT(j)  (256  + 64 * (j))
#define XB_XSUB(j)  (1280 + 64 * (j))
#define XB_XGEN(j)  (2304 + 64 * (j))
#define XB_TOP      3328
#define XB_TOPGEN   3392
#define XCD_BAR_WORDS 3456
#define XB_SPIN_CAP (1u << 18)

__device__ __forceinline__ unsigned xb_ld(unsigned* p)              { return __hip_atomic_load(p, __ATOMIC_RELAXED, __HIP_MEMORY_SCOPE_AGENT); }
__device__ __forceinline__ unsigned xb_add(unsigned* p, unsigned v) { return __hip_atomic_fetch_add(p, v, __ATOMIC_RELAXED, __HIP_MEMORY_SCOPE_AGENT); }
__device__ __forceinline__ unsigned xb_xcc_id() { return (unsigned)__builtin_amdgcn_s_getreg((3 << 11) | 20) & 0xFu; }
#define XB_SPIN(cond, bar) do { unsigned _sp = 0; while (cond) { __builtin_amdgcn_s_sleep(1); \
    if ((++_sp & 255u) == 0u) { if (xb_ld(&(bar)[XB_TMO])) break; if (_sp > XB_SPIN_CAP) { atomicAdd(&(bar)[XB_TMO], 1u); break; } } } } while (0)

struct XcdBarrier {
    unsigned* bar; unsigned x;
    volatile LAS unsigned* st;
};

__device__ __forceinline__ XcdBarrier xcd_barrier_post(unsigned* bar, volatile LAS unsigned* st) {
    XcdBarrier b; b.bar = bar; b.x = xb_xcc_id(); b.st = st;
    if (threadIdx.x == 0) (void)xb_add(&bar[XB_XCNT(b.x)], 1u);
    return b;
}
__device__ __forceinline__ void xcd_barrier_complete(unsigned* bar, unsigned x, unsigned& nloc, unsigned& nx) {
    const unsigned G = gridDim.x * gridDim.y * gridDim.z;
    unsigned sum, cnt, mine, sp = 0u;
    for (;;) {
        sum = 0u; cnt = 0u; mine = 0u;
#pragma unroll
        for (unsigned j = 0; j < 16; ++j) { const unsigned c = xb_ld(&bar[XB_XCNT(j)]); sum += c; cnt += (c > 0u) ? 1u : 0u; mine = (j == x) ? c : mine; }
        if (sum == G) break;
        __builtin_amdgcn_s_sleep(1);
        if ((++sp & 255u) == 0u) { if (xb_ld(&bar[XB_TMO])) break; if (sp > XB_SPIN_CAP) { atomicAdd(&bar[XB_TMO], 1u); break; } }
    }
    nloc = mine > 0u ? mine : 1u; nx = cnt > 0u ? cnt : 1u;
}

__device__ __forceinline__ void xcd_barrier(const XcdBarrier& b) {
    asm volatile("s_waitcnt vmcnt(0)" ::: "memory");
    __syncthreads();
    if (threadIdx.x == 0) {
        unsigned* bar = b.bar;
        __builtin_amdgcn_s_waitcnt(0);
        unsigned nloc = b.st[0], nx = b.st[1];
        if (nloc == 0u) { xcd_barrier_complete(bar, b.x, nloc, nx); b.st[0] = nloc; b.st[1] = nx; }
        const unsigned old = xb_add(&bar[XB_XSUB(b.x)], 1u);
        const unsigned gen = old / nloc;
        if (old + 1u == (gen + 1u) * nloc) {
            __builtin_amdgcn_fence(__ATOMIC_RELEASE, "agent");
            asm volatile("s_waitcnt vmcnt(0)" ::: "memory");
            const unsigned og = xb_add(&bar[XB_TOP], 1u);
            const unsigned tg = og / nx;
            if (og + 1u == (tg + 1u) * nx) xb_add(&bar[XB_TOPGEN], 1u);
            else XB_SPIN(xb_ld(&bar[XB_TOPGEN]) == tg, bar);
            __builtin_amdgcn_fence(__ATOMIC_ACQUIRE, "agent");
            xb_add(&bar[XB_XGEN(b.x)], 1u);
            asm volatile("s_waitcnt vmcnt(0)" ::: "memory");
        } else {
            XB_SPIN(xb_ld(&bar[XB_XGEN(b.x)]) == gen, bar);
            __builtin_amdgcn_fence(__ATOMIC_ACQUIRE, "agent");
            asm volatile("s_waitcnt vmcnt(0)" ::: "memory");
        }
    }
    __syncthreads();
}


__device__ __forceinline__ float wave_sum(float v) {
#pragma unroll
    for (int o = 1; o < 64; o <<= 1) v += __shfl_xor(v, o);
    return v;
}
__device__ __forceinline__ bf16_t f2bf(float x) { return (bf16_t)(cvt_pk_bf16(x, 0.f) & 0xffffu); }

__device__ __forceinline__ int colmap(int mode, int R) {
    const int hc = (R & 96) + pg8::perm32(R & 31);
    const int bj = (R >> 7) & 1, tile = R >> 8;
    if (mode == 0) return (R & ~127) + hc;
    if (mode == 1) { if (tile < 8) return (bj ? 2048 : 0) + 128 * tile + hc;
        const int type = (tile - 8) >> 2, tl = (tile - 8) & 3; const int base = type == 0 ? 1024 : type == 1 ? 3072 : type == 2 ? 4096 : type == 3 ? 5120 : 6144;
        return base + 256 * tl + 128 * bj + hc; }
    return (bj ? DFF : 0) + 128 * tile + hc;
}

template <int RT, int NG, class F>
__device__ __forceinline__ void sample_item(LAS unsigned char* lds, const bf16_t* A, int lda, int rt0, const bf16_t* Bt, int ldb, const int (&gr)[NG], int K, const F& f) {
    static_assert(8 * RT * NG * 1024 <= LDS_STAGE, "sample_item: the eight partial tiles must fit the stage region");
    int tid_ = threadIdx.x; asm volatile("" : "+v"(tid_));
    const int tid = tid_, w = __builtin_amdgcn_readfirstlane(tid >> 6), lane = tid & 63, fr = lane & 15, fq = lane >> 4;
    const int kper = K >> 3, nks = kper >> 5;
    f32x4 acc[RT][NG];
#pragma unroll
    for (int rt = 0; rt < RT; ++rt)
#pragma unroll
        for (int g = 0; g < NG; ++g) acc[rt][g] = (f32x4){0.f, 0.f, 0.f, 0.f};
    const bf16_t* ap = A + (size_t)(16 * rt0 + fr) * lda + w * kper + 8 * fq;
    const bf16_t* bp[NG];
#pragma unroll
    for (int g = 0; g < NG; ++g) bp[g] = Bt + (size_t)(gr[g] + fr) * ldb + w * kper + 8 * fq;
#pragma unroll 2
    for (int ks = 0; ks < nks; ++ks) {
        bf16x8 a[RT], b[NG];
#pragma unroll
        for (int rt = 0; rt < RT; ++rt) a[rt] = *(const bf16x8*)(ap + (size_t)(16 * rt) * lda + 32 * ks);
#pragma unroll
        for (int g = 0; g < NG; ++g) b[g] = *(const bf16x8*)(bp[g] + 32 * ks);
#pragma unroll
        for (int rt = 0; rt < RT; ++rt)
#pragma unroll
            for (int g = 0; g < NG; ++g) acc[rt][g] = __builtin_amdgcn_mfma_f32_16x16x32_bf16(b[g], a[rt], acc[rt][g], 0, 0, 0);
    }
    LAS float* P = (LAS float*)lds;
#pragma unroll
    for (int rt = 0; rt < RT; ++rt)
#pragma unroll
        for (int g = 0; g < NG; ++g) *(LAS f32x4*)(P + ((w * RT + rt) * NG + g) * 256 + fr * 16 + 4 * fq) = acc[rt][g];
    BLK_BAR();
#pragma unroll
    for (int q = 0; q < RT * 256 / 512; ++q) {
        const int e = tid + 512 * q, rt = e >> 8, rc = e & 255;
        float v[NG];
#pragma unroll
        for (int g = 0; g < NG; ++g) { float s = 0.f;
#pragma unroll
            for (int w8 = 0; w8 < 8; ++w8) s += P[((w8 * RT + rt) * NG + g) * 256 + rc];
            v[g] = s; }
        f(16 * (rt0 + rt) + (rc >> 4), rc & 15, v);
    }
    BLK_BAR();
}
__device__ __forceinline__ float grp16_sum(float s) {
    s += __shfl_xor(s, 1); s += __shfl_xor(s, 2); s += __shfl_xor(s, 4); s += __shfl_xor(s, 8); return s;
}
__device__ __forceinline__ void sample_rstd_table(LAS float* tab, const float* ssq_s) {
    const int tid = threadIdx.x;
    if (tid < MS) { const f32x4* p = (const f32x4*)(ssq_s + (size_t)tid * 32); float s = 0.f;
#pragma unroll
        for (int q = 0; q < 8; ++q) { const f32x4 a = p[q]; s += (a[0] + a[1]) + (a[2] + a[3]); }
        tab[tid] = 1.0f / sqrtf(s * (1.0f / D) + EPS); }
    BLK_BAR();
}

struct SfInA {
    Ctx cx; int R0;
    __device__ __forceinline__ void operator()(int i, int c, const float (&v)[3]) const {
        const KPtr kp = kargs(); const float* rstd0 = (const float*)(cx.ws + WS_RSTD0); const float* wca = kp->w_conv_a; const float* sa = kp->st_a; bf16_t* ba = (bf16_t*)(cx.ws + WS_BA); float* out = cx.out;
        const int ch = colmap(1, R0 + c); const float rs = rstd0[MP + i];
        const float cav = (v[0] * rs) * (v[1] * rs), bb = v[2] * rs;
        out[O_CAS + (size_t)(i * 2 + 1) * D + ch] = cav;
        const float conv = wca[ch] * sa[(size_t)(i * 2) * D + ch] + wca[D + ch] * sa[(size_t)(i * 2 + 1) * D + ch] + wca[2 * D + ch] * cav;
        ba[(size_t)(MP + i) * D + ch] = f2bf(bb * conv);
    }
};
struct SfInB {
    Ctx cx; int R0, type, slot;
    __device__ __forceinline__ void operator()(int i, int c, const float (&v)[2]) const {
        const float* rstd0 = (const float*)(cx.ws + WS_RSTD0); float* vssq_s = (float*)(cx.ws + WS_VSSQS);
        bf16_t* dst = type == 0 ? (bf16_t*)(cx.ws + WS_UU) : type == 1 ? (bf16_t*)(cx.ws + WS_VP) : type == 2 ? (bf16_t*)(cx.ws + WS_SGA) : (bf16_t*)cx.out;
        const int base = type == 0 ? 3072 : type == 1 ? 4096 : type == 2 ? 5120 : 6144;
        const float rs = rstd0[MP + i]; float s = 0.f;
#pragma unroll
        for (int g = 0; g < 2; ++g) { const int col = colmap(1, R0 + 16 * g + c) - base; float x = v[g] * rs;
            x = type <= 1 ? gelu_tanh(x) : sigmoid_f(x); s += x * x;
            dst[(size_t)(MP + i) * D + col] = f2bf(x); }
        if (type == 1) { s = grp16_sum(s); if (c == 0) vssq_s[i * 32 + slot] = s; }
    }
};
struct SfYa { Ctx cx; int R0;
    __device__ __forceinline__ void operator()(int i, int c, const float (&v)[2]) const {
        const bf16_t* sga = (const bf16_t*)(cx.ws + WS_SGA); float* t1s = (float*)(cx.ws + WS_T1S);
#pragma unroll
        for (int g = 0; g < 2; ++g) { const int col = colmap(0, R0 + 16 * g + c); t1s[i * D + col] = bf2f(sga[(size_t)(MP + i) * D + col]) * v[g]; }
    }
};
struct SfYb { Ctx cx; int R0;
    __device__ __forceinline__ void operator()(int i, int c, const float (&v)[2]) const {
        const bf16_t* sgb = (const bf16_t*)cx.out; const float* t1s = (const float*)(cx.ws + WS_T1S); bf16_t* mm = (bf16_t*)(cx.ws + WS_XB);
#pragma unroll
        for (int g = 0; g < 2; ++g) { const int col = colmap(0, R0 + 16 * g + c); mm[(size_t)(MP + i) * D + col] = f2bf(t1s[i * D + col] + bf2f(sgb[(size_t)(MP + i) * D + col]) * v[g]); }
    }
};
struct SfRes {
    Ctx cx; int R0, slot, which;
    __device__ __forceinline__ void operator()(int i, int c, const float (&v)[2]) const {
        float* h = cx.out; const float* base = which == 0 ? kargs()->x_s : h + (size_t)MP * D; bf16_t* hb = (bf16_t*)(cx.ws + (which == 0 ? WS_H1B : WS_H2B)); float* ssq_s = (float*)(cx.ws + (which == 0 ? WS_SSQ1S : WS_SSQ2S));
        float s = 0.f;
#pragma unroll
        for (int g = 0; g < 2; ++g) { const int col = colmap(0, R0 + 16 * g + c); const float x = base[(size_t)i * D + col] + v[g];
            h[(size_t)(MP + i) * D + col] = x; hb[(size_t)(MP + i) * D + col] = f2bf(x); s += x * x; }
        s = grp16_sum(s); if (c == 0) ssq_s[i * 32 + slot] = s;
    }
};
struct SfUp {
    Ctx cx; const LAS float* rs; int R0;
    __device__ __forceinline__ void operator()(int i, int c, const float (&v)[2]) const {
        const KPtr kp = kargs(); const float* wcf = kp->w_conv_f; const float* sf = kp->st_f; bf16_t* a3 = (bf16_t*)(cx.ws + WS_A3); float* out = cx.out;
        const int ja = colmap(2, R0 + c), jb = ja + DFF; const float r = rs[i];
        const float ua = v[0] * r, ub = v[1] * r;
        float* o = out + O_CFS + (size_t)(i * 2 + 1) * NUP; o[ja] = ua; o[jb] = ub;
        const float* s0 = sf + (size_t)(i * 2) * NUP; const float* s1 = s0 + NUP;
        const float ca = wcf[ja] * s0[ja] + wcf[NUP + ja] * s1[ja] + wcf[2 * NUP + ja] * ua;
        const float cb = wcf[jb] * s0[jb] + wcf[NUP + jb] * s1[jb] + wcf[2 * NUP + jb] * ub;
        a3[(size_t)(MP + i) * DFF + ja] = f2bf(gelu_tanh(ca) * cb);
    }
};
struct SfPe { Ctx cx; int R0;
    __device__ __forceinline__ void operator()(int i, int c, const float (&v)[2]) const {
        float* pes = (float*)(cx.ws + WS_PES);
#pragma unroll
        for (int g = 0; g < 2; ++g) pes[i * D + colmap(0, R0 + 16 * g + c)] = v[g];
    }
};
struct SfGate { Ctx cx; const LAS float* rs; int R0;
    __device__ __forceinline__ void operator()(int i, int c, const float (&v)[2]) const {
        const float* pes = (const float*)(cx.ws + WS_PES); float* h = cx.out;
        const float r = rs[i];
#pragma unroll
        for (int g = 0; g < 2; ++g) { const int col = colmap(0, R0 + 16 * g + c); float* hp = h + (size_t)(MP + i) * D + col; *hp = *hp + sigmoid_f(r * v[g]) * pes[i * D + col]; }
    }
};

__device__ __forceinline__ void p0_rows(const KPtr P, bf16_t* xb, float* rstd0, bf16_t* pb) {
    const int tid = threadIdx.x, lane = tid & 63, gw = blockIdx.x * 8 + (tid >> 6), NGW = gridDim.x * 8;
    for (int r = gw; r < MV; r += NGW) {
        const f32x4* src = (const f32x4*)(r < MP ? P->x_p + (size_t)r * D : P->x_s + (size_t)(r - MP) * D) + lane;
        f32x4 v[4]; float s = 0.f;
#pragma unroll
        for (int j = 0; j < 4; ++j) { v[j] = src[64 * j]; s += sum4sq(v[j]); }
        s = wave_sum(s);
        if (lane == 0) rstd0[r] = 1.0f / sqrtf(s * (1.0f / D) + EPS);
        unsigned long long* o8 = (unsigned long long*)(xb + (size_t)r * D) + lane;
#pragma unroll
        for (int j = 0; j < 4; ++j) o8[64 * j] = (unsigned long long)cvt_pk_bf16(v[j][0], v[j][1]) | ((unsigned long long)cvt_pk_bf16(v[j][2], v[j][3]) << 32);
    }
    const size_t gt = (size_t)blockIdx.x * 512 + tid, gs = (size_t)gridDim.x * 512;
    for (size_t i4 = gt; i4 < (size_t)MV * PD / 4; i4 += gs) { const size_t i = i4 * 4;
        const f32x4 v = i < (size_t)MP * PD ? *(const f32x4*)(P->p_p + i) : *(const f32x4*)(P->p_s + (i - (size_t)MP * PD));
        *(unsigned long long*)(pb + i) = (unsigned long long)cvt_pk_bf16(v[0], v[1]) | ((unsigned long long)cvt_pk_bf16(v[2], v[3]) << 32); }
    for (size_t e = gt; e < (size_t)MS * (D + NUP); e += gs) { const int i = (int)(e / (D + NUP)), c = (int)(e % (D + NUP));
        if (c < D) P->out[O_CAS + (size_t)(i * 2) * D + c] = P->st_a[(size_t)(i * 2 + 1) * D + c];
        else P->out[O_CFS + (size_t)(i * 2) * NUP + (c - D)] = P->st_f[(size_t)(i * 2 + 1) * NUP + (c - D)]; }
}
__device__ __forceinline__ void wt_tile_load(const float* W, const float* scale, int Nw, int mode, int R0, int k0, LAS float* t, int ht) {
    const int tx = ht & 63, ty = ht >> 6; const int col = colmap(mode, R0 + tx);
#pragma unroll
    for (int i = 0; i < 16; ++i) { const int k = k0 + ty + 4 * i; t[(ty + 4 * i) * 65 + tx] = W[(size_t)k * Nw + col] * (scale ? scale[k] : 1.0f); }
}
__device__ __forceinline__ void wt_tile_store(bf16_t* out, int K, int R0, int k0, const LAS float* t, int ht) {
    const int Rl = ht >> 2, kq = ht & 3; const LAS float* s = t + (kq * 16) * 65 + Rl;
    u32x4 w0, w1;
    w0.x = cvt_pk_bf16(s[0 * 65], s[1 * 65]); w0.y = cvt_pk_bf16(s[2 * 65], s[3 * 65]); w0.z = cvt_pk_bf16(s[4 * 65], s[5 * 65]); w0.w = cvt_pk_bf16(s[6 * 65], s[7 * 65]);
    w1.x = cvt_pk_bf16(s[8 * 65], s[9 * 65]); w1.y = cvt_pk_bf16(s[10 * 65], s[11 * 65]); w1.z = cvt_pk_bf16(s[12 * 65], s[13 * 65]); w1.w = cvt_pk_bf16(s[14 * 65], s[15 * 65]);
    bf16_t* o = out + (size_t)(R0 + Rl) * K + k0 + kq * 16;
    *(u32x4*)o = w0; *(u32x4*)(o + 8) = w1;
}
struct WtJob { const float* W; const float* scale; bf16_t* out; int K, Nw, mode, R0, k0; };
__device__ __forceinline__ bool wt_decode(const KPtr P, unsigned char* ws, int it, WtJob& j) {
    constexpr int T_IN = (NIN / 64) * (D / 64), T_SQ = (D / 64) * (D / 64), T_UP = (NUP / 64) * (D / 64), T_DN = (D / 64) * (DFF / 64), T_PL = (D / 64) * (PD / 64);
    int nk;
    if (it < T_IN) { j.W = P->w_in; j.scale = P->g_mix; j.out = (bf16_t*)(ws + WS_WIN); j.K = D; j.Nw = NIN; j.mode = 1; nk = D / 64; }
    else if ((it -= T_IN) < T_SQ) { j.W = P->w_out_a; j.scale = nullptr; j.out = (bf16_t*)(ws + WS_WOA); j.K = D; j.Nw = D; j.mode = 0; nk = D / 64; }
    else if ((it -= T_SQ) < T_SQ) { j.W = P->w_out_b; j.scale = nullptr; j.out = (bf16_t*)(ws + WS_WOB); j.K = D; j.Nw = D; j.mode = 0; nk = D / 64; }
    else if ((it -= T_SQ) < T_SQ) { j.W = P->w_o; j.scale = nullptr; j.out = (bf16_t*)(ws + WS_WO); j.K = D; j.Nw = D; j.mode = 0; nk = D / 64; }
    else if ((it -= T_SQ) < T_SQ) { j.W = P->w_pg; j.scale = P->g_ple; j.out = (bf16_t*)(ws + WS_WPG); j.K = D; j.Nw = D; j.mode = 0; nk = D / 64; }
    else if ((it -= T_SQ) < T_UP) { j.W = P->w_up; j.scale = P->g_ffn; j.out = (bf16_t*)(ws + WS_WUP); j.K = D; j.Nw = NUP; j.mode = 2; nk = D / 64; }
    else if ((it -= T_UP) < T_DN) { j.W = P->w_down; j.scale = nullptr; j.out = (bf16_t*)(ws + WS_WDOWN); j.K = DFF; j.Nw = D; j.mode = 0; nk = DFF / 64; }
    else if ((it -= T_DN) < T_PL) { j.W = P->w_ple; j.scale = nullptr; j.out = (bf16_t*)(ws + WS_WPLE); j.K = PD; j.Nw = D; j.mode = 0; nk = PD / 64; }
    else return false;
    j.R0 = (it / nk) * 64; j.k0 = (it % nk) * 64; return true;
}
constexpr int WT_TILES = (NIN / 64) * (D / 64) + 4 * (D / 64) * (D / 64) + (NUP / 64) * (D / 64) + (D / 64) * (DFF / 64) + (D / 64) * (PD / 64);
__device__ __forceinline__ void p0_weights(const KPtr P, unsigned char* ws, LAS unsigned char* lds) {
    const int tid = threadIdx.x, half = tid >> 8, ht = tid & 255;
    LAS float* t = (LAS float*)lds + half * (64 * 65);
    for (int base = blockIdx.x * 2; base < WT_TILES; base += gridDim.x * 2) {
        WtJob j; const bool ok = wt_decode(P, ws, base + half, j);
        if (ok) wt_tile_load(j.W, j.scale, j.Nw, j.mode, j.R0, j.k0, t, ht);
        BLK_BAR();
        if (ok) wt_tile_store(j.out, j.K, j.R0, j.k0, t, ht);
        BLK_BAR();
    }
}
__device__ __forceinline__ void p2_convA(const bf16_t* ca, bf16_t* ba, const float* wc) {
    const f32x4 z = (f32x4){0.f, 0.f, 0.f, 0.f};
    for (size_t idx = (size_t)blockIdx.x * 512 + threadIdx.x; idx < (size_t)MP * 128; idx += (size_t)gridDim.x * 512) {
        const int r = (int)(idx >> 7), j = (int)(idx & 127) * 8, t = r & (SEQ - 1);
        f32x4 c0a, c0b, c1a = z, c1b = z, c2a = z, c2b = z;
        load8_bf16(ca + (size_t)r * D + j, c0a, c0b);
        if (t >= 1) load8_bf16(ca + (size_t)(r - 1) * D + j, c1a, c1b);
        if (t >= 2) load8_bf16(ca + (size_t)(r - 2) * D + j, c2a, c2b);
        const f32x4 w0a = *(const f32x4*)(wc + j), w0b = *(const f32x4*)(wc + j + 4), w1a = *(const f32x4*)(wc + D + j), w1b = *(const f32x4*)(wc + D + j + 4),
                    w2a = *(const f32x4*)(wc + 2 * D + j), w2b = *(const f32x4*)(wc + 2 * D + j + 4);
        f32x4 b0, b1; load8_bf16(ba + (size_t)r * D + j, b0, b1);
        store8_bf16(ba + (size_t)r * D + j, b0 * (w0a * c2a + w1a * c1a + w2a * c0a), b1 * (w0b * c2b + w1b * c1b + w2b * c0b));
    }
}
__device__ __forceinline__ unsigned sp_off(unsigned row, unsigned ch) { return 256u * row + 16u * (ch ^ (((row & 3u) << 2) | ((row >> 2) & 3u))); }
typedef unsigned short u16x4_t __attribute__((ext_vector_type(4)));
__device__ __forceinline__ void p2_spatial(const KPtr P, LAS unsigned char* lds, const bf16_t* vp, bf16_t* uu, const float* vssq) {
    int tid_ = threadIdx.x; asm volatile("" : "+v"(tid_));
    const int tid = tid_, w = __builtin_amdgcn_readfirstlane(tid >> 6), lane = tid & 63, fr = lane & 15, fq = lane >> 4;
    LAS unsigned char* Vimg = lds; LAS unsigned char* Wimg = lds + 32768; LAS float* rs = (LAS float*)(lds + 65536);
    const float* gv = P->g_v; const float* wsp = P->w_sp; const float* bsp = P->b_sp; float* out = P->out;
    int g_loaded = -1;
    for (int it = blockIdx.x; it < (MP / 128) * 8; it += gridDim.x) {
        const int g = it & 7, c = it >> 3, r0 = c * 128, d0 = g * 128;
        if (tid < 128) { const f32x4* p = (const f32x4*)(vssq + (size_t)(r0 + tid) * 16); float s = 0.f;
#pragma unroll
            for (int q = 0; q < 4; ++q) { const f32x4 a = p[q]; s += (a[0] + a[1]) + (a[2] + a[3]); }
            rs[tid] = 1.0f / sqrtf(s * (1.0f / D) + EPS); }
        if (g != g_loaded) {
            const float* W = wsp + (size_t)g * 128 * 128;
#pragma unroll
            for (int i = 0; i < 4; ++i) { const int n = tid + 512 * i, t = n >> 4, ch = n & 15, s0 = 8 * ch;
                f32x4 a = *(const f32x4*)(W + t * 128 + s0), b = *(const f32x4*)(W + t * 128 + s0 + 4);
#pragma unroll
                for (int j = 0; j < 4; ++j) { if (s0 + j > t) a[j] = 0.f; if (s0 + 4 + j > t) b[j] = 0.f; }
                u32x4 pk; pk.x = cvt_pk_bf16(a[0], a[1]); pk.y = cvt_pk_bf16(a[2], a[3]); pk.z = cvt_pk_bf16(b[0], b[1]); pk.w = cvt_pk_bf16(b[2], b[3]);
                *(LAS u32x4*)(Wimg + sp_off(t, ch)) = pk; }
            g_loaded = g;
        }
        BLK_BAR();
        const bool last = (c & 15) == 15; const int b = c >> 4;
#pragma unroll
        for (int i = 0; i < 4; ++i) { const int n = tid + 512 * i, s = n >> 4, ch = n & 15;
            f32x4 a, bq; load8_bf16(vp + (size_t)(r0 + s) * D + d0 + 8 * ch, a, bq);
            const float r = rs[s]; const f32x4 ga = *(const f32x4*)(gv + d0 + 8 * ch), gb = *(const f32x4*)(gv + d0 + 8 * ch + 4);
            a = a * r * ga; bq = bq * r * gb;
            if (last) { float* o = out + O_CVP + ((size_t)(b * 128 + s)) * D + d0 + 8 * ch; *(f32x4*)o = a; *(f32x4*)(o + 4) = bq; }
            u32x4 pk; pk.x = cvt_pk_bf16(a[0], a[1]); pk.y = cvt_pk_bf16(a[2], a[3]); pk.z = cvt_pk_bf16(bq[0], bq[1]); pk.w = cvt_pk_bf16(bq[2], bq[3]);
            *(LAS u32x4*)(Vimg + sp_off(s, ch)) = pk; }
        BLK_BAR();
        const unsigned q4 = (unsigned)(fr >> 2), p4 = (unsigned)(fr & 3);
        const unsigned vbase = (unsigned)(size_t)Vimg;
        const unsigned a0 = vbase + sp_off(8u * fq + q4, 2u * w + (p4 >> 1)) + 8u * (p4 & 1u);
        const unsigned a1 = vbase + sp_off(8u * fq + 4u + q4, 2u * w + (p4 >> 1)) + 8u * (p4 & 1u);
        u16x4_t v00, v01, v10, v11, v20, v21, v30, v31;
        asm volatile("ds_read_b64_tr_b16 %0, %8\n\tds_read_b64_tr_b16 %1, %9\n\tds_read_b64_tr_b16 %2, %8 offset:8192\n\tds_read_b64_tr_b16 %3, %9 offset:8192\n\t"
                     "ds_read_b64_tr_b16 %4, %8 offset:16384\n\tds_read_b64_tr_b16 %5, %9 offset:16384\n\tds_read_b64_tr_b16 %6, %8 offset:24576\n\tds_read_b64_tr_b16 %7, %9 offset:24576\n\t"
                     "s_waitcnt lgkmcnt(0)"
                     : "=&v"(v00), "=&v"(v01), "=&v"(v10), "=&v"(v11), "=&v"(v20), "=&v"(v21), "=&v"(v30), "=&v"(v31) : "v"(a0), "v"(a1) : "memory");
        bf16x8 Vf[4];
        Vf[0] = (bf16x8){(short)v00[0], (short)v00[1], (short)v00[2], (short)v00[3], (short)v01[0], (short)v01[1], (short)v01[2], (short)v01[3]};
        Vf[1] = (bf16x8){(short)v10[0], (short)v10[1], (short)v10[2], (short)v10[3], (short)v11[0], (short)v11[1], (short)v11[2], (short)v11[3]};
        Vf[2] = (bf16x8){(short)v20[0], (short)v20[1], (short)v20[2], (short)v20[3], (short)v21[0], (short)v21[1], (short)v21[2], (short)v21[3]};
        Vf[3] = (bf16x8){(short)v30[0], (short)v30[1], (short)v30[2], (short)v30[3], (short)v31[0], (short)v31[1], (short)v31[2], (short)v31[3]};
        f32x4 acc[8];
#pragma unroll
        for (int tt = 0; tt < 8; ++tt) { acc[tt] = (f32x4){0.f, 0.f, 0.f, 0.f};
#pragma unroll
            for (int ks = 0; ks < 4; ++ks) if (2 * ks <= tt) {
                const bf16x8 Wf = *(const LAS bf16x8*)(Wimg + sp_off((unsigned)(16 * tt + fr), (unsigned)(4 * ks + fq)));
                acc[tt] = __builtin_amdgcn_mfma_f32_16x16x32_bf16(Vf[ks], Wf, acc[tt], 0, 0, 0); } }
#pragma unroll
        for (int tt = 0; tt < 8; ++tt) { const int t = 16 * tt + fr; const float bb = bsp[g * 128 + t];
            bf16_t* up = uu + (size_t)(r0 + t) * D + d0 + 16 * w + 4 * fq;
            const unsigned long long uw = *(const unsigned long long*)up;
            const float u0 = __uint_as_float((unsigned)(uw << 16)), u1 = __uint_as_float((unsigned)uw & 0xffff0000u), u2 = __uint_as_float((unsigned)(uw >> 32) << 16), u3 = __uint_as_float((unsigned)(uw >> 32) & 0xffff0000u);
            const f32x4 s4 = acc[tt] + bb;
            *(unsigned long long*)up = (unsigned long long)cvt_pk_bf16(u0 * s4[0], u1 * s4[1]) | ((unsigned long long)cvt_pk_bf16(u2 * s4[2], u3 * s4[3]) << 32); }
        BLK_BAR();
    }
}
__device__ __forceinline__ void p2_spatial_s(const KPtr P, const bf16_t* vp, bf16_t* uu, const float* vssq_s) {
    const int tid = threadIdx.x, lane = tid & 63, gw = blockIdx.x * 8 + (tid >> 6), NGW = gridDim.x * 8;
    for (int i = gw; i < MS; i += NGW) {
        float s = lane < 32 ? vssq_s[i * 32 + lane] : 0.f; s = wave_sum(s);
        const float rsv = 1.0f / sqrtf(s * (1.0f / D) + EPS); const size_t r = (size_t)(MP + i) * D;
        for (int d = lane; d < D; d += 64) { const int g = d >> 7;
            const float vnv = bf2f(vp[r + d]) * rsv * P->g_v[d];
            P->out[O_CVS + (size_t)i * D + d] = vnv;
            uu[r + d] = f2bf(bf2f(uu[r + d]) * (P->w_sp[(size_t)g * 128 * 128] * vnv + P->b_sp[g * 128])); }
    }
}
__device__ __forceinline__ void p5_convF(const bf16_t* uph, bf16_t* a3, const float* wcf, int half) {
    const f32x4 z = (f32x4){0.f, 0.f, 0.f, 0.f};
    for (size_t idx = (size_t)blockIdx.x * 512 + threadIdx.x; idx < (size_t)MP * 176; idx += (size_t)gridDim.x * 512) {
        const int c8 = (int)(idx & 15), t = (int)((idx >> 4) % 11), r = (int)(idx / 176), tt = r & (SEQ - 1);
        const int c = c8 * 8, ja = 1408 * half + 128 * t + c, jb = DFF + ja;
        const bf16_t* pa = uph + (size_t)r * DFF + 256 * t + c; const bf16_t* pb = pa + 128;
        f32x4 a0[2], a1[2], a2[2], b0[2], b1[2], b2[2];
        load8_bf16(pa, a0[0], a0[1]); load8_bf16(pb, b0[0], b0[1]);
        if (tt >= 1) { load8_bf16(pa - DFF, a1[0], a1[1]); load8_bf16(pb - DFF, b1[0], b1[1]); } else { a1[0] = a1[1] = b1[0] = b1[1] = z; }
        if (tt >= 2) { load8_bf16(pa - 2 * DFF, a2[0], a2[1]); load8_bf16(pb - 2 * DFF, b2[0], b2[1]); } else { a2[0] = a2[1] = b2[0] = b2[1] = z; }
        f32x4 o[2];
#pragma unroll
        for (int q = 0; q < 2; ++q) {
            const f32x4 wa0 = *(const f32x4*)(wcf + ja + 4 * q), wa1 = *(const f32x4*)(wcf + NUP + ja + 4 * q), wa2 = *(const f32x4*)(wcf + 2 * NUP + ja + 4 * q);
            const f32x4 wb0 = *(const f32x4*)(wcf + jb + 4 * q), wb1 = *(const f32x4*)(wcf + NUP + jb + 4 * q), wb2 = *(const f32x4*)(wcf + 2 * NUP + jb + 4 * q);
            f32x4 cav = wa0 * a2[q] + wa1 * a1[q] + wa2 * a0[q]; const f32x4 cbv = wb0 * b2[q] + wb1 * b1[q] + wb2 * b0[q];
#pragma unroll
            for (int j = 0; j < 4; ++j) cav[j] = gelu_tanh(cav[j]);
            o[q] = cav * cbv; }
        store8_bf16(a3 + (size_t)r * DFF + ja, o[0], o[1]);
    }
}
__device__ __forceinline__ void p8_final(float* h, const float* gf) {
    const int tid = threadIdx.x, lane = tid & 63, gw = blockIdx.x * 8 + (tid >> 6), NGW = gridDim.x * 8;
    for (int r = gw; r < MV; r += NGW) {
        f32x4* p = (f32x4*)(h + (size_t)r * D) + lane; f32x4 v[4]; float s = 0.f;
#pragma unroll
        for (int j = 0; j < 4; ++j) { v[j] = p[64 * j]; s += sum4sq(v[j]); }
        s = wave_sum(s); const float rs = 1.0f / sqrtf(s * (1.0f / D) + EPS);
#pragma unroll
        for (int j = 0; j < 4; ++j) { const f32x4 g = *((const f32x4*)gf + lane + 64 * j); p[64 * j] = v[j] * rs * g; }
    }
}

__device__ __forceinline__ void p6_fixup(const Ctx c, const KPtr P, int pm) {
    if ((pm & 7) == 0) return;
    const float* hb = WSP(const float, WS_HB); bf16_t* a3 = WSP(bf16_t, WS_A3); const float* wcf = P->w_conv_f;
    const float* pv = hb + ((size_t)(pm - 1) * 4) * NUP;
    const float* cu = hb + ((size_t)pm * 4 + 2) * NUP;
    for (int e = threadIdx.x; e < 2 * (DFF / 4); e += 512) { const int row = e / (DFF / 4), ja = (e % (DFF / 4)) * 4, jb = DFF + ja;
        f32x4 cv[2];
#pragma unroll
        for (int s = 0; s < 2; ++s) { const int j = s ? jb : ja;
            const f32x4 w0 = *(const f32x4*)(wcf + j), w1 = *(const f32x4*)(wcf + NUP + j), w2 = *(const f32x4*)(wcf + 2 * NUP + j);
            const f32x4 m2 = row == 0 ? *(const f32x4*)(pv + j) : *(const f32x4*)(pv + NUP + j);
            const f32x4 m1 = row == 0 ? *(const f32x4*)(pv + NUP + j) : *(const f32x4*)(cu + j);
            const f32x4 m0 = row == 0 ? *(const f32x4*)(cu + j) : *(const f32x4*)(cu + NUP + j);
            cv[s] = w0 * m2 + w1 * m1 + w2 * m0; }
        f32x4 o;
#pragma unroll
        for (int j = 0; j < 4; ++j) o[j] = gelu_tanh(cv[0][j]) * cv[1][j];
        *(unsigned long long*)(a3 + (size_t)(pm * 256 + row) * DFF + ja) = (unsigned long long)cvt_pk_bf16(o[0], o[1]) | ((unsigned long long)cvt_pk_bf16(o[2], o[3]) << 32); }
    asm volatile("s_waitcnt vmcnt(0)" ::: "memory");
    __syncthreads();
}
template <class Epi> __device__ __forceinline__ void run_gemm(LAS unsigned char* lds, const bf16_t* A, int lda, const bf16_t* Bt, int ldb, int N, int K, const Epi& E) {
    pg8::Gemm g; g.A = A; g.Bt = Bt; g.M = MP; g.N = N; g.K = K; g.lda = lda; g.ldb = ldb; g.pad = 0;
    pg8::StaticOrder S; S.init(MP, N, (int)gridDim.x, (int)blockIdx.x);
    pg8::gemm_phase<Epi, pg8::StaticOrder, true, true>(lds, g, S, E);
}

#ifndef PROBE_A
#define PROBE_A -1
#define PROBE_B -1
#endif
template <class Epi> __device__ __forceinline__ void run_gemm2(LAS unsigned char* lds, const Ctx c, size_t a_off, int lda, size_t b_off, int ldb, int N, int K, const Epi& E) {
    pg8::Gemm g; g.A = (const bf16_t*)(c.ws + a_off); g.Bt = (const bf16_t*)(c.ws + b_off); g.M = MP; g.N = N; g.K = K; g.lda = lda; g.ldb = ldb; g.pad = 0;
    pg8::StaticOrder S; S.init(MP, N, (int)gridDim.x, (int)blockIdx.x);
    pg8::gemm_phase<Epi, pg8::StaticOrder, true, true>(lds, g, S, E);
}
__global__ void __launch_bounds__(512, 2) mega_fwd(Ptrs P_unused) {
    extern __shared__ __attribute__((aligned(16))) unsigned char lds_raw[];
    LAS unsigned char* lds = (LAS unsigned char*)lds_raw;
    volatile LAS unsigned* MISC = (volatile LAS unsigned*)(lds + LDS_CTL_OFF);
    if (threadIdx.x < 128) MISC[threadIdx.x] = 0u;
    __syncthreads();
    Ctx c; { const KPtr kp = kargs(); c.ws = kp->ws; c.out = kp->out; }
    XcdBarrier bar = xcd_barrier_post((unsigned*)(c.ws + WS_CTL), MISC + 8);
    enum { CNT0 = __COUNTER__ };
#define STAMP(k) do { if (PROBE_A >= 0 && threadIdx.x == 0) ((volatile LAS unsigned*)(lds + LDS_CTL_OFF + 256))[k] = (unsigned)__builtin_amdgcn_s_memrealtime(); } while (0)
#define GRID_BAR() do { xcd_barrier(bar); STAMP(__COUNTER__ - CNT0); } while (0)
    STAMP(0);
    LAS float* rstab = (LAS float*)(lds + LDS_XTRA_OFF);
    const int G = gridDim.x, bid = blockIdx.x;

    { const KPtr kp = kargs();
      p0_rows(kp, WSP(bf16_t, WS_XB), WSP(float, WS_RSTD0), WSP(bf16_t, WS_PB));
      p0_weights(kp, c.ws, lds); }
    GRID_BAR();
    { EpiIn E; E.c = c; run_gemm2(lds, c, WS_XB, D, WS_WIN, D, NIN, D, E); }
    for (int it = bid; it < 256; it += G) {
        const bf16_t* As = WSP(const bf16_t, WS_XB) + (size_t)MP * D; const bf16_t* Bt = WSP(const bf16_t, WS_WIN);
        if (it < 128) { const int rh = it >> 6, i6 = it & 63, t = i6 >> 3, wc = (i6 >> 1) & 3, n = i6 & 1, Rx = t * 256 + wc * 32 + n * 16;
            const int gr[3] = {Rx, Rx + 128, (8 + (t >> 1)) * 256 + (t & 1) * 128 + wc * 32 + n * 16};
            SfInA f; f.cx = c; f.R0 = Rx;
            sample_item<4, 3>(lds, As, D, 4 * rh, Bt, D, gr, D, f);
        } else { const int j = it - 128, tile = 12 + (j >> 3), bj = (j >> 2) & 1, wc = j & 3, R0 = tile * 256 + bj * 128 + wc * 32, type = (tile - 12) >> 2;
            const int gr[2] = {R0, R0 + 16};
            SfInB f; f.cx = c; f.R0 = R0; f.type = type; f.slot = ((tile - 16) & 3) * 8 + bj * 4 + wc;
            sample_item<8, 2>(lds, As, D, 0, Bt, D, gr, D, f); }
    }
    GRID_BAR();
    { const KPtr kp = kargs();
      p2_convA(WSP(const bf16_t, WS_CA), WSP(bf16_t, WS_BA), kp->w_conv_a);
      p2_spatial(kp, lds, WSP(const bf16_t, WS_VP), WSP(bf16_t, WS_UU), WSP(const float, WS_VSSQ));
      p2_spatial_s(kp, WSP(const bf16_t, WS_VP), WSP(bf16_t, WS_UU), WSP(const float, WS_VSSQS)); }
    GRID_BAR();
    { EpiYa E; E.c = c; run_gemm2(lds, c, WS_BA, D, WS_WOA, D, D, D, E); }
    for (int it = bid; it < 32; it += G) { const int gr[2] = {it * 32, it * 32 + 16}; SfYa f; f.cx = c; f.R0 = it * 32;
        sample_item<8, 2>(lds, WSP(const bf16_t, WS_BA) + (size_t)MP * D, D, 0, WSP(const bf16_t, WS_WOA), D, gr, D, f); }
    GRID_BAR();
    { EpiYb E; E.c = c; run_gemm2(lds, c, WS_UU, D, WS_WOB, D, D, D, E); }
    for (int it = bid; it < 32; it += G) { const int gr[2] = {it * 32, it * 32 + 16}; SfYb f; f.cx = c; f.R0 = it * 32;
        sample_item<8, 2>(lds, WSP(const bf16_t, WS_UU) + (size_t)MP * D, D, 0, WSP(const bf16_t, WS_WOB), D, gr, D, f); }
    GRID_BAR();
    { EpiRes<0> E; E.c = c; run_gemm2(lds, c, WS_XB, D, WS_WO, D, D, D, E); }
    for (int it = bid; it < 32; it += G) { const int gr[2] = {it * 32, it * 32 + 16}; SfRes f; f.cx = c; f.R0 = it * 32; f.slot = it; f.which = 0;
        sample_item<8, 2>(lds, WSP(const bf16_t, WS_XB) + (size_t)MP * D, D, 0, WSP(const bf16_t, WS_WO), D, gr, D, f); }
    GRID_BAR();
    { EpiUpF E; E.c = c; E.halo = (LAS float*)(lds + LDS_XTRA_OFF); run_gemm2(lds, c, WS_H1B, D, WS_WUP, D, NUP, D, E); }
    if (bid < 176) sample_rstd_table(rstab, WSP(const float, WS_SSQ1S));
    for (int it = bid; it < 176; it += G) { const int T = it >> 3, wc = (it >> 1) & 3, n = it & 1, Ra = T * 256 + wc * 32 + n * 16; const int gr[2] = {Ra, Ra + 128};
        SfUp f; f.cx = c; f.rs = rstab; f.R0 = Ra;
        sample_item<8, 2>(lds, WSP(const bf16_t, WS_H1B) + (size_t)MP * D, D, 0, WSP(const bf16_t, WS_WUP), D, gr, D, f); }
    GRID_BAR();
    { pg8::StaticOrder S0; S0.init(MP, D, G, bid); pg8::Unit u0; for (int i = 0; S0.next(i, u0); ++i) p6_fixup(c, kargs(), u0.pm); }
    { EpiRes<1> E; E.c = c; run_gemm2(lds, c, WS_A3, DFF, WS_WDOWN, DFF, D, DFF, E); }
    for (int it = bid; it < 128; it += G) { const int rg = it >> 5, cg = it & 31; const int gr[2] = {cg * 32, cg * 32 + 16};
        SfRes f; f.cx = c; f.R0 = cg * 32; f.slot = cg; f.which = 1;
        sample_item<2, 2>(lds, WSP(const bf16_t, WS_A3) + (size_t)MP * DFF, DFF, 2 * rg, WSP(const bf16_t, WS_WDOWN), DFF, gr, DFF, f); }
    GRID_BAR();
    { EpiPe E; E.c = c; run_gemm2(lds, c, WS_PB, PD, WS_WPLE, PD, D, PD, E); }
    { EpiGate E; E.c = c; run_gemm2(lds, c, WS_H2B, D, WS_WPG, D, D, D, E); }
    if (bid < 32) sample_rstd_table(rstab, WSP(const float, WS_SSQ2S));
    for (int it = bid; it < 32; it += G) { const int gr[2] = {it * 32, it * 32 + 16};
        { SfPe f; f.cx = c; f.R0 = it * 32; sample_item<8, 2>(lds, WSP(const bf16_t, WS_PB) + (size_t)MP * PD, PD, 0, WSP(const bf16_t, WS_WPLE), PD, gr, PD, f); }
        { SfGate f; f.cx = c; f.rs = rstab; f.R0 = it * 32; sample_item<8, 2>(lds, WSP(const bf16_t, WS_H2B) + (size_t)MP * D, D, 0, WSP(const bf16_t, WS_WPG), D, gr, D, f); } }
    GRID_BAR();
    p8_final(c.out, kargs()->g_final);
#if PROBE_A >= 0
    GRID_BAR();
    if (bid == 0) {
        volatile LAS unsigned* tsl = (volatile LAS unsigned*)(lds + LDS_CTL_OFF + 256);
        const float da = (float)(tsl[PROBE_A + 1] - tsl[PROBE_A]) * 0.01f;
        const float db = (float)(tsl[PROBE_B + 1] - tsl[PROBE_B]) * 0.01f;
        const float sc = 1.0f + da * 0.001f;
        for (int i = threadIdx.x; i < MS * D; i += 512) c.out[(size_t)MP * D + i] *= sc;
        if (threadIdx.x == 0) c.out[O_CAP] += db;
    }
#endif
}

extern "C" void kernel_launch(void* const* d_in, const int* in_sizes, int n_in, void* d_out, int out_size, void* d_ws, size_t ws_size, hipStream_t stream) {
    (void)in_sizes; (void)n_in; (void)out_size; (void)ws_size;
    static int grid = 0;
    if (grid == 0) {
        int dev = 0, cus = 0, per_cu = 0;
        (void)hipGetDevice(&dev); (void)hipDeviceGetAttribute(&cus, hipDeviceAttributeMultiprocessorCount, dev);
        (void)hipFuncSetAttribute((const void*)mega_fwd, hipFuncAttributeMaxDynamicSharedMemorySize, LDS_TOTAL);
        if (hipOccupancyMaxActiveBlocksPerMultiprocessor(&per_cu, (const void*)mega_fwd, 512, LDS_TOTAL) != hipSuccess || per_cu < 1) { per_cu = 1; (void)hipGetLastError(); }
        grid = cus * (per_cu > 1 ? 1 : per_cu);
        if (grid <= 0) grid = 256;
    }
    (void)hipMemsetAsync((char*)d_ws + WS_CTL, 0, CTL_BYTES, stream);
    Ptrs P{};
    const float** pf = (const float**)&P;
    for (int i = 0; i < 23; ++i) pf[i] = (const float*)d_in[i];
    P.out = (float*)d_out; P.ws = (unsigned char*)d_ws;
    void* args[] = {&P};
    hipError_t e = hipLaunchCooperativeKernel((const void*)mega_fwd, dim3(grid), dim3(512), args, LDS_TOTAL, stream);
    if (e != hipSuccess) { fprintf(stderr, "cooperative launch failed: %s (grid %d)\n", hipGetErrorString(e), grid); (void)hipGetLastError();
        hipLaunchKernelGGL(mega_fwd, dim3(grid), dim3(512), LDS_TOTAL, stream, P); }
}
```

```cpp
#include <hip/hip_runtime.h>
#include <cstdio>
#include <cstdint>
namespace pg8 {
#define PG8_LAS __attribute__((address_space(3)))
typedef unsigned short bf16_t;
typedef short bf16x8 __attribute__((ext_vector_type(8)));
typedef float f32x4 __attribute__((ext_vector_type(4)));
typedef unsigned u32x4 __attribute__((ext_vector_type(4)));
constexpr int BM = 256, BK = 64, HALF = 128, HTB = HALF * BK * 2  , STAGE_BYTES = 8 * HTB, NXCD = 8, WGM = 8;

__host__ __device__ __forceinline__ int lds_byte(int r, int c) { const int st = (r >> 4) * 2 + (c >> 5), rr = r & 15, cc = c & 31, ob = rr * 64 + cc * 2; return st * 1024 + (ob ^ (((ob >> 9) & 1) << 5)); }
__host__ __device__ __forceinline__ void stage_rc(int b, int& R, int& C) { const int st = b / 1024, sb = b % 1024, swz = sb ^ (((sb >> 9) & 1) << 5); R = (st >> 1) * 16 + swz / 64; C = (st & 1) * 32 + (swz % 64) / 2; }
__host__ __device__ __forceinline__ int perm32(int rho) { const int n = rho >> 4, i = rho & 15; return 8 * (i >> 2) + 4 * n + (i & 3); }

struct Unit { int pm, pn; };
struct Gemm { const bf16_t* A; const bf16_t* Bt; int M, N, K, lda, ldb, pad; };

struct StaticOrder {
    int nM, nN, nwg, G, c;
    __host__ __device__ __forceinline__ void init(int M, int N, int G_, int c_) { nM = M / BM; nN = N / BM; nwg = nM * nN; G = G_; c = c_; }
    __host__ __device__ __forceinline__ bool next(int i, Unit& u) const {
        const long L = (long)i * G + c; if (L >= nwg) return false;
        int wgid = (int)L; { const int q = nwg / NXCD, r = nwg % NXCD, xcd = wgid % NXCD, off = wgid / NXCD; wgid = (xcd < r ? xcd * (q + 1) : r * (q + 1) + (xcd - r) * q) + off; }
        const int nig = WGM * nN, gid = wgid / nig, fm = gid * WGM, gsz = (nM - fm) < WGM ? (nM - fm) : WGM;
        u.pm = fm + ((wgid % nig) % gsz); u.pn = (wgid % nig) / gsz; return true;
    }
    __device__ __forceinline__ void a_ready(const Unit&) const {}
    __device__ __forceinline__ void done(const Unit&) const {}
};


typedef __bf16 bf16x2_nat __attribute__((ext_vector_type(2)));
typedef float f32x2_nat __attribute__((ext_vector_type(2)));
__device__ __forceinline__ unsigned cvt_pk_bf16(float lo, float hi) { const f32x2_nat v = {lo, hi}; return __builtin_bit_cast(unsigned, __builtin_convertvector(v, bf16x2_nat)); }
template <class Epi, class Sched, bool ALIGN_EPI = false, bool SP2 = false>
__device__ __forceinline__ void gemm_phase(PG8_LAS unsigned char* lds, const Gemm g, const Sched& S, const Epi& E) {
    int tid_ = threadIdx.x; asm volatile("" : "+v"(tid_));
    const int tid = tid_, wid = __builtin_amdgcn_readfirstlane(tid >> 6), lane = tid & 63, wr = wid >> 2, wc = wid & 3, fr = lane & 15, fq = lane >> 4;
    const int K = g.K, nt = K / BK;
    unsigned voffA[2], voffB[2];
#pragma unroll
    for (int i = 0; i < 2; ++i) { int R, C; stage_rc(tid * 16 + i * 8192, R, C); voffA[i] = (unsigned)(R * g.lda + C) * 2u; voffB[i] = (unsigned)(R * g.ldb + C) * 2u; }
    const size_t kstep = (size_t)(BK * 2);
    const size_t hstepA = (size_t)HALF * g.lda * 2, hstepB = (size_t)HALF * g.ldb * 2;
    const size_t tstepA = 2 * hstepA, tstepB = 2 * hstepB;
    const unsigned ldsw = (unsigned)wid * 1024u;
    const int aoff = lds_byte(wr * 64 + fr, fq * 8), boff = lds_byte(wc * 32 + fr, fq * 8);
#define PG8_SA(b, h) (((b) * 2 + (h)) * HTB)
#define PG8_SB(b, h) ((4 + (b) * 2 + (h)) * HTB)
#define PG8_STAGE(bufoff, gbase, voff) do { _Pragma("unroll") for (int _i = 0; _i < 2; ++_i) \
        __builtin_amdgcn_global_load_lds((const unsigned*)((const char*)(gbase) + (voff)[_i]), (PG8_LAS unsigned*)(lds + (bufoff) + ldsw + _i * 8192), 16, 0, 0); } while (0)
#define PG8_LDA(dst, b, h) do { _Pragma("unroll") for (int m = 0; m < 4; ++m) _Pragma("unroll") for (int k = 0; k < 2; ++k) dst[m][k] = *(const PG8_LAS bf16x8*)(lds + PG8_SA(b, h) + aoff + m * 2048 + k * 1024); } while (0)
#define PG8_LDB(dst, b, h) do { _Pragma("unroll") for (int n = 0; n < 2; ++n) _Pragma("unroll") for (int k = 0; k < 2; ++k) dst[n][k] = *(const PG8_LAS bf16x8*)(lds + PG8_SB(b, h) + boff + n * 2048 + k * 1024); } while (0)
#define PG8_MMA(ai, bj, At, Bt) do { __builtin_amdgcn_s_setprio(1); _Pragma("unroll") for (int m = 0; m < 4; ++m) _Pragma("unroll") for (int n = 0; n < 2; ++n) _Pragma("unroll") for (int k = 0; k < 2; ++k) \
        acc[ai][bj][m][n] = __builtin_amdgcn_mfma_f32_16x16x32_bf16(Bt[n][k], At[m][k], acc[ai][bj][m][n], 0, 0, 0); __builtin_amdgcn_s_setprio(0); } while (0)
#define PG8_WAIT_V(n) asm volatile("s_waitcnt vmcnt(" #n ")" ::: "memory")
#define PG8_WAIT_L(n) asm volatile("s_waitcnt lgkmcnt(" #n ")" ::: "memory")
#define PG8_BAR __builtin_amdgcn_s_barrier()
#define PG8_SCHED __builtin_amdgcn_sched_barrier(0)
    Unit cur, nxt; int ui = 0;
    if (!S.next(0, cur)) return;
    f32x4 acc[2][2][4][2];
#pragma unroll
    for (int a = 0; a < 2; ++a)
#pragma unroll
        for (int b = 0; b < 2; ++b)
#pragma unroll
            for (int m = 0; m < 4; ++m)
#pragma unroll
                for (int n = 0; n < 2; ++n) acc[a][b][m][n] = (f32x4){0.f, 0.f, 0.f, 0.f};
    bf16x8 At[4][2], B0[2][2], B1[2][2];
    const char* cA = (const char*)g.A + (size_t)cur.pm * tstepA; const char* cB = (const char*)g.Bt + (size_t)cur.pn * tstepB;
    S.a_ready(cur);
    if constexpr (SP2) {
        PG8_STAGE(PG8_SB(0, 0), cB, voffB); PG8_STAGE(PG8_SB(0, 1), cB + hstepB, voffB); PG8_STAGE(PG8_SA(0, 0), cA, voffA); PG8_STAGE(PG8_SA(0, 1), cA + hstepA, voffA);
        if (wr == 1) PG8_BAR;
        PG8_WAIT_V(2); PG8_BAR;
        PG8_STAGE(PG8_SB(1, 0), cB + kstep, voffB); PG8_STAGE(PG8_SA(1, 0), cA + kstep, voffA); PG8_STAGE(PG8_SB(1, 1), cB + hstepB + kstep, voffB);
        PG8_WAIT_V(6); PG8_BAR;
    } else {
        PG8_STAGE(PG8_SB(0, 0), cB, voffB); PG8_STAGE(PG8_SA(0, 0), cA, voffA); PG8_STAGE(PG8_SB(0, 1), cB + hstepB, voffB); PG8_STAGE(PG8_SA(0, 1), cA + hstepA, voffA);
        if (wr == 1) PG8_BAR;
        PG8_WAIT_V(4); PG8_BAR;
        PG8_STAGE(PG8_SB(1, 0), cB + kstep, voffB); PG8_STAGE(PG8_SA(1, 0), cA + kstep, voffA); PG8_STAGE(PG8_SB(1, 1), cB + hstepB + kstep, voffB);
        PG8_WAIT_V(6); PG8_BAR;
    }
    for (;;) {
        const bool has_next = S.next(ui + 1, nxt);
        const char* nA = has_next ? (const char*)g.A + (size_t)nxt.pm * tstepA : cA; const char* nB = has_next ? (const char*)g.Bt + (size_t)nxt.pn * tstepB : cB;
        for (int t = 0; t < nt; t += 2) {
            const bool last = (t == nt - 2);
            const char* a1 = cA + (size_t)(t + 1) * kstep;
            const char* a2 = last ? nA : cA + (size_t)(t + 2) * kstep; const char* b2 = last ? nB : cB + (size_t)(t + 2) * kstep;
            const char* a3 = a2 + kstep; const char* b3 = b2 + kstep;
            if (last && has_next) S.a_ready(nxt);
            if constexpr (SP2) {
            PG8_LDB(B0, 0, 0); PG8_LDB(B1, 0, 1); PG8_SCHED; PG8_LDA(At, 0, 0); PG8_STAGE(PG8_SA(1, 1), a1 + hstepA, voffA);
            PG8_WAIT_V(8); PG8_WAIT_L(0); PG8_BAR; PG8_MMA(0, 0, At, B0); PG8_MMA(0, 1, At, B1); PG8_BAR; PG8_SCHED;
            PG8_LDA(At, 0, 1); PG8_STAGE(PG8_SB(0, 0), b2, voffB); PG8_STAGE(PG8_SB(0, 1), b2 + hstepB, voffB); PG8_STAGE(PG8_SA(0, 0), a2, voffA);
            PG8_WAIT_V(8); PG8_WAIT_L(0); PG8_BAR; PG8_MMA(1, 0, At, B0); PG8_MMA(1, 1, At, B1); PG8_BAR; PG8_SCHED;
            PG8_LDB(B0, 1, 0); PG8_LDB(B1, 1, 1); PG8_SCHED; PG8_LDA(At, 1, 0); PG8_STAGE(PG8_SA(0, 1), a2 + hstepA, voffA);
            PG8_WAIT_V(8); PG8_WAIT_L(0); PG8_BAR; PG8_MMA(0, 0, At, B0); PG8_MMA(0, 1, At, B1); PG8_BAR; PG8_SCHED;
            PG8_LDA(At, 1, 1); PG8_STAGE(PG8_SB(1, 0), b3, voffB); PG8_STAGE(PG8_SB(1, 1), b3 + hstepB, voffB); PG8_STAGE(PG8_SA(1, 0), a3, voffA);
            PG8_WAIT_V(8); PG8_WAIT_L(0); PG8_BAR; PG8_MMA(1, 0, At, B0); PG8_MMA(1, 1, At, B1); PG8_BAR; PG8_SCHED;
            } else {
            PG8_LDB(B0, 0, 0); PG8_SCHED; PG8_LDA(At, 0, 0); PG8_STAGE(PG8_SA(1, 1), a1 + hstepA, voffA);
            PG8_WAIT_L(8); PG8_BAR; PG8_WAIT_L(0); PG8_MMA(0, 0, At, B0); PG8_BAR; PG8_SCHED;
            PG8_LDB(B1, 0, 1); PG8_STAGE(PG8_SB(0, 0), b2, voffB);
            PG8_BAR; PG8_WAIT_L(0); PG8_MMA(0, 1, At, B1); PG8_BAR;
            PG8_LDA(At, 0, 1); PG8_STAGE(PG8_SA(0, 0), a2, voffA);
            PG8_BAR; PG8_WAIT_L(0); PG8_MMA(1, 0, At, B0); PG8_BAR; PG8_SCHED;
            PG8_STAGE(PG8_SB(0, 1), b2 + hstepB, voffB);
            PG8_WAIT_V(6); PG8_BAR; PG8_MMA(1, 1, At, B1); PG8_BAR;
            PG8_LDB(B0, 1, 0); PG8_SCHED; PG8_LDA(At, 1, 0); PG8_STAGE(PG8_SA(0, 1), a2 + hstepA, voffA);
            PG8_WAIT_L(8); PG8_BAR; PG8_WAIT_L(0); PG8_MMA(0, 0, At, B0); PG8_BAR; PG8_SCHED;
            PG8_LDB(B1, 1, 1); PG8_STAGE(PG8_SB(1, 0), b3, voffB);
            PG8_BAR; PG8_WAIT_L(0); PG8_MMA(0, 1, At, B1); PG8_BAR;
            PG8_LDA(At, 1, 1); PG8_STAGE(PG8_SA(1, 0), a3, voffA);
            PG8_BAR; PG8_WAIT_L(0); PG8_MMA(1, 0, At, B0); PG8_BAR; PG8_SCHED;
            PG8_STAGE(PG8_SB(1, 1), b3 + hstepB, voffB);
            PG8_WAIT_V(6); PG8_BAR; PG8_MMA(1, 1, At, B1); PG8_BAR;
            }
        }
        if constexpr (ALIGN_EPI) { if (wr == 0) PG8_BAR; }
        if constexpr (!Epi::AFTER_DRAIN) { E(acc, cur, wr, wc, fr, fq); S.done(cur); }
        if (!has_next) break;
#pragma unroll
        for (int a = 0; a < 2; ++a)
#pragma unroll
            for (int b = 0; b < 2; ++b)
#pragma unroll
                for (int m = 0; m < 4; ++m)
#pragma unroll
                    for (int n = 0; n < 2; ++n) acc[a][b][m][n] = (f32x4){0.f, 0.f, 0.f, 0.f};
        cur = nxt; cA = nA; cB = nB; ++ui;
        if constexpr (ALIGN_EPI) { if (wr == 1) PG8_BAR; }
    }
    PG8_WAIT_V(0);
    if constexpr (!ALIGN_EPI) { if (wr == 0) PG8_BAR; }
    PG8_BAR;
    if constexpr (Epi::AFTER_DRAIN) { E.fused(acc, cur, wr, wc, fr, fq, lds, wid, lane); S.done(cur); }
#undef PG8_SA
#undef PG8_SB
#undef PG8_STAGE
#undef PG8_LDA
#undef PG8_LDB
#undef PG8_MMA
#undef PG8_WAIT_V
#undef PG8_WAIT_L
#undef PG8_BAR
#undef PG8_SCHED
}
}

using pg8::bf16_t; using pg8::f32x4; using pg8::u32x4; using pg8::Unit; using pg8::cvt_pk_bf16;
constexpr int D = 1024, NBATCH = 8, SEQ = 2048, MP = NBATCH * SEQ, MS = 128, MV = MP + MS  , MALL = MP + 256  ;
constexpr int NIN = 7168, DFF = 2816, NUP = 2 * DFF, PD = 256;
constexpr float EPS = 1e-6f;
constexpr int LDS_BYTES = 131072;

constexpr size_t O_Y = 0;
constexpr size_t O_CAP = (size_t)MV * D;
constexpr size_t O_CAS = O_CAP + (size_t)NBATCH * 2 * D;
constexpr size_t O_CVP = O_CAS + (size_t)MS * 2 * D;
constexpr size_t O_CVS = O_CVP + (size_t)NBATCH * 128 * D;
constexpr size_t O_CFP = O_CVS + (size_t)MS * D;
constexpr size_t O_CFS = O_CFP + (size_t)NBATCH * 2 * NUP;
constexpr size_t O_END = O_CFS + (size_t)MS * 2 * NUP;

struct Ptrs {
    const float *x_p, *x_s, *p_p, *p_s, *st_a, *st_f, *g_mix, *w_in, *w_conv_a, *w_out_a, *g_v, *w_sp, *b_sp, *w_out_b, *w_o, *g_ffn, *w_up, *w_conv_f, *w_down, *g_ple, *w_pg, *w_ple, *g_final;
    float* out; unsigned char* ws;
};
constexpr size_t MiB = 1u << 20;
constexpr size_t WS_WUP = 0, WS_WDOWN = 11 * MiB, WS_WPG = 16 * MiB + MiB / 2, WS_WPLE = 18 * MiB + MiB / 2;
constexpr size_t WS_SMALL = 19 * MiB, WS_CTL = WS_SMALL, CTL_BYTES = 65536;
constexpr size_t WS_RSTD0 = WS_SMALL + 65536, WS_VSSQS = WS_RSTD0 + 131072, WS_SSQ1S = WS_VSSQS + 16384, WS_SSQ2S = WS_SSQ1S + 16384, WS_T1S = WS_SSQ2S + 16384, WS_PES = WS_T1S + 524288;
constexpr size_t WS_VSSQ = 20 * MiB + MiB / 2, WS_SSQ1 = 21 * MiB + 3 * MiB / 4, WS_SSQ2 = 23 * MiB;
constexpr size_t WS_PB = 24 * MiB + MiB / 2;
constexpr size_t WS_WIN = 33 * MiB, WS_WOA = 47 * MiB, WS_WOB = 49 * MiB, WS_WO = 51 * MiB;
constexpr size_t WS_XB = 53 * MiB, WS_CA = 86 * MiB, WS_VP = WS_CA + 65 * MiB / 2, WS_BA = 151 * MiB, WS_UU = 184 * MiB, WS_SGA = 217 * MiB;
constexpr size_t WS_H1B = 222 * MiB, WS_UPH = 33 * MiB, WS_A3 = 123 * MiB, WS_H2B = 33 * MiB, WS_PE = 123 * MiB, WS_HB = 213 * MiB;


typedef const Ptrs __attribute__((address_space(4)))* KPtr;
__device__ __forceinline__ KPtr kargs() { KPtr p = (KPtr)__builtin_amdgcn_kernarg_segment_ptr(); asm volatile("" : "+s"(p)); return p; }
struct Ctx { unsigned char* ws; float* out; };
#define WSP(T, off) ((T*)(c.ws + (off)))
__device__ __forceinline__ float gelu_tanh(float x) {
    const float t = x * x;
    const float u2 = x * (2.3022082f + 0.10294324f * t);
    const float e = __builtin_amdgcn_exp2f(-u2);
    return x * __builtin_amdgcn_rcpf(1.0f + e);
}
__device__ __forceinline__ float sigmoid_f(float x) { return __builtin_amdgcn_rcpf(1.0f + __builtin_amdgcn_exp2f(-1.4426950409f * x)); }
__device__ __forceinline__ float bf2f(unsigned short b) { return __uint_as_float(((unsigned)b) << 16); }
__device__ __forceinline__ void store8_bf16(bf16_t* p, f32x4 v0, f32x4 v1) {
    u32x4 w; w.x = cvt_pk_bf16(v0[0], v0[1]); w.y = cvt_pk_bf16(v0[2], v0[3]); w.z = cvt_pk_bf16(v1[0], v1[1]); w.w = cvt_pk_bf16(v1[2], v1[3]);
    *(u32x4*)p = w;
}
__device__ __forceinline__ void load8_bf16(const bf16_t* p, f32x4& v0, f32x4& v1) {
    const u32x4 w = *(const u32x4*)p;
    v0 = (f32x4){__uint_as_float(w.x << 16), __uint_as_float(w.x & 0xffff0000u), __uint_as_float(w.y << 16), __uint_as_float(w.y & 0xffff0000u)};
    v1 = (f32x4){__uint_as_float(w.z << 16), __uint_as_float(w.z & 0xffff0000u), __uint_as_float(w.w << 16), __uint_as_float(w.w & 0xffff0000u)};
}
__device__ __forceinline__ float sum4sq(f32x4 v) { return (v[0] * v[0] + v[1] * v[1]) + (v[2] * v[2] + v[3] * v[3]); }

__device__ __forceinline__ float row_rstd16(const float* ssq, int r, int fq) {
    const f32x4 a = *(const f32x4*)(ssq + (size_t)r * 16 + 4 * fq);
    float s = (a[0] + a[1]) + (a[2] + a[3]); s += __shfl_xor(s, 16); s += __shfl_xor(s, 32);
    return 1.0f / sqrtf(s * (1.0f / D) + EPS);
}
#define EPI_ROW(ai, m) (u.pm * 256 + (ai) * 128 + wr * 64 + (m) * 16 + fr)
typedef const f32x4 (&AccRef)[2][2][4][2];

struct EpiIn {
    static constexpr bool AFTER_DRAIN = false;
    Ctx c;
    __device__ __forceinline__ void operator()(AccRef acc, const Unit& u, int wr, int wc, int fr, int fq) const {
        const float* rstd0 = WSP(const float, WS_RSTD0); bf16_t* ca = WSP(bf16_t, WS_CA); bf16_t* ba = WSP(bf16_t, WS_BA); bf16_t* uu = WSP(bf16_t, WS_UU); bf16_t* vp = WSP(bf16_t, WS_VP);
        bf16_t* sga = WSP(bf16_t, WS_SGA); bf16_t* sgb = (bf16_t*)c.out; float* vssq = WSP(float, WS_VSSQ); float* out = c.out;
        const int tile = u.pn, hc = wc * 32 + 8 * fq;
        if (tile < 8) {
#pragma unroll
            for (int ai = 0; ai < 2; ++ai)
#pragma unroll
                for (int m = 0; m < 4; ++m) {
                    const int r = EPI_ROW(ai, m); const float rs = rstd0[r];
                    const f32x4 p0 = (acc[ai][0][m][0] * rs) * (acc[ai][1][m][0] * rs), p1 = (acc[ai][0][m][1] * rs) * (acc[ai][1][m][1] * rs);
                    store8_bf16(ca + (size_t)r * D + 128 * tile + hc, p0, p1);
                    if (r < MP) { const int t = r & (SEQ - 1); if (t >= SEQ - 2) { float* o = out + O_CAP + ((size_t)((r >> 11) * 2 + (t - (SEQ - 2)))) * D + 128 * tile + hc; *(f32x4*)o = p0; *(f32x4*)(o + 4) = p1; } }
                    else if (r < MV) { float* o = out + O_CAS + ((size_t)((r - MP) * 2 + 1)) * D + 128 * tile + hc; *(f32x4*)o = p0; *(f32x4*)(o + 4) = p1; }
                }
        } else {
            const int type = (tile - 8) >> 2, tl = (tile - 8) & 3;
            bf16_t* dst = type == 0 ? ba : type == 1 ? uu : type == 2 ? vp : type == 3 ? sga : sgb;
            dst += 256 * tl + hc;
            if (type == 0) {
#pragma unroll
                for (int ai = 0; ai < 2; ++ai)
#pragma unroll
                    for (int m = 0; m < 4; ++m) { const int r = EPI_ROW(ai, m); const float rs = rstd0[r];
#pragma unroll
                        for (int bj = 0; bj < 2; ++bj) store8_bf16(dst + (size_t)r * D + 128 * bj, acc[ai][bj][m][0] * rs, acc[ai][bj][m][1] * rs); }
            } else if (type <= 2) {
#pragma unroll
                for (int ai = 0; ai < 2; ++ai)
#pragma unroll
                    for (int m = 0; m < 4; ++m) { const int r = EPI_ROW(ai, m); const float rs = rstd0[r]; float s = 0.f;
#pragma unroll
                        for (int bj = 0; bj < 2; ++bj) { f32x4 v0 = acc[ai][bj][m][0] * rs, v1 = acc[ai][bj][m][1] * rs;
#pragma unroll
                            for (int j = 0; j < 4; ++j) { v0[j] = gelu_tanh(v0[j]); v1[j] = gelu_tanh(v1[j]); }
                            s += sum4sq(v0) + sum4sq(v1);
                            store8_bf16(dst + (size_t)r * D + 128 * bj, v0, v1); }
                        if (type == 2) { s += __shfl_xor(s, 16); s += __shfl_xor(s, 32); if (fq == 0) vssq[(size_t)r * 16 + tl * 4 + wc] = s; } }
            } else {
#pragma unroll
                for (int ai = 0; ai < 2; ++ai)
#pragma unroll
                    for (int m = 0; m < 4; ++m) { const int r = EPI_ROW(ai, m); const float rs = rstd0[r];
#pragma unroll
                        for (int bj = 0; bj < 2; ++bj) { f32x4 v0 = acc[ai][bj][m][0] * rs, v1 = acc[ai][bj][m][1] * rs;
#pragma unroll
                            for (int j = 0; j < 4; ++j) { v0[j] = sigmoid_f(v0[j]); v1[j] = sigmoid_f(v1[j]); }
                            store8_bf16(dst + (size_t)r * D + 128 * bj, v0, v1); } }
            }
        }
    }
};
struct EpiYa {
    static constexpr bool AFTER_DRAIN = false;
    Ctx c;
    __device__ __forceinline__ void operator()(AccRef acc, const Unit& u, int wr, int wc, int fr, int fq) const {
        const bf16_t* sga = WSP(const bf16_t, WS_SGA); float* t1 = WSP(float, WS_CA);
        const int hc = u.pn * 256 + wc * 32 + 8 * fq;
#pragma unroll
        for (int ai = 0; ai < 2; ++ai)
#pragma unroll
            for (int m = 0; m < 4; ++m) { const int r = EPI_ROW(ai, m);
#pragma unroll
                for (int bj = 0; bj < 2; ++bj) { const size_t o = (size_t)r * D + hc + 128 * bj; f32x4 g0, g1; load8_bf16(sga + o, g0, g1);
                    *(f32x4*)(t1 + o) = g0 * acc[ai][bj][m][0]; *(f32x4*)(t1 + o + 4) = g1 * acc[ai][bj][m][1]; } }
    }
};
struct EpiYb {
    static constexpr bool AFTER_DRAIN = false;
    Ctx c;
    __device__ __forceinline__ void operator()(AccRef acc, const Unit& u, int wr, int wc, int fr, int fq) const {
        const bf16_t* sgb = (const bf16_t*)c.out; const float* t1 = WSP(const float, WS_CA); bf16_t* mm = WSP(bf16_t, WS_XB);
        const int hc = u.pn * 256 + wc * 32 + 8 * fq;
#pragma unroll
        for (int ai = 0; ai < 2; ++ai)
#pragma unroll
            for (int m = 0; m < 4; ++m) { const int r = EPI_ROW(ai, m);
#pragma unroll
                for (int bj = 0; bj < 2; ++bj) { const size_t o = (size_t)r * D + hc + 128 * bj; f32x4 g0, g1; load8_bf16(sgb + o, g0, g1);
                    const f32x4 a0 = *(const f32x4*)(t1 + o), a1 = *(const f32x4*)(t1 + o + 4);
                    store8_bf16(mm + o, a0 + g0 * acc[ai][bj][m][0], a1 + g1 * acc[ai][bj][m][1]); } }
    }
};
template <int SRC> struct EpiRes {
    static constexpr bool AFTER_DRAIN = false;
    Ctx c;
    __device__ __forceinline__ void operator()(AccRef acc, const Unit& u, int wr, int wc, int fr, int fq) const {
        const KPtr kp = kargs(); const float* xp = kp->x_p; const float* xs = kp->x_s; float* h = c.out; bf16_t* hb = WSP(bf16_t, SRC == 0 ? WS_H1B : WS_H2B); float* ssq = WSP(float, SRC == 0 ? WS_SSQ1 : WS_SSQ2);
        const int hc = u.pn * 256 + wc * 32 + 8 * fq;
#pragma unroll
        for (int ai = 0; ai < 2; ++ai)
#pragma unroll
            for (int m = 0; m < 4; ++m) { const int r = EPI_ROW(ai, m); float s = 0.f; const bool valid = r < MV;
                const float* base = SRC == 1 ? h + (size_t)r * D : (r < MP ? xp + (size_t)r * D : xs + (size_t)(r - MP) * D);
#pragma unroll
                for (int bj = 0; bj < 2; ++bj) { const int c = hc + 128 * bj;
                    f32x4 b0 = (f32x4){0.f, 0.f, 0.f, 0.f}, b1 = b0; if (valid) { b0 = *(const f32x4*)(base + c); b1 = *(const f32x4*)(base + c + 4); }
                    const f32x4 v0 = b0 + acc[ai][bj][m][0], v1 = b1 + acc[ai][bj][m][1];
                    if (valid) { *(f32x4*)(h + (size_t)r * D + c) = v0; *(f32x4*)(h + (size_t)r * D + c + 4) = v1; }
                    store8_bf16(hb + (size_t)r * D + c, v0, v1);
                    s += sum4sq(v0) + sum4sq(v1); }
                s += __shfl_xor(s, 16); s += __shfl_xor(s, 32); if (fq == 0) ssq[(size_t)r * 16 + u.pn * 4 + wc] = s; }
    }
};
struct EpiUp {
    static constexpr bool AFTER_DRAIN = false;
    Ctx c; int half; int pad;
    __device__ __forceinline__ void operator()(AccRef acc, const Unit& u, int wr, int wc, int fr, int fq) const {
        const float* ssq1 = WSP(const float, WS_SSQ1); bf16_t* uph = WSP(bf16_t, WS_UPH); float* out = c.out;
        const int hc = wc * 32 + 8 * fq;
#pragma unroll
        for (int ai = 0; ai < 2; ++ai)
#pragma unroll
            for (int m = 0; m < 4; ++m) { const int r = EPI_ROW(ai, m); const float rs = row_rstd16(ssq1, r, fq);
#pragma unroll
                for (int bj = 0; bj < 2; ++bj) { const f32x4 v0 = acc[ai][bj][m][0] * rs, v1 = acc[ai][bj][m][1] * rs;
                    store8_bf16(uph + (size_t)r * DFF + 256 * u.pn + 128 * bj + hc, v0, v1);
                    const int col = (bj ? DFF : 0) + 1408 * half + 128 * u.pn + hc;
                    if (r < MP) { const int t = r & (SEQ - 1); if (t >= SEQ - 2) { float* o = out + O_CFP + ((size_t)((r >> 11) * 2 + (t - (SEQ - 2)))) * NUP + col; *(f32x4*)o = v0; *(f32x4*)(o + 4) = v1; } }
                    else if (r < MV) { float* o = out + O_CFS + ((size_t)((r - MP) * 2 + 1)) * NUP + col; *(f32x4*)o = v0; *(f32x4*)(o + 4) = v1; } } }
    }
};

__device__ __forceinline__ float dpp_ror1(float x) { return __builtin_bit_cast(float, __builtin_amdgcn_update_dpp(0, __builtin_bit_cast(int, x), 0x121, 0xf, 0xf, false)); }
__device__ __forceinline__ float dpp_ror2(float x) { return __builtin_bit_cast(float, __builtin_amdgcn_update_dpp(0, __builtin_bit_cast(int, x), 0x122, 0xf, 0xf, false)); }
__device__ __forceinline__ f32x4 dpp_ror1(f32x4 v) { return (f32x4){dpp_ror1(v[0]), dpp_ror1(v[1]), dpp_ror1(v[2]), dpp_ror1(v[3])}; }
__device__ __forceinline__ f32x4 dpp_ror2(f32x4 v) { return (f32x4){dpp_ror2(v[0]), dpp_ror2(v[1]), dpp_ror2(v[2]), dpp_ror2(v[3])}; }
#define EPI_BAR() do { asm volatile("s_waitcnt lgkmcnt(0)" ::: "memory"); __builtin_amdgcn_s_barrier(); asm volatile("" ::: "memory"); } while (0)
struct EpiUpF {
    static constexpr bool AFTER_DRAIN = false;
    Ctx c; __attribute__((address_space(3))) float* halo;
    __device__ __forceinline__ void operator()(AccRef acc, const Unit& u, int wr, int wc, int fr, int fq) const {
        const KPtr kp = kargs(); const float* wcf = kp->w_conv_f; float* out = c.out;
        const float* ssq1 = WSP(const float, WS_SSQ1); bf16_t* a3 = WSP(bf16_t, WS_A3); float* hb = WSP(float, WS_HB);
        const int hc = wc * 32 + 8 * fq, ja = 128 * u.pn + hc, jb = DFF + ja, pl = u.pm & 7;
        float rsv[2][4];
#pragma unroll
        for (int ai = 0; ai < 2; ++ai)
#pragma unroll
            for (int m = 0; m < 4; ++m) rsv[ai][m] = row_rstd16(ssq1, EPI_ROW(ai, m), fq);
        if (fr >= 14) {
#pragma unroll
            for (int ai = 0; ai < 2; ++ai)
#pragma unroll
                for (int bj = 0; bj < 2; ++bj)
#pragma unroll
                    for (int n = 0; n < 2; ++n) *(__attribute__((address_space(3))) f32x4*)(halo + ((2 * ai + wr) * 2 + (fr - 14)) * 256 + 128 * bj + hc + 4 * n) = acc[ai][bj][3][n] * rsv[ai][3]; }
        EPI_BAR();
#pragma unroll
        for (int n = 0; n < 2; ++n) {
            f32x4 w[3][2];
#pragma unroll
            for (int tap = 0; tap < 3; ++tap) { w[tap][0] = *(const f32x4*)(wcf + tap * NUP + ja + 4 * n); w[tap][1] = *(const f32x4*)(wcf + tap * NUP + jb + 4 * n); }
#pragma unroll
            for (int ai = 0; ai < 2; ++ai) {
                const int B = 2 * ai + wr;
                f32x4 y1p[2], y2p[2];
                y1p[0] = y1p[1] = y2p[0] = y2p[1] = (f32x4){0.f, 0.f, 0.f, 0.f};
                if (B > 0 && fr < 2) { const __attribute__((address_space(3))) float* hp = halo + ((B - 1) * 2) * 256 + hc + 4 * n;
#pragma unroll
                    for (int bj = 0; bj < 2; ++bj) { const f32x4 r62 = *(const __attribute__((address_space(3))) f32x4*)(hp + 128 * bj), r63 = *(const __attribute__((address_space(3))) f32x4*)(hp + 256 + 128 * bj);
                        y1p[bj] = r63; y2p[bj] = fr == 0 ? r62 : r63; } }
#pragma unroll
                for (int m = 0; m < 4; ++m) {
                    const int r = EPI_ROW(ai, m); const float rs = rsv[ai][m];
                    f32x4 x[2], cv[2];
#pragma unroll
                    for (int bj = 0; bj < 2; ++bj) { x[bj] = acc[ai][bj][m][n] * rs;
                        const f32x4 y1 = dpp_ror1(x[bj]), y2 = dpp_ror2(x[bj]);
                        const f32x4 p1 = fr == 0 ? y1p[bj] : y1, p2 = fr < 2 ? y2p[bj] : y2;
                        cv[bj] = w[0][bj] * p2 + w[1][bj] * p1 + w[2][bj] * x[bj];
                        y1p[bj] = y1; y2p[bj] = y2; }
                    f32x4 o;
#pragma unroll
                    for (int j = 0; j < 4; ++j) o[j] = gelu_tanh(cv[0][j]) * cv[1][j];
                    const bool edge_lo = (B == 0 && m == 0 && fr < 2), edge_hi = (B == 3 && m == 3 && fr >= 14);
                    if (!(edge_lo && pl != 0)) *(unsigned long long*)(a3 + (size_t)r * DFF + ja + 4 * n) = (unsigned long long)cvt_pk_bf16(o[0], o[1]) | ((unsigned long long)cvt_pk_bf16(o[2], o[3]) << 32);
                    if (edge_lo || edge_hi) { float* hrow = hb + ((size_t)u.pm * 4 + (edge_lo ? 2 + fr : fr - 14)) * NUP;
                        *(f32x4*)(hrow + ja + 4 * n) = x[0]; *(f32x4*)(hrow + jb + 4 * n) = x[1];
                        if (edge_hi && pl == 7) { float* o2 = out + O_CFP + ((size_t)((u.pm >> 3) * 2 + (fr - 14))) * NUP; *(f32x4*)(o2 + ja + 4 * n) = x[0]; *(f32x4*)(o2 + jb + 4 * n) = x[1]; } }
                }
            }
        }
    }
};
struct EpiPe {
    static constexpr bool AFTER_DRAIN = false;
    Ctx c;
    __device__ __forceinline__ void operator()(AccRef acc, const Unit& u, int wr, int wc, int fr, int fq) const {
        float* pe = WSP(float, WS_PE);
        const int hc = u.pn * 256 + wc * 32 + 8 * fq;
#pragma unroll
        for (int ai = 0; ai < 2; ++ai)
#pragma unroll
            for (int m = 0; m < 4; ++m) { const int r = EPI_ROW(ai, m);
#pragma unroll
                for (int bj = 0; bj < 2; ++bj) { const size_t o = (size_t)r * D + hc + 128 * bj; *(f32x4*)(pe + o) = acc[ai][bj][m][0]; *(f32x4*)(pe + o + 4) = acc[ai][bj][m][1]; } }
    }
};
struct EpiGate {
    static constexpr bool AFTER_DRAIN = false;
    Ctx c;
    __device__ __forceinline__ void operator()(AccRef acc, const Unit& u, int wr, int wc, int fr, int fq) const {
        const float* ssq2 = WSP(const float, WS_SSQ2); const float* pe = WSP(const float, WS_PE); float* h = c.out;
        const int hc = u.pn * 256 + wc * 32 + 8 * fq;
#pragma unroll
        for (int ai = 0; ai < 2; ++ai)
#pragma unroll
            for (int m = 0; m < 4; ++m) { const int r = EPI_ROW(ai, m); const float rs = row_rstd16(ssq2, r, fq);
#pragma unroll
                for (int bj = 0; bj < 2; ++bj) { const size_t o = (size_t)r * D + hc + 128 * bj;
                    f32x4 g0 = acc[ai][bj][m][0] * rs, g1 = acc[ai][bj][m][1] * rs;
#pragma unroll
                    for (int j = 0; j < 4; ++j) { g0[j] = sigmoid_f(g0[j]); g1[j] = sigmoid_f(g1[j]); }
                    const f32x4 p0 = *(const f32x4*)(pe + o), p1 = *(const f32x4*)(pe + o + 4);
                    const f32x4 h0 = *(const f32x4*)(h + o), h1 = *(const f32x4*)(h + o + 4);
                    *(f32x4*)(h + o) = h0 + g0 * p0; *(f32x4*)(h + o + 4) = h1 + g1 * p1; } }
    }
};


#define LAS __attribute__((address_space(3)))
typedef pg8::bf16x8 bf16x8;
constexpr int LDS_STAGE = 131072, LDS_XTRA_OFF = LDS_STAGE, LDS_XTRA = 8192, LDS_CTL_OFF = LDS_STAGE + LDS_XTRA, LDS_TOTAL = 147456;
#define BLK_BAR() do { asm volatile("s_waitcnt lgkmcnt(0)" ::: "memory"); __builtin_amdgcn_s_barrier(); asm volatile("" ::: "memory"); } while (0)

#define XB_TMO      128
#define XB_XCNT(j)  (256  + 64 * (j))
#define XB_XSUB(j)  (1280 + 64 * (j))
#define XB_XGEN(j)  (2304 + 64 * (j))
#define XB_TOP      3328
#define XB_TOPGEN   3392
#define XCD_BAR_WORDS 3456
#define XB_SPIN_CAP (1u << 18)

__device__ __forceinline__ unsigned xb_ld(unsigned* p)              { return __hip_atomic_load(p, __ATOMIC_RELAXED, __HIP_MEMORY_SCOPE_AGENT); }
__device__ __forceinline__ unsigned xb_add(unsigned* p, unsigned v) { return __hip_atomic_fetch_add(p, v, __ATOMIC_RELAXED, __HIP_MEMORY_SCOPE_AGENT); }
__device__ __forceinline__ unsigned xb_xcc_id() { return (unsigned)__builtin_amdgcn_s_getreg((3 << 11) | 20) & 0xFu; }
#define XB_SPIN(cond, bar) do { unsigned _sp = 0; while (cond) { __builtin_amdgcn_s_sleep(1); \
    if ((++_sp & 255u) == 0u) { if (xb_ld(&(bar)[XB_TMO])) break; if (_sp > XB_SPIN_CAP) { atomicAdd(&(bar)[XB_TMO], 1u); break; } } } } while (0)

struct XcdBarrier {
    unsigned* bar; unsigned x;
    volatile LAS unsigned* st;
};

__device__ __forceinline__ XcdBarrier xcd_barrier_post(unsigned* bar, volatile LAS unsigned* st) {
    XcdBarrier b; b.bar = bar; b.x = xb_xcc_id(); b.st = st;
    if (threadIdx.x == 0) (void)xb_add(&bar[XB_XCNT(b.x)], 1u);
    return b;
}
__device__ __forceinline__ void xcd_barrier_complete(unsigned* bar, unsigned x, unsigned& nloc, unsigned& nx) {
    const unsigned G = gridDim.x * gridDim.y * gridDim.z;
    unsigned sum, cnt, mine, sp = 0u;
    for (;;) {
        sum = 0u; cnt = 0u; mine = 0u;
#pragma unroll
        for (unsigned j = 0; j < 16; ++j) { const unsigned c = xb_ld(&bar[XB_XCNT(j)]); sum += c; cnt += (c > 0u) ? 1u : 0u; mine = (j == x) ? c : mine; }
        if (sum == G) break;
        __builtin_amdgcn_s_sleep(1);
        if ((++sp & 255u) == 0u) { if (xb_ld(&bar[XB_TMO])) break; if (sp > XB_SPIN_CAP) { atomicAdd(&bar[XB_TMO], 1u); break; } }
    }
    nloc = mine > 0u ? mine : 1u; nx = cnt > 0u ? cnt : 1u;
}

__device__ __forceinline__ void xcd_barrier(const XcdBarrier& b) {
    asm volatile("s_waitcnt vmcnt(0)" ::: "memory");
    __syncthreads();
    if (threadIdx.x == 0) {
        unsigned* bar = b.bar;
        __builtin_amdgcn_s_waitcnt(0);
        unsigned nloc = b.st[0], nx = b.st[1];
        if (nloc == 0u) { xcd_barrier_complete(bar, b.x, nloc, nx); b.st[0] = nloc; b.st[1] = nx; }
        const unsigned old = xb_add(&bar[XB_XSUB(b.x)], 1u);
        const unsigned gen = old / nloc;
        if (old + 1u == (gen + 1u) * nloc) {
            __builtin_amdgcn_fence(__ATOMIC_RELEASE, "agent");
            asm volatile("s_waitcnt vmcnt(0)" ::: "memory");
            const unsigned og = xb_add(&bar[XB_TOP], 1u);
            const unsigned tg = og / nx;
            if (og + 1u == (tg + 1u) * nx) xb_add(&bar[XB_TOPGEN], 1u);
            else XB_SPIN(xb_ld(&bar[XB_TOPGEN]) == tg, bar);
            __builtin_amdgcn_fence(__ATOMIC_ACQUIRE, "agent");
            xb_add(&bar[XB_XGEN(b.x)], 1u);
            asm volatile("s_waitcnt vmcnt(0)" ::: "memory");
        } else {
            XB_SPIN(xb_ld(&bar[XB_XGEN(b.x)]) == gen, bar);
            __builtin_amdgcn_fence(__ATOMIC_ACQUIRE, "agent");
            asm volatile("s_waitcnt vmcnt(0)" ::: "memory");
        }
    }
    __syncthreads();
}


__device__ __forceinline__ int otid() { int t = threadIdx.x; asm volatile("" : "+v"(t)); return t; }
__device__ __forceinline__ float wave_sum(float v) {
#pragma unroll
    for (int o = 1; o < 64; o <<= 1) v += __shfl_xor(v, o);
    return v;
}
__device__ __forceinline__ bf16_t f2bf(float x) { return (bf16_t)(cvt_pk_bf16(x, 0.f) & 0xffffu); }

__device__ __forceinline__ int colmap(int mode, int R) {
    const int hc = (R & 96) + pg8::perm32(R & 31);
    const int bj = (R >> 7) & 1, tile = R >> 8;
    if (mode == 0) return (R & ~127) + hc;
    if (mode == 1) { if (tile < 8) return (bj ? 2048 : 0) + 128 * tile + hc;
        const int type = (tile - 8) >> 2, tl = (tile - 8) & 3; const int base = type == 0 ? 1024 : type == 1 ? 3072 : type == 2 ? 4096 : type == 3 ? 5120 : 6144;
        return base + 256 * tl + 128 * bj + hc; }
    return (bj ? DFF : 0) + 128 * tile + hc;
}

template <int RT, int NG, int K, class F>
__device__ __forceinline__ void sample_item(LAS unsigned char* lds, const bf16_t* A, int lda, int rt0, const bf16_t* Bt, int ldb, const int (&gr)[NG], const F& f) {
    static_assert(8 * RT * NG * 1024 <= LDS_STAGE, "sample_item: the eight partial tiles must fit the stage region");
    constexpr int KPER = K / 8, NKS = KPER / 32;
    static_assert(NKS * 32 * 8 == K, "sample_item: K must be a multiple of 256");
    int tid_ = threadIdx.x; asm volatile("" : "+v"(tid_));
    const int tid = tid_, w = __builtin_amdgcn_readfirstlane(tid >> 6), lane = tid & 63, fr = lane & 15, fq = lane >> 4;
    const bf16_t* ap = A + (size_t)(16 * rt0 + fr) * lda + w * KPER + 8 * fq;
    bf16x8 a[RT][NKS], b[NG][NKS];
#pragma unroll
    for (int ks = 0; ks < NKS; ++ks) {
#pragma unroll
        for (int rt = 0; rt < RT; ++rt) a[rt][ks] = *(const bf16x8*)(ap + (size_t)(16 * rt) * lda + 32 * ks);
#pragma unroll
        for (int g = 0; g < NG; ++g) b[g][ks] = *(const bf16x8*)(Bt + (size_t)(gr[g] + fr) * ldb + w * KPER + 8 * fq + 32 * ks);
    }
    f32x4 acc[RT][NG];
#pragma unroll
    for (int rt = 0; rt < RT; ++rt)
#pragma unroll
        for (int g = 0; g < NG; ++g) acc[rt][g] = (f32x4){0.f, 0.f, 0.f, 0.f};
#pragma unroll
    for (int ks = 0; ks < NKS; ++ks)
#pragma unroll
        for (int rt = 0; rt < RT; ++rt)
#pragma unroll
            for (int g = 0; g < NG; ++g) acc[rt][g] = __builtin_amdgcn_mfma_f32_16x16x32_bf16(b[g][ks], a[rt][ks], acc[rt][g], 0, 0, 0);
    LAS float* P = (LAS float*)lds;
#pragma unroll
    for (int rt = 0; rt < RT; ++rt)
#pragma unroll
        for (int g = 0; g < NG; ++g) *(LAS f32x4*)(P + ((w * RT + rt) * NG + g) * 256 + fr * 16 + 4 * fq) = acc[rt][g];
    BLK_BAR();
#pragma unroll
    for (int q = 0; q < (RT * 256 + 511) / 512; ++q) {
        const int e = tid + 512 * q;
        if (e < RT * 256) {
            const int rt = e >> 8, rc = e & 255;
            float v[NG];
#pragma unroll
            for (int g = 0; g < NG; ++g) { float s = 0.f;
#pragma unroll
                for (int w8 = 0; w8 < 8; ++w8) s += P[((w8 * RT + rt) * NG + g) * 256 + rc];
                v[g] = s; }
            f(16 * (rt0 + rt) + (rc >> 4), rc & 15, v);
        }
    }
    BLK_BAR();
}
__device__ __forceinline__ float grp16_sum(float s) {
    s += __shfl_xor(s, 1); s += __shfl_xor(s, 2); s += __shfl_xor(s, 4); s += __shfl_xor(s, 8); return s;
}
__device__ __forceinline__ void sample_rstd_table(LAS float* tab, const float* ssq_s) {
    const int tid = otid();
    if (tid < MS) { const f32x4* p = (const f32x4*)(ssq_s + (size_t)tid * 32); float s = 0.f;
#pragma unroll
        for (int q = 0; q < 8; ++q) { const f32x4 a = p[q]; s += (a[0] + a[1]) + (a[2] + a[3]); }
        tab[tid] = 1.0f / sqrtf(s * (1.0f / D) + EPS); }
    BLK_BAR();
}

struct SfInA {
    Ctx cx; int R0;
    __device__ __forceinline__ void operator()(int i, int c, const float (&v)[6]) const {
        const KPtr kp = kargs(); const float* rstd0 = (const float*)(cx.ws + WS_RSTD0); const float* wca = kp->w_conv_a; const float* sa = kp->st_a; bf16_t* ba = (bf16_t*)(cx.ws + WS_BA); float* out = cx.out;
        const float rs = rstd0[MP + i];
#pragma unroll
        for (int n = 0; n < 2; ++n) { const int ch = colmap(1, R0 + 16 * n + c);
            const float cav = (v[n] * rs) * (v[2 + n] * rs), bb = v[4 + n] * rs;
            out[O_CAS + (size_t)(i * 2 + 1) * D + ch] = cav;
            const float conv = wca[ch] * sa[(size_t)(i * 2) * D + ch] + wca[D + ch] * sa[(size_t)(i * 2 + 1) * D + ch] + wca[2 * D + ch] * cav;
            ba[(size_t)(MP + i) * D + ch] = f2bf(bb * conv); }
    }
};
struct SfInB {
    Ctx cx; int R0, type, slot;
    __device__ __forceinline__ void operator()(int i, int c, const float (&v)[4]) const {
        const float* rstd0 = (const float*)(cx.ws + WS_RSTD0); float* vssq_s = (float*)(cx.ws + WS_VSSQS);
        bf16_t* dst = type == 0 ? (bf16_t*)(cx.ws + WS_UU) : type == 1 ? (bf16_t*)(cx.ws + WS_VP) : type == 2 ? (bf16_t*)(cx.ws + WS_SGA) : (bf16_t*)cx.out;
        const int base = type == 0 ? 3072 : type == 1 ? 4096 : type == 2 ? 5120 : 6144;
        const float rs = rstd0[MP + i]; float s = 0.f;
#pragma unroll
        for (int g = 0; g < 4; ++g) { const int col = colmap(1, R0 + 16 * g + c) - base; float x = v[g] * rs;
            x = type <= 1 ? gelu_tanh(x) : sigmoid_f(x); s += x * x;
            dst[(size_t)(MP + i) * D + col] = f2bf(x); }
        if (type == 1) { s = grp16_sum(s); if (c == 0) vssq_s[i * 16 + slot] = s; }
    }
};
struct SfYa { Ctx cx; int R0;
    __device__ __forceinline__ void operator()(int i, int c, const float (&v)[2]) const {
        const bf16_t* sga = (const bf16_t*)(cx.ws + WS_SGA); float* t1s = (float*)(cx.ws + WS_T1S);
#pragma unroll
        for (int g = 0; g < 2; ++g) { const int col = colmap(0, R0 + 16 * g + c); t1s[i * D + col] = bf2f(sga[(size_t)(MP + i) * D + col]) * v[g]; }
    }
};
struct SfYb { Ctx cx; int R0;
    __device__ __forceinline__ void operator()(int i, int c, const float (&v)[2]) const {
        const bf16_t* sgb = (const bf16_t*)cx.out; const float* t1s = (const float*)(cx.ws + WS_T1S); bf16_t* mm = (bf16_t*)(cx.ws + WS_XB);
#pragma unroll
        for (int g = 0; g < 2; ++g) { const int col = colmap(0, R0 + 16 * g + c); mm[(size_t)(MP + i) * D + col] = f2bf(t1s[i * D + col] + bf2f(sgb[(size_t)(MP + i) * D + col]) * v[g]); }
    }
};
struct SfRes {
    Ctx cx; int R0, slot, which;
    __device__ __forceinline__ void operator()(int i, int c, const float (&v)[2]) const {
        float* h = cx.out; const float* base = which == 0 ? kargs()->x_s : h + (size_t)MP * D; bf16_t* hb = (bf16_t*)(cx.ws + (which == 0 ? WS_H1B : WS_H2B)); float* ssq_s = (float*)(cx.ws + (which == 0 ? WS_SSQ1S : WS_SSQ2S));
        float s = 0.f;
#pragma unroll
        for (int g = 0; g < 2; ++g) { const int col = colmap(0, R0 + 16 * g + c); const float x = base[(size_t)i * D + col] + v[g];
            h[(size_t)(MP + i) * D + col] = x; hb[(size_t)(MP + i) * D + col] = f2bf(x); s += x * x; }
        s = grp16_sum(s); if (c == 0) ssq_s[i * 32 + slot] = s;
    }
};
struct SfUp {
    Ctx cx; const LAS float* rs; int R0;
    __device__ __forceinline__ void operator()(int i, int c, const float (&v)[4]) const {
        const KPtr kp = kargs(); const float* wcf = kp->w_conv_f; const float* sf = kp->st_f; bf16_t* a3 = (bf16_t*)(cx.ws + WS_A3); float* out = cx.out;
        const float r = rs[i];
        float* o = out + O_CFS + (size_t)(i * 2 + 1) * NUP; const float* s0 = sf + (size_t)(i * 2) * NUP; const float* s1 = s0 + NUP;
#pragma unroll
        for (int n = 0; n < 2; ++n) { const int ja = colmap(2, R0 + 16 * n + c), jb = ja + DFF;
            const float ua = v[n] * r, ub = v[2 + n] * r;
            o[ja] = ua; o[jb] = ub;
            const float ca = wcf[ja] * s0[ja] + wcf[NUP + ja] * s1[ja] + wcf[2 * NUP + ja] * ua;
            const float cb = wcf[jb] * s0[jb] + wcf[NUP + jb] * s1[jb] + wcf[2 * NUP + jb] * ub;
            a3[(size_t)(MP + i) * DFF + ja] = f2bf(gelu_tanh(ca) * cb); }
    }
};
struct SfPe { Ctx cx; int R0;
    __device__ __forceinline__ void operator()(int i, int c, const float (&v)[2]) const {
        float* pes = (float*)(cx.ws + WS_PES);
#pragma unroll
        for (int g = 0; g < 2; ++g) pes[i * D + colmap(0, R0 + 16 * g + c)] = v[g];
    }
};
struct SfGate { Ctx cx; const LAS float* rs; int R0;
    __device__ __forceinline__ void operator()(int i, int c, const float (&v)[2]) const {
        const float* pes = (const float*)(cx.ws + WS_PES); float* h = cx.out;
        const float r = rs[i];
#pragma unroll
        for (int g = 0; g < 2; ++g) { const int col = colmap(0, R0 + 16 * g + c); float* hp = h + (size_t)(MP + i) * D + col; *hp = *hp + sigmoid_f(r * v[g]) * pes[i * D + col]; }
    }
};

__device__ __forceinline__ void p0_rows(const KPtr P, bf16_t* xb, float* rstd0, bf16_t* pb) {
    const int tid = otid(), lane = tid & 63, gw = blockIdx.x * 8 + (tid >> 6), NGW = gridDim.x * 8;
    for (int r = gw; r < MV; r += NGW) {
        const f32x4* src = (const f32x4*)(r < MP ? P->x_p + (size_t)r * D : P->x_s + (size_t)(r - MP) * D) + lane;
        f32x4 v[4]; float s = 0.f;
#pragma unroll
        for (int j = 0; j < 4; ++j) { v[j] = src[64 * j]; s += sum4sq(v[j]); }
        s = wave_sum(s);
        if (lane == 0) rstd0[r] = 1.0f / sqrtf(s * (1.0f / D) + EPS);
        unsigned long long* o8 = (unsigned long long*)(xb + (size_t)r * D) + lane;
#pragma unroll
        for (int j = 0; j < 4; ++j) o8[64 * j] = (unsigned long long)cvt_pk_bf16(v[j][0], v[j][1]) | ((unsigned long long)cvt_pk_bf16(v[j][2], v[j][3]) << 32);
    }
    const size_t gt = (size_t)blockIdx.x * 512 + tid, gs = (size_t)gridDim.x * 512;
    for (size_t i4 = gt; i4 < (size_t)MV * PD / 4; i4 += gs) { const size_t i = i4 * 4;
        const f32x4 v = i < (size_t)MP * PD ? *(const f32x4*)(P->p_p + i) : *(const f32x4*)(P->p_s + (i - (size_t)MP * PD));
        *(unsigned long long*)(pb + i) = (unsigned long long)cvt_pk_bf16(v[0], v[1]) | ((unsigned long long)cvt_pk_bf16(v[2], v[3]) << 32); }
    for (size_t e = gt; e < (size_t)MS * (D + NUP); e += gs) { const int i = (int)(e / (D + NUP)), c = (int)(e % (D + NUP));
        if (c < D) P->out[O_CAS + (size_t)(i * 2) * D + c] = P->st_a[(size_t)(i * 2 + 1) * D + c];
        else P->out[O_CFS + (size_t)(i * 2) * NUP + (c - D)] = P->st_f[(size_t)(i * 2 + 1) * NUP + (c - D)]; }
}
__device__ __forceinline__ void wt_tile_load(const float* W, const float* scale, int Nw, int mode, int R0, int k0, LAS float* t, int ht) {
    const int tx = ht & 63, ty = ht >> 6; const int col = colmap(mode, R0 + tx);
#pragma unroll
    for (int i = 0; i < 16; ++i) { const int k = k0 + ty + 4 * i; t[(ty + 4 * i) * 65 + tx] = W[(size_t)k * Nw + col] * (scale ? scale[k] : 1.0f); }
}
__device__ __forceinline__ void wt_tile_store(bf16_t* out, int K, int R0, int k0, const LAS float* t, int ht) {
    const int Rl = ht >> 2, kq = ht & 3; const LAS float* s = t + (kq * 16) * 65 + Rl;
    u32x4 w0, w1;
    w0.x = cvt_pk_bf16(s[0 * 65], s[1 * 65]); w0.y = cvt_pk_bf16(s[2 * 65], s[3 * 65]); w0.z = cvt_pk_bf16(s[4 * 65], s[5 * 65]); w0.w = cvt_pk_bf16(s[6 * 65], s[7 * 65]);
    w1.x = cvt_pk_bf16(s[8 * 65], s[9 * 65]); w1.y = cvt_pk_bf16(s[10 * 65], s[11 * 65]); w1.z = cvt_pk_bf16(s[12 * 65], s[13 * 65]); w1.w = cvt_pk_bf16(s[14 * 65], s[15 * 65]);
    bf16_t* o = out + (size_t)(R0 + Rl) * K + k0 + kq * 16;
    *(u32x4*)o = w0; *(u32x4*)(o + 8) = w1;
}
struct WtJob { const float* W; const float* scale; bf16_t* out; int K, Nw, mode, R0, k0; };
__device__ __forceinline__ bool wt_decode(const KPtr P, unsigned char* ws, int it, WtJob& j) {
    constexpr int T_IN = (NIN / 64) * (D / 64), T_SQ = (D / 64) * (D / 64), T_UP = (NUP / 64) * (D / 64), T_DN = (D / 64) * (DFF / 64), T_PL = (D / 64) * (PD / 64);
    int nk;
    if (it < T_IN) { j.W = P->w_in; j.scale = P->g_mix; j.out = (bf16_t*)(ws + WS_WIN); j.K = D; j.Nw = NIN; j.mode = 1; nk = D / 64; }
    else if ((it -= T_IN) < T_SQ) { j.W = P->w_out_a; j.scale = nullptr; j.out = (bf16_t*)(ws + WS_WOA); j.K = D; j.Nw = D; j.mode = 0; nk = D / 64; }
    else if ((it -= T_SQ) < T_SQ) { j.W = P->w_out_b; j.scale = nullptr; j.out = (bf16_t*)(ws + WS_WOB); j.K = D; j.Nw = D; j.mode = 0; nk = D / 64; }
    else if ((it -= T_SQ) < T_SQ) { j.W = P->w_o; j.scale = nullptr; j.out = (bf16_t*)(ws + WS_WO); j.K = D; j.Nw = D; j.mode = 0; nk = D / 64; }
    else if ((it -= T_SQ) < T_SQ) { j.W = P->w_pg; j.scale = P->g_ple; j.out = (bf16_t*)(ws + WS_WPG); j.K = D; j.Nw = D; j.mode = 0; nk = D / 64; }
    else if ((it -= T_SQ) < T_UP) { j.W = P->w_up; j.scale = P->g_ffn; j.out = (bf16_t*)(ws + WS_WUP); j.K = D; j.Nw = NUP; j.mode = 2; nk = D / 64; }
    else if ((it -= T_UP) < T_DN) { j.W = P->w_down; j.scale = nullptr; j.out = (bf16_t*)(ws + WS_WDOWN); j.K = DFF; j.Nw = D; j.mode = 0; nk = DFF / 64; }
    else if ((it -= T_DN) < T_PL) { j.W = P->w_ple; j.scale = nullptr; j.out = (bf16_t*)(ws + WS_WPLE); j.K = PD; j.Nw = D; j.mode = 0; nk = PD / 64; }
    else return false;
    j.R0 = (it / nk) * 64; j.k0 = (it % nk) * 64; return true;
}
constexpr int WT_TILES = (NIN / 64) * (D / 64) + 4 * (D / 64) * (D / 64) + (NUP / 64) * (D / 64) + (D / 64) * (DFF / 64) + (D / 64) * (PD / 64);
__device__ __forceinline__ void p0_weights(const KPtr P, unsigned char* ws, LAS unsigned char* lds) {
    const int tid = otid(), half = tid >> 8, ht = tid & 255;
    LAS float* t = (LAS float*)lds + half * (64 * 65);
    for (int base = blockIdx.x * 2; base < WT_TILES; base += gridDim.x * 2) {
        WtJob j; const bool ok = wt_decode(P, ws, base + half, j);
        if (ok) wt_tile_load(j.W, j.scale, j.Nw, j.mode, j.R0, j.k0, t, ht);
        BLK_BAR();
        if (ok) wt_tile_store(j.out, j.K, j.R0, j.k0, t, ht);
        BLK_BAR();
    }
}
__device__ __forceinline__ void p2_convA(const bf16_t* ca, const bf16_t* ba, bf16_t* dst, const float* wc) {
    const f32x4 z = (f32x4){0.f, 0.f, 0.f, 0.f};
    for (size_t idx = (size_t)blockIdx.x * 512 + otid(); idx < (size_t)MP * 128; idx += (size_t)gridDim.x * 512) {
        const int r = (int)(idx >> 7), j = (int)(idx & 127) * 8, t = r & (SEQ - 1);
        f32x4 c0a, c0b, c1a = z, c1b = z, c2a = z, c2b = z;
        load8_bf16(ca + (size_t)r * D + j, c0a, c0b);
        if (t >= 1) load8_bf16(ca + (size_t)(r - 1) * D + j, c1a, c1b);
        if (t >= 2) load8_bf16(ca + (size_t)(r - 2) * D + j, c2a, c2b);
        const f32x4 w0a = *(const f32x4*)(wc + j), w0b = *(const f32x4*)(wc + j + 4), w1a = *(const f32x4*)(wc + D + j), w1b = *(const f32x4*)(wc + D + j + 4),
                    w2a = *(const f32x4*)(wc + 2 * D + j), w2b = *(const f32x4*)(wc + 2 * D + j + 4);
        f32x4 b0, b1; load8_bf16(ba + (size_t)r * D + j, b0, b1);
        store8_bf16(dst + (size_t)r * D + j, b0 * (w0a * c2a + w1a * c1a + w2a * c0a), b1 * (w0b * c2b + w1b * c1b + w2b * c0b));
    }
}
__device__ __forceinline__ unsigned sp_off(unsigned row, unsigned ch) { return 256u * row + 16u * (ch ^ (((row & 3u) << 2) | ((row >> 2) & 3u))); }
typedef unsigned short u16x4_t __attribute__((ext_vector_type(4)));
__device__ __forceinline__ void p2_spatial(const KPtr P, LAS unsigned char* lds, const bf16_t* vp, const bf16_t* uu, bf16_t* udst, const float* vssq) {
    int tid_ = threadIdx.x; asm volatile("" : "+v"(tid_));
    const int tid = tid_, w = __builtin_amdgcn_readfirstlane(tid >> 6), lane = tid & 63, fr = lane & 15, fq = lane >> 4;
    LAS unsigned char* Vimg = lds; LAS unsigned char* Wimg = lds + 32768; LAS float* rs = (LAS float*)(lds + 65536);
    const float* gv = P->g_v; const float* wsp = P->w_sp; const float* bsp = P->b_sp; float* out = P->out;
    int g_loaded = -1;
    for (int it = blockIdx.x; it < (MP / 128) * 8; it += gridDim.x) {
        const int g = it & 7, c = it >> 3, r0 = c * 128, d0 = g * 128;
        if (tid < 128) { const f32x4* p = (const f32x4*)(vssq + (size_t)(r0 + tid) * 16); float s = 0.f;
#pragma unroll
            for (int q = 0; q < 4; ++q) { const f32x4 a = p[q]; s += (a[0] + a[1]) + (a[2] + a[3]); }
            rs[tid] = 1.0f / sqrtf(s * (1.0f / D) + EPS); }
        if (g != g_loaded) {
            const float* W = wsp + (size_t)g * 128 * 128;
#pragma unroll
            for (int i = 0; i < 4; ++i) { const int n = tid + 512 * i, t = n >> 4, ch = n & 15, s0 = 8 * ch;
                f32x4 a = *(const f32x4*)(W + t * 128 + s0), b = *(const f32x4*)(W + t * 128 + s0 + 4);
#pragma unroll
                for (int j = 0; j < 4; ++j) { if (s0 + j > t) a[j] = 0.f; if (s0 + 4 + j > t) b[j] = 0.f; }
                u32x4 pk; pk.x = cvt_pk_bf16(a[0], a[1]); pk.y = cvt_pk_bf16(a[2], a[3]); pk.z = cvt_pk_bf16(b[0], b[1]); pk.w = cvt_pk_bf16(b[2], b[3]);
                *(LAS u32x4*)(Wimg + sp_off(t, ch)) = pk; }
            g_loaded = g;
        }
        BLK_BAR();
        const bool last = (c & 15) == 15; const int b = c >> 4;
#pragma unroll
        for (int i = 0; i < 4; ++i) { const int n = tid + 512 * i, s = n >> 4, ch = n & 15;
            f32x4 a, bq; load8_bf16(vp + (size_t)(r0 + s) * D + d0 + 8 * ch, a, bq);
            const float r = rs[s]; const f32x4 ga = *(const f32x4*)(gv + d0 + 8 * ch), gb = *(const f32x4*)(gv + d0 + 8 * ch + 4);
            a = a * r * ga; bq = bq * r * gb;
            if (last) { float* o = out + O_CVP + ((size_t)(b * 128 + s)) * D + d0 + 8 * ch; *(f32x4*)o = a; *(f32x4*)(o + 4) = bq; }
            u32x4 pk; pk.x = cvt_pk_bf16(a[0], a[1]); pk.y = cvt_pk_bf16(a[2], a[3]); pk.z = cvt_pk_bf16(bq[0], bq[1]); pk.w = cvt_pk_bf16(bq[2], bq[3]);
            *(LAS u32x4*)(Vimg + sp_off(s, ch)) = pk; }
        BLK_BAR();
        const unsigned q4 = (unsigned)(fr >> 2), p4 = (unsigned)(fr & 3);
        const unsigned vbase = (unsigned)(size_t)Vimg;
        const unsigned a0 = vbase + sp_off(8u * fq + q4, 2u * w + (p4 >> 1)) + 8u * (p4 & 1u);
        const unsigned a1 = vbase + sp_off(8u * fq + 4u + q4, 2u * w + (p4 >> 1)) + 8u * (p4 & 1u);
        u16x4_t v00, v01, v10, v11, v20, v21, v30, v31;
        asm volatile("ds_read_b64_tr_b16 %0, %8\n\tds_read_b64_tr_b16 %1, %9\n\tds_read_b64_tr_b16 %2, %8 offset:8192\n\tds_read_b64_tr_b16 %3, %9 offset:8192\n\t"
                     "ds_read_b64_tr_b16 %4, %8 offset:16384\n\tds_read_b64_tr_b16 %5, %9 offset:16384\n\tds_read_b64_tr_b16 %6, %8 offset:24576\n\tds_read_b64_tr_b16 %7, %9 offset:24576\n\t"
                     "s_waitcnt lgkmcnt(0)"
                     : "=&v"(v00), "=&v"(v01), "=&v"(v10), "=&v"(v11), "=&v"(v20), "=&v"(v21), "=&v"(v30), "=&v"(v31) : "v"(a0), "v"(a1) : "memory");
        bf16x8 Vf[4];
        Vf[0] = (bf16x8){(short)v00[0], (short)v00[1], (short)v00[2], (short)v00[3], (short)v01[0], (short)v01[1], (short)v01[2], (short)v01[3]};
        Vf[1] = (bf16x8){(short)v10[0], (short)v10[1], (short)v10[2], (short)v10[3], (short)v11[0], (short)v11[1], (short)v11[2], (short)v11[3]};
        Vf[2] = (bf16x8){(short)v20[0], (short)v20[1], (short)v20[2], (short)v20[3], (short)v21[0], (short)v21[1], (short)v21[2], (short)v21[3]};
        Vf[3] = (bf16x8){(short)v30[0], (short)v30[1], (short)v30[2], (short)v30[3], (short)v31[0], (short)v31[1], (short)v31[2], (short)v31[3]};
        f32x4 acc[8];
#pragma unroll
        for (int tt = 0; tt < 8; ++tt) { acc[tt] = (f32x4){0.f, 0.f, 0.f, 0.f};
#pragma unroll
            for (int ks = 0; ks < 4; ++ks) if (2 * ks <= tt) {
                const bf16x8 Wf = *(const LAS bf16x8*)(Wimg + sp_off((unsigned)(16 * tt + fr), (unsigned)(4 * ks + fq)));
                acc[tt] = __builtin_amdgcn_mfma_f32_16x16x32_bf16(Vf[ks], Wf, acc[tt], 0, 0, 0); } }
#pragma unroll
        for (int tt = 0; tt < 8; ++tt) { const int t = 16 * tt + fr; const float bb = bsp[g * 128 + t];
            const size_t uo = (size_t)(r0 + t) * D + d0 + 16 * w + 4 * fq;
            const unsigned long long uw = *(const unsigned long long*)(uu + uo);
            const float u0 = __uint_as_float((unsigned)(uw << 16)), u1 = __uint_as_float((unsigned)uw & 0xffff0000u), u2 = __uint_as_float((unsigned)(uw >> 32) << 16), u3 = __uint_as_float((unsigned)(uw >> 32) & 0xffff0000u);
            const f32x4 s4 = acc[tt] + bb;
            *(unsigned long long*)(udst + uo) = (unsigned long long)cvt_pk_bf16(u0 * s4[0], u1 * s4[1]) | ((unsigned long long)cvt_pk_bf16(u2 * s4[2], u3 * s4[3]) << 32); }
        BLK_BAR();
    }
}
__device__ __forceinline__ void p2_spatial_s(const KPtr P, const bf16_t* vp, bf16_t* uu, const float* vssq_s) {
    const int tid = otid(), lane = tid & 63, gw = blockIdx.x * 8 + (tid >> 6), NGW = gridDim.x * 8;
    for (int i = gw; i < MS; i += NGW) {
        float s = lane < 16 ? vssq_s[i * 16 + lane] : 0.f; s = wave_sum(s);
        const float rsv = 1.0f / sqrtf(s * (1.0f / D) + EPS); const size_t r = (size_t)(MP + i) * D;
        for (int d = lane; d < D; d += 64) { const int g = d >> 7;
            const float vnv = bf2f(vp[r + d]) * rsv * P->g_v[d];
            P->out[O_CVS + (size_t)i * D + d] = vnv;
            uu[r + d] = f2bf(bf2f(uu[r + d]) * (P->w_sp[(size_t)g * 128 * 128] * vnv + P->b_sp[g * 128])); }
    }
}
__device__ __forceinline__ void p5_convF(const bf16_t* uph, bf16_t* a3, const float* wcf, int half) {
    const f32x4 z = (f32x4){0.f, 0.f, 0.f, 0.f};
    for (size_t idx = (size_t)blockIdx.x * 512 + threadIdx.x; idx < (size_t)MP * 176; idx += (size_t)gridDim.x * 512) {
        const int c8 = (int)(idx & 15), t = (int)((idx >> 4) % 11), r = (int)(idx / 176), tt = r & (SEQ - 1);
        const int c = c8 * 8, ja = 1408 * half + 128 * t + c, jb = DFF + ja;
        const bf16_t* pa = uph + (size_t)r * DFF + 256 * t + c; const bf16_t* pb = pa + 128;
        f32x4 a0[2], a1[2], a2[2], b0[2], b1[2], b2[2];
        load8_bf16(pa, a0[0], a0[1]); load8_bf16(pb, b0[0], b0[1]);
        if (tt >= 1) { load8_bf16(pa - DFF, a1[0], a1[1]); load8_bf16(pb - DFF, b1[0], b1[1]); } else { a1[0] = a1[1] = b1[0] = b1[1] = z; }
        if (tt >= 2) { load8_bf16(pa - 2 * DFF, a2[0], a2[1]); load8_bf16(pb - 2 * DFF, b2[0], b2[1]); } else { a2[0] = a2[1] = b2[0] = b2[1] = z; }
        f32x4 o[2];
#pragma unroll
        for (int q = 0; q < 2; ++q) {
            const f32x4 wa0 = *(const f32x4*)(wcf + ja + 4 * q), wa1 = *(const f32x4*)(wcf + NUP + ja + 4 * q), wa2 = *(const f32x4*)(wcf + 2 * NUP + ja + 4 * q);
            const f32x4 wb0 = *(const f32x4*)(wcf + jb + 4 * q), wb1 = *(const f32x4*)(wcf + NUP + jb + 4 * q), wb2 = *(const f32x4*)(wcf + 2 * NUP + jb + 4 * q);
            f32x4 cav = wa0 * a2[q] + wa1 * a1[q] + wa2 * a0[q]; const f32x4 cbv = wb0 * b2[q] + wb1 * b1[q] + wb2 * b0[q];
#pragma unroll
            for (int j = 0; j < 4; ++j) cav[j] = gelu_tanh(cav[j]);
            o[q] = cav * cbv; }
        store8_bf16(a3 + (size_t)r * DFF + ja, o[0], o[1]);
    }
}
__device__ __forceinline__ void p8_final(const float* h, float* dst, const float* gf) {
    const int tid = otid(), lane = tid & 63, gw = blockIdx.x * 8 + (tid >> 6), NGW = gridDim.x * 8;
    for (int r = gw; r < MV; r += NGW) {
        const f32x4* p = (const f32x4*)(h + (size_t)r * D) + lane; f32x4* pd = (f32x4*)(dst + (size_t)r * D) + lane; f32x4 v[4]; float s = 0.f;
#pragma unroll
        for (int j = 0; j < 4; ++j) { v[j] = p[64 * j]; s += sum4sq(v[j]); }
        s = wave_sum(s); const float rs = 1.0f / sqrtf(s * (1.0f / D) + EPS);
#pragma unroll
        for (int j = 0; j < 4; ++j) { const f32x4 g = *((const f32x4*)gf + lane + 64 * j); pd[64 * j] = v[j] * rs * g; }
    }
}

__device__ __forceinline__ void p6_fixup(const Ctx c, const KPtr P, int pm) {
    if ((pm & 7) == 0) return;
    const float* hb = WSP(const float, WS_HB); bf16_t* a3 = WSP(bf16_t, WS_A3); const float* wcf = P->w_conv_f;
    const float* pv = hb + ((size_t)(pm - 1) * 4) * NUP;
    const float* cu = hb + ((size_t)pm * 4 + 2) * NUP;
    for (int e = otid(); e < 2 * (DFF / 4); e += 512) { const int row = e / (DFF / 4), ja = (e % (DFF / 4)) * 4, jb = DFF + ja;
        f32x4 cv[2];
#pragma unroll
        for (int s = 0; s < 2; ++s) { const int j = s ? jb : ja;
            const f32x4 w0 = *(const f32x4*)(wcf + j), w1 = *(const f32x4*)(wcf + NUP + j), w2 = *(const f32x4*)(wcf + 2 * NUP + j);
            const f32x4 m2 = row == 0 ? *(const f32x4*)(pv + j) : *(const f32x4*)(pv + NUP + j);
            const f32x4 m1 = row == 0 ? *(const f32x4*)(pv + NUP + j) : *(const f32x4*)(cu + j);
            const f32x4 m0 = row == 0 ? *(const f32x4*)(cu + j) : *(const f32x4*)(cu + NUP + j);
            cv[s] = w0 * m2 + w1 * m1 + w2 * m0; }
        f32x4 o;
#pragma unroll
        for (int j = 0; j < 4; ++j) o[j] = gelu_tanh(cv[0][j]) * cv[1][j];
        *(unsigned long long*)(a3 + (size_t)(pm * 256 + row) * DFF + ja) = (unsigned long long)cvt_pk_bf16(o[0], o[1]) | ((unsigned long long)cvt_pk_bf16(o[2], o[3]) << 32); }
    asm volatile("s_waitcnt vmcnt(0)" ::: "memory");
    __syncthreads();
}
template <class Epi> __device__ __forceinline__ void run_gemm(LAS unsigned char* lds, const bf16_t* A, int lda, const bf16_t* Bt, int ldb, int N, int K, const Epi& E) {
    pg8::Gemm g; g.A = A; g.Bt = Bt; g.M = MP; g.N = N; g.K = K; g.lda = lda; g.ldb = ldb; g.pad = 0;
    pg8::StaticOrder S; S.init(MP, N, (int)gridDim.x, (int)blockIdx.x);
    pg8::gemm_phase<Epi, pg8::StaticOrder, true, true>(lds, g, S, E);
}

#ifndef PROBE_A
#define PROBE_A -1
#define PROBE_B -1
#endif
template <class Epi> __device__ __forceinline__ void run_gemm2(LAS unsigned char* lds, const Ctx c, size_t a_off, int lda, size_t b_off, int ldb, int N, int K, const Epi& E) {
    pg8::Gemm g; g.A = (const bf16_t*)(c.ws + a_off); g.Bt = (const bf16_t*)(c.ws + b_off); g.M = MP; g.N = N; g.K = K; g.lda = lda; g.ldb = ldb; g.pad = 0;
    pg8::StaticOrder S; S.init(MP, N, (int)gridDim.x, (int)blockIdx.x);
    pg8::gemm_phase<Epi, pg8::StaticOrder, true, true>(lds, g, S, E);
}
__global__ void __launch_bounds__(512, 2) mega_fwd(Ptrs P_unused) {
    extern __shared__ __attribute__((aligned(16))) unsigned char lds_raw[];
    LAS unsigned char* lds = (LAS unsigned char*)lds_raw;
    volatile LAS unsigned* MISC = (volatile LAS unsigned*)(lds + LDS_CTL_OFF);
    if (threadIdx.x < 128) MISC[threadIdx.x] = 0u;
    __syncthreads();
    { const KPtr kp = kargs(); (void)xcd_barrier_post((unsigned*)(kp->ws + WS_CTL), MISC + 8); }
    enum { CNT0 = __COUNTER__ };
#define STAMP(k) do { if (PROBE_A >= 0 && threadIdx.x == 0) ((volatile LAS unsigned*)(lds + LDS_CTL_OFF + 256))[k] = (unsigned)__builtin_amdgcn_s_memrealtime(); } while (0)
#define GRID_BAR() do { XcdBarrier b_; b_.bar = (unsigned*)(kargs()->ws + WS_CTL); b_.x = xb_xcc_id(); b_.st = (volatile LAS unsigned*)(lds + LDS_CTL_OFF) + 8; xcd_barrier(b_); STAMP(__COUNTER__ - CNT0); } while (0)
#define CTX() Ctx c; { const KPtr kp_ = kargs(); c.ws = kp_->ws; c.out = kp_->out; }
    STAMP(0);
#define rstab ((LAS float*)(lds + LDS_XTRA_OFF))
#define G ((int)gridDim.x)
#define bid ((int)blockIdx.x)

    {   CTX();
    { const KPtr kp = kargs();
      p0_rows(kp, WSP(bf16_t, WS_XB), WSP(float, WS_RSTD0), WSP(bf16_t, WS_PB));
      p0_weights(kp, c.ws, lds); }
    }
    GRID_BAR();
    {   CTX();
    { EpiIn E; E.c = c; run_gemm2(lds, c, WS_XB, D, WS_WIN, D, NIN, D, E); }
    for (int it = bid; it < 512; it += G) {
        const bf16_t* As = WSP(const bf16_t, WS_XB) + (size_t)MP * D; const bf16_t* Bt = WSP(const bf16_t, WS_WIN);
        if (it < 256) { const int rt = it >> 5, t = (it >> 2) & 7, wc = it & 3, Rx = t * 256 + wc * 32, Rb = (8 + (t >> 1)) * 256 + (t & 1) * 128 + wc * 32;
            const int gr[6] = {Rx, Rx + 16, Rx + 128, Rx + 144, Rb, Rb + 16};
            SfInA f; f.cx = c; f.R0 = Rx;
            sample_item<1, 6, D>(lds, As, D, rt, Bt, D, gr, f);
        } else { const int j = it - 256, rh = j >> 6, tile = 12 + ((j >> 2) & 15), bj = (j >> 1) & 1, wcp = j & 1, R0 = tile * 256 + bj * 128 + wcp * 64, type = (tile - 12) >> 2;
            const int gr[4] = {R0, R0 + 16, R0 + 32, R0 + 48};
            SfInB f; f.cx = c; f.R0 = R0; f.type = type; f.slot = ((tile - 16) & 3) * 4 + bj * 2 + wcp;
            sample_item<2, 4, D>(lds, As, D, 2 * rh, Bt, D, gr, f); }
    }
    }
    GRID_BAR();
    {   CTX();
    { const KPtr kp = kargs();
      p2_convA(WSP(const bf16_t, WS_CA), WSP(const bf16_t, WS_BA), WSP(bf16_t, WS_BA), kp->w_conv_a);
      p2_spatial(kp, lds, WSP(const bf16_t, WS_VP), WSP(const bf16_t, WS_UU), WSP(bf16_t, WS_UU), WSP(const float, WS_VSSQ));
      p2_spatial_s(kp, WSP(const bf16_t, WS_VP), WSP(bf16_t, WS_UU), WSP(const float, WS_VSSQS)); }
    }
    GRID_BAR();
    {   CTX();
    { EpiYa E; E.c = c; run_gemm2(lds, c, WS_BA, D, WS_WOA, D, D, D, E); }
    for (int it = bid; it < 256; it += G) { const int rt = it >> 5, cg = it & 31; const int gr[2] = {cg * 32, cg * 32 + 16}; SfYa f; f.cx = c; f.R0 = cg * 32;
        sample_item<1, 2, D>(lds, WSP(const bf16_t, WS_BA) + (size_t)MP * D, D, rt, WSP(const bf16_t, WS_WOA), D, gr, f); }
    }
    GRID_BAR();
    {   CTX();
    { EpiYb E; E.c = c; run_gemm2(lds, c, WS_UU, D, WS_WOB, D, D, D, E); }
    for (int it = bid; it < 256; it += G) { const int rt = it >> 5, cg = it & 31; const int gr[2] = {cg * 32, cg * 32 + 16}; SfYb f; f.cx = c; f.R0 = cg * 32;
        sample_item<1, 2, D>(lds, WSP(const bf16_t, WS_UU) + (size_t)MP * D, D, rt, WSP(const bf16_t, WS_WOB), D, gr, f); }
    }
    GRID_BAR();
    {   CTX();
    { EpiRes<0> E; E.c = c; run_gemm2(lds, c, WS_XB, D, WS_WO, D, D, D, E); }
    for (int it = bid; it < 256; it += G) { const int rt = it >> 5, cg = it & 31; const int gr[2] = {cg * 32, cg * 32 + 16}; SfRes f; f.cx = c; f.R0 = cg * 32; f.slot = cg; f.which = 0;
        sample_item<1, 2, D>(lds, WSP(const bf16_t, WS_XB) + (size_t)MP * D, D, rt, WSP(const bf16_t, WS_WO), D, gr, f); }
    }
    GRID_BAR();
    {   CTX();
    { EpiUpF E; E.c = c; E.halo = (LAS float*)(lds + LDS_XTRA_OFF); run_gemm2(lds, c, WS_H1B, D, WS_WUP, D, NUP, D, E); }
    sample_rstd_table(rstab, WSP(const float, WS_SSQ1S));
    for (int it = bid; it < 352; it += G) { const int rh = it / 88, j = it % 88, T = j >> 2, wc = j & 3, Ra = T * 256 + wc * 32; const int gr[4] = {Ra, Ra + 16, Ra + 128, Ra + 144};
        SfUp f; f.cx = c; f.rs = rstab; f.R0 = Ra;
        sample_item<2, 4, D>(lds, WSP(const bf16_t, WS_H1B) + (size_t)MP * D, D, 2 * rh, WSP(const bf16_t, WS_WUP), D, gr, f); }
    }
    GRID_BAR();
    {   CTX();
    { pg8::StaticOrder S0; S0.init(MP, D, G, bid); pg8::Unit u0; for (int i = 0; S0.next(i, u0); ++i) p6_fixup(c, kargs(), u0.pm); }
    { EpiRes<1> E; E.c = c; run_gemm2(lds, c, WS_A3, DFF, WS_WDOWN, DFF, D, DFF, E); }
    for (int it = bid; it < 256; it += G) { const int rt = it >> 5, cg = it & 31; const int gr[2] = {cg * 32, cg * 32 + 16};
        SfRes f; f.cx = c; f.R0 = cg * 32; f.slot = cg; f.which = 1;
        sample_item<1, 2, DFF>(lds, WSP(const bf16_t, WS_A3) + (size_t)MP * DFF, DFF, rt, WSP(const bf16_t, WS_WDOWN), DFF, gr, f); }
    }
    GRID_BAR();
    {   CTX();
    { EpiPe E; E.c = c; run_gemm2(lds, c, WS_PB, PD, WS_WPLE, PD, D, PD, E); }
    { EpiGate E; E.c = c; run_gemm2(lds, c, WS_H2B, D, WS_WPG, D, D, D, E); }
    sample_rstd_table(rstab, WSP(const float, WS_SSQ2S));
    for (int it = bid; it < 256; it += G) { const int rt = it >> 5, cg = it & 31; const int gr[2] = {cg * 32, cg * 32 + 16};
        { SfPe f; f.cx = c; f.R0 = cg * 32; sample_item<1, 2, PD>(lds, WSP(const bf16_t, WS_PB) + (size_t)MP * PD, PD, rt, WSP(const bf16_t, WS_WPLE), PD, gr, f); }
        { SfGate f; f.cx = c; f.rs = rstab; f.R0 = cg * 32; sample_item<1, 2, D>(lds, WSP(const bf16_t, WS_H2B) + (size_t)MP * D, D, rt, WSP(const bf16_t, WS_WPG), D, gr, f); } }
    }
    GRID_BAR();
    {   CTX();
    p8_final(c.out, c.out, kargs()->g_final);
    }
#if PROBE_A >= 0
    GRID_BAR();
    if (bid == 0) { CTX();
        volatile LAS unsigned* tsl = (volatile LAS unsigned*)(lds + LDS_CTL_OFF + 256);
        const float da = (float)(tsl[PROBE_A + 1] - tsl[PROBE_A]) * 0.01f;
        const float db = (float)(tsl[PROBE_B + 1] - tsl[PROBE_B]) * 0.01f;
        const float sc = 1.0f + da * 0.001f;
        for (int i = threadIdx.x; i < MS * D; i += 512) c.out[(size_t)MP * D + i] *= sc;
        if (threadIdx.x == 0) c.out[O_CAP] += db;
    }
#endif
}

extern "C" void kernel_launch(void* const* d_in, const int* in_sizes, int n_in, void* d_out, int out_size, void* d_ws, size_t ws_size, hipStream_t stream) {
    (void)in_sizes; (void)n_in; (void)out_size; (void)ws_size;
    static int grid = 0;
    if (grid == 0) {
        int dev = 0, cus = 0, per_cu = 0;
        (void)hipGetDevice(&dev); (void)hipDeviceGetAttribute(&cus, hipDeviceAttributeMultiprocessorCount, dev);
        (void)hipFuncSetAttribute((const void*)mega_fwd, hipFuncAttributeMaxDynamicSharedMemorySize, LDS_TOTAL);
        if (hipOccupancyMaxActiveBlocksPerMultiprocessor(&per_cu, (const void*)mega_fwd, 512, LDS_TOTAL) != hipSuccess || per_cu < 1) { per_cu = 1; (void)hipGetLastError(); }
        grid = cus * (per_cu > 1 ? 1 : per_cu);
        if (grid <= 0) grid = 256;
    }
    (void)hipMemsetAsync((char*)d_ws + WS_CTL, 0, CTL_BYTES, stream);
    Ptrs P{};
    const float** pf = (const float**)&P;
    for (int i = 0; i < 23; ++i) pf[i] = (const float*)d_in[i];
    P.out = (float*)d_out; P.ws = (unsigned char*)d_ws;
    void* args[] = {&P};
    hipError_t e = hipLaunchCooperativeKernel((const void*)mega_fwd, dim3(grid), dim3(512), args, LDS_TOTAL, stream);
    if (e != hipSuccess) { fprintf(stderr, "cooperative launch failed: %s (grid %d)\n", hipGetErrorString(e), grid); (void)hipGetLastError();
        hipLaunchKernelGGL(mega_fwd, dim3(grid), dim3(512), LDS_TOTAL, stream, P); }
}
```

```cpp
#include <hip/hip_runtime.h>
#include <cstdio>
#include <cstdint>
namespace pg8 {
#define PG8_LAS __attribute__((address_space(3)))
typedef unsigned short bf16_t;
typedef short bf16x8 __attribute__((ext_vector_type(8)));
typedef float f32x4 __attribute__((ext_vector_type(4)));
typedef unsigned u32x4 __attribute__((ext_vector_type(4)));
constexpr int BM = 256, BK = 64, HALF = 128, HTB = HALF * BK * 2  , STAGE_BYTES = 8 * HTB, NXCD = 8, WGM = 8;

__host__ __device__ __forceinline__ int lds_byte(int r, int c) { const int st = (r >> 4) * 2 + (c >> 5), rr = r & 15, cc = c & 31, ob = rr * 64 + cc * 2; return st * 1024 + (ob ^ (((ob >> 9) & 1) << 5)); }
__host__ __device__ __forceinline__ void stage_rc(int b, int& R, int& C) { const int st = b / 1024, sb = b % 1024, swz = sb ^ (((sb >> 9) & 1) << 5); R = (st >> 1) * 16 + swz / 64; C = (st & 1) * 32 + (swz % 64) / 2; }
__host__ __device__ __forceinline__ int perm32(int rho) { const int n = rho >> 4, i = rho & 15; return 8 * (i >> 2) + 4 * n + (i & 3); }

struct Unit { int pm, pn; };
struct Gemm { const bf16_t* A; const bf16_t* Bt; int M, N, K, lda, ldb, ksplit; long ajump; };

struct StaticOrder {
    int nM, nN, nwg, G, c;
    __host__ __device__ __forceinline__ void init(int M, int N, int G_, int c_) { nM = M / BM; nN = N / BM; nwg = nM * nN; G = G_; c = c_; }
    __host__ __device__ __forceinline__ bool next(int i, Unit& u) const {
        const long L = (long)i * G + c; if (L >= nwg) return false;
        int wgid = (int)L; { const int q = nwg / NXCD, r = nwg % NXCD, xcd = wgid % NXCD, off = wgid / NXCD; wgid = (xcd < r ? xcd * (q + 1) : r * (q + 1) + (xcd - r) * q) + off; }
        const int nig = WGM * nN, gid = wgid / nig, fm = gid * WGM, gsz = (nM - fm) < WGM ? (nM - fm) : WGM;
        u.pm = fm + ((wgid % nig) % gsz); u.pn = (wgid % nig) / gsz; return true;
    }
    __device__ __forceinline__ void a_ready(const Unit&) const {}
    __device__ __forceinline__ void done(const Unit&) const {}
};


typedef __bf16 bf16x2_nat __attribute__((ext_vector_type(2)));
typedef float f32x2_nat __attribute__((ext_vector_type(2)));
__device__ __forceinline__ unsigned cvt_pk_bf16(float lo, float hi) { const f32x2_nat v = {lo, hi}; return __builtin_bit_cast(unsigned, __builtin_convertvector(v, bf16x2_nat)); }
template <class Epi, class Sched, bool ALIGN_EPI = false, bool SP2 = false>
__device__ __forceinline__ void gemm_phase(PG8_LAS unsigned char* lds, const Gemm g, const Sched& S, const Epi& E) {
    int tid_ = threadIdx.x; asm volatile("" : "+v"(tid_));
    const int tid = tid_, wid = __builtin_amdgcn_readfirstlane(tid >> 6), lane = tid & 63, wr = wid >> 2, wc = wid & 3, fr = lane & 15, fq = lane >> 4;
    const int K = g.K, nt = K / BK;
    unsigned voffA[2], voffB[2];
#pragma unroll
    for (int i = 0; i < 2; ++i) { int R, C; stage_rc(tid * 16 + i * 8192, R, C); voffA[i] = (unsigned)(R * g.lda + C) * 2u; voffB[i] = (unsigned)(R * g.ldb + C) * 2u; }
    const size_t kstep = (size_t)(BK * 2);
    const size_t hstepA = (size_t)HALF * g.lda * 2, hstepB = (size_t)HALF * g.ldb * 2;
    const size_t tstepA = 2 * hstepA, tstepB = 2 * hstepB;
    const unsigned ldsw = (unsigned)wid * 1024u;
    const int aoff = lds_byte(wr * 64 + fr, fq * 8), boff = lds_byte(wc * 32 + fr, fq * 8);
#define PG8_SA(b, h) (((b) * 2 + (h)) * HTB)
#define PG8_SB(b, h) ((4 + (b) * 2 + (h)) * HTB)
#define PG8_STAGE(bufoff, gbase, voff) do { _Pragma("unroll") for (int _i = 0; _i < 2; ++_i) \
        __builtin_amdgcn_global_load_lds((const unsigned*)((const char*)(gbase) + (voff)[_i]), (PG8_LAS unsigned*)(lds + (bufoff) + ldsw + _i * 8192), 16, 0, 0); } while (0)
#define PG8_LDA(dst, b, h) do { _Pragma("unroll") for (int m = 0; m < 4; ++m) _Pragma("unroll") for (int k = 0; k < 2; ++k) dst[m][k] = *(const PG8_LAS bf16x8*)(lds + PG8_SA(b, h) + aoff + m * 2048 + k * 1024); } while (0)
#define PG8_LDB(dst, b, h) do { _Pragma("unroll") for (int n = 0; n < 2; ++n) _Pragma("unroll") for (int k = 0; k < 2; ++k) dst[n][k] = *(const PG8_LAS bf16x8*)(lds + PG8_SB(b, h) + boff + n * 2048 + k * 1024); } while (0)
#define PG8_MMA(ai, bj, At, Bt) do { __builtin_amdgcn_s_setprio(1); _Pragma("unroll") for (int m = 0; m < 4; ++m) _Pragma("unroll") for (int n = 0; n < 2; ++n) _Pragma("unroll") for (int k = 0; k < 2; ++k) \
        acc[ai][bj][m][n] = __builtin_amdgcn_mfma_f32_16x16x32_bf16(Bt[n][k], At[m][k], acc[ai][bj][m][n], 0, 0, 0); __builtin_amdgcn_s_setprio(0); } while (0)
#define PG8_WAIT_V(n) asm volatile("s_waitcnt vmcnt(" #n ")" ::: "memory")
#define PG8_WAIT_L(n) asm volatile("s_waitcnt lgkmcnt(" #n ")" ::: "memory")
#define PG8_BAR __builtin_amdgcn_s_barrier()
#define PG8_SCHED __builtin_amdgcn_sched_barrier(0)
    Unit cur, nxt; int ui = 0;
    if (!S.next(0, cur)) return;
    f32x4 acc[2][2][4][2];
#pragma unroll
    for (int a = 0; a < 2; ++a)
#pragma unroll
        for (int b = 0; b < 2; ++b)
#pragma unroll
            for (int m = 0; m < 4; ++m)
#pragma unroll
                for (int n = 0; n < 2; ++n) acc[a][b][m][n] = (f32x4){0.f, 0.f, 0.f, 0.f};
    bf16x8 At[4][2], B0[2][2], B1[2][2];
    const char* cA = (const char*)g.A + (size_t)cur.pm * tstepA; const char* cB = (const char*)g.Bt + (size_t)cur.pn * tstepB;
    S.a_ready(cur);
    if constexpr (SP2) {
        PG8_STAGE(PG8_SB(0, 0), cB, voffB); PG8_STAGE(PG8_SB(0, 1), cB + hstepB, voffB); PG8_STAGE(PG8_SA(0, 0), cA, voffA); PG8_STAGE(PG8_SA(0, 1), cA + hstepA, voffA);
        if (wr == 1) PG8_BAR;
        PG8_WAIT_V(2); PG8_BAR;
        PG8_STAGE(PG8_SB(1, 0), cB + kstep, voffB); PG8_STAGE(PG8_SA(1, 0), cA + kstep, voffA); PG8_STAGE(PG8_SB(1, 1), cB + hstepB + kstep, voffB);
        PG8_WAIT_V(6); PG8_BAR;
    } else {
        PG8_STAGE(PG8_SB(0, 0), cB, voffB); PG8_STAGE(PG8_SA(0, 0), cA, voffA); PG8_STAGE(PG8_SB(0, 1), cB + hstepB, voffB); PG8_STAGE(PG8_SA(0, 1), cA + hstepA, voffA);
        if (wr == 1) PG8_BAR;
        PG8_WAIT_V(4); PG8_BAR;
        PG8_STAGE(PG8_SB(1, 0), cB + kstep, voffB); PG8_STAGE(PG8_SA(1, 0), cA + kstep, voffA); PG8_STAGE(PG8_SB(1, 1), cB + hstepB + kstep, voffB);
        PG8_WAIT_V(6); PG8_BAR;
    }
    for (;;) {
        const bool has_next = S.next(ui + 1, nxt);
        const char* nA = has_next ? (const char*)g.A + (size_t)nxt.pm * tstepA : cA; const char* nB = has_next ? (const char*)g.Bt + (size_t)nxt.pn * tstepB : cB;
        for (int t = 0; t < nt; t += 2) {
            const bool last = (t == nt - 2);
            const char* a1 = cA + (size_t)(t + 1) * kstep + ((t + 1) >= g.ksplit ? g.ajump : 0);
            const char* a2 = last ? nA : cA + (size_t)(t + 2) * kstep + ((t + 2) >= g.ksplit ? g.ajump : 0); const char* b2 = last ? nB : cB + (size_t)(t + 2) * kstep;
            if constexpr (Epi::HAS_MID) { if (t == Epi::MID_T) E.mid(acc, cur, wr, wc, fr, fq); }
            const char* a3 = a2 + kstep; const char* b3 = b2 + kstep;
            if (last && has_next) S.a_ready(nxt);
            if constexpr (SP2) {
            PG8_LDB(B0, 0, 0); PG8_LDB(B1, 0, 1); PG8_SCHED; PG8_LDA(At, 0, 0); PG8_STAGE(PG8_SA(1, 1), a1 + hstepA, voffA);
            PG8_WAIT_V(8); PG8_WAIT_L(0); PG8_BAR; PG8_MMA(0, 0, At, B0); PG8_MMA(0, 1, At, B1); PG8_BAR; PG8_SCHED;
            PG8_LDA(At, 0, 1); PG8_STAGE(PG8_SB(0, 0), b2, voffB); PG8_STAGE(PG8_SB(0, 1), b2 + hstepB, voffB); PG8_STAGE(PG8_SA(0, 0), a2, voffA);
            PG8_WAIT_V(8); PG8_WAIT_L(0); PG8_BAR; PG8_MMA(1, 0, At, B0); PG8_MMA(1, 1, At, B1); PG8_BAR; PG8_SCHED;
            PG8_LDB(B0, 1, 0); PG8_LDB(B1, 1, 1); PG8_SCHED; PG8_LDA(At, 1, 0); PG8_STAGE(PG8_SA(0, 1), a2 + hstepA, voffA);
            PG8_WAIT_V(8); PG8_WAIT_L(0); PG8_BAR; PG8_MMA(0, 0, At, B0); PG8_MMA(0, 1, At, B1); PG8_BAR; PG8_SCHED;
            PG8_LDA(At, 1, 1); PG8_STAGE(PG8_SB(1, 0), b3, voffB); PG8_STAGE(PG8_SB(1, 1), b3 + hstepB, voffB); PG8_STAGE(PG8_SA(1, 0), a3, voffA);
            PG8_WAIT_V(8); PG8_WAIT_L(0); PG8_BAR; PG8_MMA(1, 0, At, B0); PG8_MMA(1, 1, At, B1); PG8_BAR; PG8_SCHED;
            } else {
            PG8_LDB(B0, 0, 0); PG8_SCHED; PG8_LDA(At, 0, 0); PG8_STAGE(PG8_SA(1, 1), a1 + hstepA, voffA);
            PG8_WAIT_L(8); PG8_BAR; PG8_WAIT_L(0); PG8_MMA(0, 0, At, B0); PG8_BAR; PG8_SCHED;
            PG8_LDB(B1, 0, 1); PG8_STAGE(PG8_SB(0, 0), b2, voffB);
            PG8_BAR; PG8_WAIT_L(0); PG8_MMA(0, 1, At, B1); PG8_BAR;
            PG8_LDA(At, 0, 1); PG8_STAGE(PG8_SA(0, 0), a2, voffA);
            PG8_BAR; PG8_WAIT_L(0); PG8_MMA(1, 0, At, B0); PG8_BAR; PG8_SCHED;
            PG8_STAGE(PG8_SB(0, 1), b2 + hstepB, voffB);
            PG8_WAIT_V(6); PG8_BAR; PG8_MMA(1, 1, At, B1); PG8_BAR;
            PG8_LDB(B0, 1, 0); PG8_SCHED; PG8_LDA(At, 1, 0); PG8_STAGE(PG8_SA(0, 1), a2 + hstepA, voffA);
            PG8_WAIT_L(8); PG8_BAR; PG8_WAIT_L(0); PG8_MMA(0, 0, At, B0); PG8_BAR; PG8_SCHED;
            PG8_LDB(B1, 1, 1); PG8_STAGE(PG8_SB(1, 0), b3, voffB);
            PG8_BAR; PG8_WAIT_L(0); PG8_MMA(0, 1, At, B1); PG8_BAR;
            PG8_LDA(At, 1, 1); PG8_STAGE(PG8_SA(1, 0), a3, voffA);
            PG8_BAR; PG8_WAIT_L(0); PG8_MMA(1, 0, At, B0); PG8_BAR; PG8_SCHED;
            PG8_STAGE(PG8_SB(1, 1), b3 + hstepB, voffB);
            PG8_WAIT_V(6); PG8_BAR; PG8_MMA(1, 1, At, B1); PG8_BAR;
            }
        }
        if constexpr (ALIGN_EPI) { if (wr == 0) PG8_BAR; }
        if constexpr (!Epi::AFTER_DRAIN) { E(acc, cur, wr, wc, fr, fq); S.done(cur); }
        if (!has_next) break;
#pragma unroll
        for (int a = 0; a < 2; ++a)
#pragma unroll
            for (int b = 0; b < 2; ++b)
#pragma unroll
                for (int m = 0; m < 4; ++m)
#pragma unroll
                    for (int n = 0; n < 2; ++n) acc[a][b][m][n] = (f32x4){0.f, 0.f, 0.f, 0.f};
        cur = nxt; cA = nA; cB = nB; ++ui;
        if constexpr (ALIGN_EPI) { if (wr == 1) PG8_BAR; }
    }
    PG8_WAIT_V(0);
    if constexpr (!ALIGN_EPI) { if (wr == 0) PG8_BAR; }
    PG8_BAR;
    if constexpr (Epi::AFTER_DRAIN) { E.fused(acc, cur, wr, wc, fr, fq, lds, wid, lane); S.done(cur); }
#undef PG8_SA
#undef PG8_SB
#undef PG8_STAGE
#undef PG8_LDA
#undef PG8_LDB
#undef PG8_MMA
#undef PG8_WAIT_V
#undef PG8_WAIT_L
#undef PG8_BAR
#undef PG8_SCHED
}
}

using pg8::bf16_t; using pg8::f32x4; using pg8::u32x4; using pg8::Unit; using pg8::cvt_pk_bf16;
constexpr int D = 1024, NBATCH = 8, SEQ = 2048, MP = NBATCH * SEQ, MS = 128, MV = MP + MS  , MALL = MP + 256  ;
constexpr int NIN = 7168, DFF = 2816, NUP = 2 * DFF, PD = 256;
constexpr float EPS = 1e-6f;
constexpr int LDS_BYTES = 131072;

constexpr size_t O_Y = 0;
constexpr size_t O_CAP = (size_t)MV * D;
constexpr size_t O_CAS = O_CAP + (size_t)NBATCH * 2 * D;
constexpr size_t O_CVP = O_CAS + (size_t)MS * 2 * D;
constexpr size_t O_CVS = O_CVP + (size_t)NBATCH * 128 * D;
constexpr size_t O_CFP = O_CVS + (size_t)MS * D;
constexpr size_t O_CFS = O_CFP + (size_t)NBATCH * 2 * NUP;
constexpr size_t O_END = O_CFS + (size_t)MS * 2 * NUP;

struct Ptrs {
    const float *x_p, *x_s, *p_p, *p_s, *st_a, *st_f, *g_mix, *w_in, *w_conv_a, *w_out_a, *g_v, *w_sp, *b_sp, *w_out_b, *w_o, *g_ffn, *w_up, *w_conv_f, *w_down, *g_ple, *w_pg, *w_ple, *g_final;
    float* out; unsigned char* ws;
};
constexpr size_t MiB = 1u << 20;
constexpr size_t WS_WUP = 0, WS_WDOWN = 11 * MiB, WS_WPG = 16 * MiB + MiB / 2, WS_WPLE = 18 * MiB + MiB / 2;
constexpr size_t WS_SMALL = 19 * MiB, WS_CTL = WS_SMALL, CTL_BYTES = 65536;
constexpr size_t WS_RSTD0 = WS_SMALL + 65536, WS_VSSQS = WS_RSTD0 + 131072, WS_SSQ1S = WS_VSSQS + 16384, WS_SSQ2S = WS_SSQ1S + 16384, WS_T1S = WS_SSQ2S + 16384, WS_PES = WS_T1S + 524288;
constexpr size_t WS_VSSQ = 20 * MiB + MiB / 2, WS_SSQ1 = 21 * MiB + 3 * MiB / 4, WS_SSQ2 = 23 * MiB;
constexpr size_t WS_PB = 24 * MiB + MiB / 2;
constexpr size_t WS_WIN = 33 * MiB, WS_WOA = 47 * MiB, WS_WOB = 49 * MiB, WS_WO = 51 * MiB;
constexpr size_t WS_XB = 53 * MiB, WS_CA = 86 * MiB, WS_VP = WS_CA + 65 * MiB / 2, WS_BA = 151 * MiB, WS_UU = 184 * MiB, WS_SGA = 217 * MiB;
constexpr size_t WS_H1B = 222 * MiB, WS_UPH = 33 * MiB, WS_A3 = 123 * MiB, WS_H2B = 33 * MiB, WS_PE = 123 * MiB, WS_HB = 213 * MiB;


typedef const Ptrs __attribute__((address_space(4)))* KPtr;
__device__ __forceinline__ KPtr kargs() { KPtr p = (KPtr)__builtin_amdgcn_kernarg_segment_ptr(); asm volatile("" : "+s"(p)); return p; }
struct Ctx { unsigned char* ws; float* out; };
#define WSP(T, off) ((T*)(c.ws + (off)))
__device__ __forceinline__ float gelu_tanh(float x) {
    const float t = x * x;
    const float u2 = x * (2.3022082f + 0.10294324f * t);
    const float e = __builtin_amdgcn_exp2f(-u2);
    return x * __builtin_amdgcn_rcpf(1.0f + e);
}
__device__ __forceinline__ float sigmoid_f(float x) { return __builtin_amdgcn_rcpf(1.0f + __builtin_amdgcn_exp2f(-1.4426950409f * x)); }
__device__ __forceinline__ float bf2f(unsigned short b) { return __uint_as_float(((unsigned)b) << 16); }
__device__ __forceinline__ void store8_bf16(bf16_t* p, f32x4 v0, f32x4 v1) {
    u32x4 w; w.x = cvt_pk_bf16(v0[0], v0[1]); w.y = cvt_pk_bf16(v0[2], v0[3]); w.z = cvt_pk_bf16(v1[0], v1[1]); w.w = cvt_pk_bf16(v1[2], v1[3]);
    *(u32x4*)p = w;
}
__device__ __forceinline__ void load8_bf16(const bf16_t* p, f32x4& v0, f32x4& v1) {
    const u32x4 w = *(const u32x4*)p;
    v0 = (f32x4){__uint_as_float(w.x << 16), __uint_as_float(w.x & 0xffff0000u), __uint_as_float(w.y << 16), __uint_as_float(w.y & 0xffff0000u)};
    v1 = (f32x4){__uint_as_float(w.z << 16), __uint_as_float(w.z & 0xffff0000u), __uint_as_float(w.w << 16), __uint_as_float(w.w & 0xffff0000u)};
}
__device__ __forceinline__ float sum4sq(f32x4 v) { return (v[0] * v[0] + v[1] * v[1]) + (v[2] * v[2] + v[3] * v[3]); }

__device__ __forceinline__ float row_rstd16(const float* ssq, int r, int fq) {
    const f32x4 a = *(const f32x4*)(ssq + (size_t)r * 16 + 4 * fq);
    float s = (a[0] + a[1]) + (a[2] + a[3]); s += __shfl_xor(s, 16); s += __shfl_xor(s, 32);
    return 1.0f / sqrtf(s * (1.0f / D) + EPS);
}
#define EPI_ROW(ai, m) (u.pm * 256 + (ai) * 128 + wr * 64 + (m) * 16 + fr)
typedef const f32x4 (&AccRef)[2][2][4][2];

struct EpiIn {
    static constexpr bool AFTER_DRAIN = false, HAS_MID = false;
    Ctx c;
    __device__ __forceinline__ void operator()(AccRef acc, const Unit& u, int wr, int wc, int fr, int fq) const {
        const float* rstd0 = WSP(const float, WS_RSTD0); bf16_t* ca = WSP(bf16_t, WS_CA); bf16_t* ba = WSP(bf16_t, WS_BA); bf16_t* uu = WSP(bf16_t, WS_UU); bf16_t* vp = WSP(bf16_t, WS_VP);
        bf16_t* sga = WSP(bf16_t, WS_SGA); bf16_t* sgb = (bf16_t*)c.out; float* vssq = WSP(float, WS_VSSQ); float* out = c.out;
        const int tile = u.pn, hc = wc * 32 + 8 * fq;
        if (tile < 8) {
#pragma unroll
            for (int ai = 0; ai < 2; ++ai)
#pragma unroll
                for (int m = 0; m < 4; ++m) {
                    const int r = EPI_ROW(ai, m); const float rs = rstd0[r];
                    const f32x4 p0 = (acc[ai][0][m][0] * rs) * (acc[ai][1][m][0] * rs), p1 = (acc[ai][0][m][1] * rs) * (acc[ai][1][m][1] * rs);
                    store8_bf16(ca + (size_t)r * D + 128 * tile + hc, p0, p1);
                    if (r < MP) { const int t = r & (SEQ - 1); if (t >= SEQ - 2) { float* o = out + O_CAP + ((size_t)((r >> 11) * 2 + (t - (SEQ - 2)))) * D + 128 * tile + hc; *(f32x4*)o = p0; *(f32x4*)(o + 4) = p1; } }
                    else if (r < MV) { float* o = out + O_CAS + ((size_t)((r - MP) * 2 + 1)) * D + 128 * tile + hc; *(f32x4*)o = p0; *(f32x4*)(o + 4) = p1; }
                }
        } else {
            const int type = (tile - 8) >> 2, tl = (tile - 8) & 3;
            bf16_t* dst = type == 0 ? ba : type == 1 ? uu : type == 2 ? vp : type == 3 ? sga : sgb;
            dst += 256 * tl + hc;
            if (type == 0) {
#pragma unroll
                for (int ai = 0; ai < 2; ++ai)
#pragma unroll
                    for (int m = 0; m < 4; ++m) { const int r = EPI_ROW(ai, m); const float rs = rstd0[r];
#pragma unroll
                        for (int bj = 0; bj < 2; ++bj) store8_bf16(dst + (size_t)r * D + 128 * bj, acc[ai][bj][m][0] * rs, acc[ai][bj][m][1] * rs); }
            } else if (type <= 2) {
#pragma unroll
                for (int ai = 0; ai < 2; ++ai)
#pragma unroll
                    for (int m = 0; m < 4; ++m) { const int r = EPI_ROW(ai, m); const float rs = rstd0[r]; float s = 0.f;
#pragma unroll
                        for (int bj = 0; bj < 2; ++bj) { f32x4 v0 = acc[ai][bj][m][0] * rs, v1 = acc[ai][bj][m][1] * rs;
#pragma unroll
                            for (int j = 0; j < 4; ++j) { v0[j] = gelu_tanh(v0[j]); v1[j] = gelu_tanh(v1[j]); }
                            s += sum4sq(v0) + sum4sq(v1);
                            store8_bf16(dst + (size_t)r * D + 128 * bj, v0, v1); }
                        if (type == 2) { s += __shfl_xor(s, 16); s += __shfl_xor(s, 32); if (fq == 0) vssq[(size_t)r * 16 + tl * 4 + wc] = s; } }
            } else {
#pragma unroll
                for (int ai = 0; ai < 2; ++ai)
#pragma unroll
                    for (int m = 0; m < 4; ++m) { const int r = EPI_ROW(ai, m); const float rs = rstd0[r];
#pragma unroll
                        for (int bj = 0; bj < 2; ++bj) { f32x4 v0 = acc[ai][bj][m][0] * rs, v1 = acc[ai][bj][m][1] * rs;
#pragma unroll
                            for (int j = 0; j < 4; ++j) { v0[j] = sigmoid_f(v0[j]); v1[j] = sigmoid_f(v1[j]); }
                            store8_bf16(dst + (size_t)r * D + 128 * bj, v0, v1); } }
            }
        }
    }
};
struct EpiYab {
    static constexpr bool AFTER_DRAIN = false, HAS_MID = true; static constexpr int MID_T = 16;
    Ctx c;
    __device__ __forceinline__ void mid(f32x4 (&acc)[2][2][4][2], const Unit& u, int wr, int wc, int fr, int fq) const {
        const bf16_t* sga = WSP(const bf16_t, WS_SGA); const bf16_t* sgb = (const bf16_t*)c.out;
        unsigned off0 = (unsigned)(u.pm * 256 + wr * 64 + fr) * D + u.pn * 256 + wc * 32 + 8 * fq;
        asm volatile("" : "+v"(off0));
#pragma unroll
        for (int ai = 0; ai < 2; ++ai)
#pragma unroll
            for (int m = 0; m < 4; ++m) {
#pragma unroll
                for (int bj = 0; bj < 2; ++bj) { const unsigned o = off0 + (unsigned)((128 * ai + 16 * m) * D + 128 * bj); f32x4 a0, a1, b0, b1; load8_bf16(sga + o, a0, a1); load8_bf16(sgb + o, b0, b1);
#pragma unroll
                    for (int j = 0; j < 4; ++j) { acc[ai][bj][m][0][j] *= a0[j] * __builtin_amdgcn_rcpf(b0[j]); acc[ai][bj][m][1][j] *= a1[j] * __builtin_amdgcn_rcpf(b1[j]); } }
                asm volatile("" ::: "memory"); }
    }
    __device__ __forceinline__ void operator()(AccRef acc, const Unit& u, int wr, int wc, int fr, int fq) const {
        const bf16_t* sgb = (const bf16_t*)c.out; bf16_t* mm = WSP(bf16_t, WS_XB);
        const int hc = u.pn * 256 + wc * 32 + 8 * fq;
#pragma unroll
        for (int ai = 0; ai < 2; ++ai)
#pragma unroll
            for (int m = 0; m < 4; ++m) { const int r = EPI_ROW(ai, m);
#pragma unroll
                for (int bj = 0; bj < 2; ++bj) { const size_t o = (size_t)r * D + hc + 128 * bj; f32x4 g0, g1; load8_bf16(sgb + o, g0, g1);
                    store8_bf16(mm + o, g0 * acc[ai][bj][m][0], g1 * acc[ai][bj][m][1]); } }
    }
};
struct EpiYa {
    static constexpr bool AFTER_DRAIN = false, HAS_MID = false;
    Ctx c;
    __device__ __forceinline__ void operator()(AccRef acc, const Unit& u, int wr, int wc, int fr, int fq) const {
        const bf16_t* sga = WSP(const bf16_t, WS_SGA); float* t1 = WSP(float, WS_CA);
        const int hc = u.pn * 256 + wc * 32 + 8 * fq;
#pragma unroll
        for (int ai = 0; ai < 2; ++ai)
#pragma unroll
            for (int m = 0; m < 4; ++m) { const int r = EPI_ROW(ai, m);
#pragma unroll
                for (int bj = 0; bj < 2; ++bj) { const size_t o = (size_t)r * D + hc + 128 * bj; f32x4 g0, g1; load8_bf16(sga + o, g0, g1);
                    *(f32x4*)(t1 + o) = g0 * acc[ai][bj][m][0]; *(f32x4*)(t1 + o + 4) = g1 * acc[ai][bj][m][1]; } }
    }
};
struct EpiYb {
    static constexpr bool AFTER_DRAIN = false, HAS_MID = false;
    Ctx c;
    __device__ __forceinline__ void operator()(AccRef acc, const Unit& u, int wr, int wc, int fr, int fq) const {
        const bf16_t* sgb = (const bf16_t*)c.out; const float* t1 = WSP(const float, WS_CA); bf16_t* mm = WSP(bf16_t, WS_XB);
        const int hc = u.pn * 256 + wc * 32 + 8 * fq;
#pragma unroll
        for (int ai = 0; ai < 2; ++ai)
#pragma unroll
            for (int m = 0; m < 4; ++m) { const int r = EPI_ROW(ai, m);
#pragma unroll
                for (int bj = 0; bj < 2; ++bj) { const size_t o = (size_t)r * D + hc + 128 * bj; f32x4 g0, g1; load8_bf16(sgb + o, g0, g1);
                    const f32x4 a0 = *(const f32x4*)(t1 + o), a1 = *(const f32x4*)(t1 + o + 4);
                    store8_bf16(mm + o, a0 + g0 * acc[ai][bj][m][0], a1 + g1 * acc[ai][bj][m][1]); } }
    }
};
template <int SRC> struct EpiRes {
    static constexpr bool AFTER_DRAIN = false, HAS_MID = false;
    Ctx c;
    __device__ __forceinline__ void operator()(AccRef acc, const Unit& u, int wr, int wc, int fr, int fq) const {
        const KPtr kp = kargs(); const float* xp = kp->x_p; const float* xs = kp->x_s; float* h = c.out; bf16_t* hb = WSP(bf16_t, SRC == 0 ? WS_H1B : WS_H2B); float* ssq = WSP(float, SRC == 0 ? WS_SSQ1 : WS_SSQ2);
        const int hc = u.pn * 256 + wc * 32 + 8 * fq;
#pragma unroll
        for (int ai = 0; ai < 2; ++ai)
#pragma unroll
            for (int m = 0; m < 4; ++m) { const int r = EPI_ROW(ai, m); float s = 0.f; const bool valid = r < MV;
                const float* base = SRC == 1 ? h + (size_t)r * D : (r < MP ? xp + (size_t)r * D : xs + (size_t)(r - MP) * D);
#pragma unroll
                for (int bj = 0; bj < 2; ++bj) { const int c = hc + 128 * bj;
                    f32x4 b0 = (f32x4){0.f, 0.f, 0.f, 0.f}, b1 = b0; if (valid) { b0 = *(const f32x4*)(base + c); b1 = *(const f32x4*)(base + c + 4); }
                    const f32x4 v0 = b0 + acc[ai][bj][m][0], v1 = b1 + acc[ai][bj][m][1];
                    if (valid) { *(f32x4*)(h + (size_t)r * D + c) = v0; *(f32x4*)(h + (size_t)r * D + c + 4) = v1; }
                    store8_bf16(hb + (size_t)r * D + c, v0, v1);
                    s += sum4sq(v0) + sum4sq(v1); }
                s += __shfl_xor(s, 16); s += __shfl_xor(s, 32); if (fq == 0) ssq[(size_t)r * 16 + u.pn * 4 + wc] = s; }
    }
};
struct EpiUp {
    static constexpr bool AFTER_DRAIN = false, HAS_MID = false;
    Ctx c; int half; int pad;
    __device__ __forceinline__ void operator()(AccRef acc, const Unit& u, int wr, int wc, int fr, int fq) const {
        const float* ssq1 = WSP(const float, WS_SSQ1); bf16_t* uph = WSP(bf16_t, WS_UPH); float* out = c.out;
        const int hc = wc * 32 + 8 * fq;
#pragma unroll
        for (int ai = 0; ai < 2; ++ai)
#pragma unroll
            for (int m = 0; m < 4; ++m) { const int r = EPI_ROW(ai, m); const float rs = row_rstd16(ssq1, r, fq);
#pragma unroll
                for (int bj = 0; bj < 2; ++bj) { const f32x4 v0 = acc[ai][bj][m][0] * rs, v1 = acc[ai][bj][m][1] * rs;
                    store8_bf16(uph + (size_t)r * DFF + 256 * u.pn + 128 * bj + hc, v0, v1);
                    const int col = (bj ? DFF : 0) + 1408 * half + 128 * u.pn + hc;
                    if (r < MP) { const int t = r & (SEQ - 1); if (t >= SEQ - 2) { float* o = out + O_CFP + ((size_t)((r >> 11) * 2 + (t - (SEQ - 2)))) * NUP + col; *(f32x4*)o = v0; *(f32x4*)(o + 4) = v1; } }
                    else if (r < MV) { float* o = out + O_CFS + ((size_t)((r - MP) * 2 + 1)) * NUP + col; *(f32x4*)o = v0; *(f32x4*)(o + 4) = v1; } } }
    }
};

__device__ __forceinline__ float dpp_ror1(float x) { return __builtin_bit_cast(float, __builtin_amdgcn_update_dpp(0, __builtin_bit_cast(int, x), 0x121, 0xf, 0xf, false)); }
__device__ __forceinline__ float dpp_ror2(float x) { return __builtin_bit_cast(float, __builtin_amdgcn_update_dpp(0, __builtin_bit_cast(int, x), 0x122, 0xf, 0xf, false)); }
__device__ __forceinline__ f32x4 dpp_ror1(f32x4 v) { return (f32x4){dpp_ror1(v[0]), dpp_ror1(v[1]), dpp_ror1(v[2]), dpp_ror1(v[3])}; }
__device__ __forceinline__ f32x4 dpp_ror2(f32x4 v) { return (f32x4){dpp_ror2(v[0]), dpp_ror2(v[1]), dpp_ror2(v[2]), dpp_ror2(v[3])}; }
#define EPI_BAR() do { asm volatile("s_waitcnt lgkmcnt(0)" ::: "memory"); __builtin_amdgcn_s_barrier(); asm volatile("" ::: "memory"); } while (0)
struct EpiUpF {
    static constexpr bool AFTER_DRAIN = false, HAS_MID = false;
    Ctx c; __attribute__((address_space(3))) float* halo;
    __device__ __forceinline__ void operator()(AccRef acc, const Unit& u, int wr, int wc, int fr, int fq) const {
        const KPtr kp = kargs(); const float* wcf = kp->w_conv_f; float* out = c.out;
        const float* ssq1 = WSP(const float, WS_SSQ1); bf16_t* a3 = WSP(bf16_t, WS_A3); float* hb = WSP(float, WS_HB);
        const int hc = wc * 32 + 8 * fq, ja = 128 * u.pn + hc, jb = DFF + ja, pl = u.pm & 7;
        float rsv[2][4];
#pragma unroll
        for (int ai = 0; ai < 2; ++ai)
#pragma unroll
            for (int m = 0; m < 4; ++m) rsv[ai][m] = row_rstd16(ssq1, EPI_ROW(ai, m), fq);
        if (fr >= 14) {
#pragma unroll
            for (int ai = 0; ai < 2; ++ai)
#pragma unroll
                for (int bj = 0; bj < 2; ++bj)
#pragma unroll
                    for (int n = 0; n < 2; ++n) *(__attribute__((address_space(3))) f32x4*)(halo + ((2 * ai + wr) * 2 + (fr - 14)) * 256 + 128 * bj + hc + 4 * n) = acc[ai][bj][3][n] * rsv[ai][3]; }
        EPI_BAR();
#pragma unroll
        for (int n = 0; n < 2; ++n) {
            f32x4 w[3][2];
#pragma unroll
            for (int tap = 0; tap < 3; ++tap) { w[tap][0] = *(const f32x4*)(wcf + tap * NUP + ja + 4 * n); w[tap][1] = *(const f32x4*)(wcf + tap * NUP + jb + 4 * n); }
#pragma unroll
            for (int ai = 0; ai < 2; ++ai) {
                const int B = 2 * ai + wr;
                f32x4 y1p[2], y2p[2];
                y1p[0] = y1p[1] = y2p[0] = y2p[1] = (f32x4){0.f, 0.f, 0.f, 0.f};
                if (B > 0 && fr < 2) { const __attribute__((address_space(3))) float* hp = halo + ((B - 1) * 2) * 256 + hc + 4 * n;
#pragma unroll
                    for (int bj = 0; bj < 2; ++bj) { const f32x4 r62 = *(const __attribute__((address_space(3))) f32x4*)(hp + 128 * bj), r63 = *(const __attribute__((address_space(3))) f32x4*)(hp + 256 + 128 * bj);
                        y1p[bj] = r63; y2p[bj] = fr == 0 ? r62 : r63; } }
#pragma unroll
                for (int m = 0; m < 4; ++m) {
                    const int r = EPI_ROW(ai, m); const float rs = rsv[ai][m];
                    f32x4 x[2], cv[2];
#pragma unroll
                    for (int bj = 0; bj < 2; ++bj) { x[bj] = acc[ai][bj][m][n] * rs;
                        const f32x4 y1 = dpp_ror1(x[bj]), y2 = dpp_ror2(x[bj]);
                        const f32x4 p1 = fr == 0 ? y1p[bj] : y1, p2 = fr < 2 ? y2p[bj] : y2;
                        cv[bj] = w[0][bj] * p2 + w[1][bj] * p1 + w[2][bj] * x[bj];
                        y1p[bj] = y1; y2p[bj] = y2; }
                    f32x4 o;
#pragma unroll
                    for (int j = 0; j < 4; ++j) o[j] = gelu_tanh(cv[0][j]) * cv[1][j];
                    const bool edge_lo = (B == 0 && m == 0 && fr < 2), edge_hi = (B == 3 && m == 3 && fr >= 14);
                    if (!(edge_lo && pl != 0)) *(unsigned long long*)(a3 + (size_t)r * DFF + ja + 4 * n) = (unsigned long long)cvt_pk_bf16(o[0], o[1]) | ((unsigned long long)cvt_pk_bf16(o[2], o[3]) << 32);
                    if (edge_lo || edge_hi) { float* hrow = hb + ((size_t)u.pm * 4 + (edge_lo ? 2 + fr : fr - 14)) * NUP;
                        *(f32x4*)(hrow + ja + 4 * n) = x[0]; *(f32x4*)(hrow + jb + 4 * n) = x[1];
                        if (edge_hi && pl == 7) { float* o2 = out + O_CFP + ((size_t)((u.pm >> 3) * 2 + (fr - 14))) * NUP; *(f32x4*)(o2 + ja + 4 * n) = x[0]; *(f32x4*)(o2 + jb + 4 * n) = x[1]; } }
                }
            }
        }
    }
};
struct EpiPe {
    static constexpr bool AFTER_DRAIN = false, HAS_MID = false;
    Ctx c;
    __device__ __forceinline__ void operator()(AccRef acc, const Unit& u, int wr, int wc, int fr, int fq) const {
        float* pe = WSP(float, WS_PE);
        const int hc = u.pn * 256 + wc * 32 + 8 * fq;
#pragma unroll
        for (int ai = 0; ai < 2; ++ai)
#pragma unroll
            for (int m = 0; m < 4; ++m) { const int r = EPI_ROW(ai, m);
#pragma unroll
                for (int bj = 0; bj < 2; ++bj) { const size_t o = (size_t)r * D + hc + 128 * bj; *(f32x4*)(pe + o) = acc[ai][bj][m][0]; *(f32x4*)(pe + o + 4) = acc[ai][bj][m][1]; } }
    }
};
struct EpiGate {
    static constexpr bool AFTER_DRAIN = false, HAS_MID = false;
    Ctx c;
    __device__ __forceinline__ void operator()(AccRef acc, const Unit& u, int wr, int wc, int fr, int fq) const {
        const float* ssq2 = WSP(const float, WS_SSQ2); const float* pe = WSP(const float, WS_PE); float* h = c.out;
        const int hc = u.pn * 256 + wc * 32 + 8 * fq;
#pragma unroll
        for (int ai = 0; ai < 2; ++ai)
#pragma unroll
            for (int m = 0; m < 4; ++m) { const int r = EPI_ROW(ai, m); const float rs = row_rstd16(ssq2, r, fq);
#pragma unroll
                for (int bj = 0; bj < 2; ++bj) { const size_t o = (size_t)r * D + hc + 128 * bj;
                    f32x4 g0 = acc[ai][bj][m][0] * rs, g1 = acc[ai][bj][m][1] * rs;
#pragma unroll
                    for (int j = 0; j < 4; ++j) { g0[j] = sigmoid_f(g0[j]); g1[j] = sigmoid_f(g1[j]); }
                    const f32x4 p0 = *(const f32x4*)(pe + o), p1 = *(const f32x4*)(pe + o + 4);
                    const f32x4 h0 = *(const f32x4*)(h + o), h1 = *(const f32x4*)(h + o + 4);
                    *(f32x4*)(h + o) = h0 + g0 * p0; *(f32x4*)(h + o + 4) = h1 + g1 * p1; } }
    }
};


#define LAS __attribute__((address_space(3)))
typedef pg8::bf16x8 bf16x8;
constexpr int LDS_STAGE = 131072, LDS_XTRA_OFF = LDS_STAGE, LDS_XTRA = 8192, LDS_CTL_OFF = LDS_STAGE + LDS_XTRA, LDS_TOTAL = 147456;
#define BLK_BAR() do { asm volatile("s_waitcnt lgkmcnt(0)" ::: "memory"); __builtin_amdgcn_s_barrier(); asm volatile("" ::: "memory"); } while (0)

#define XB_TMO      128
#define XB_XCNT(j)  (256  + 64 * (j))
#define XB_XSUB(j)  (1280 + 64 * (j))
#define XB_XGEN(j)  (2304 + 64 * (j))
#define XB_TOP      3328
#define XB_TOPGEN   3392
#define XCD_BAR_WORDS 3456
#define XB_SPIN_CAP (1u << 18)

__device__ __forceinline__ unsigned xb_ld(unsigned* p)              { return __hip_atomic_load(p, __ATOMIC_RELAXED, __HIP_MEMORY_SCOPE_AGENT); }
__device__ __forceinline__ unsigned xb_add(unsigned* p, unsigned v) { return __hip_atomic_fetch_add(p, v, __ATOMIC_RELAXED, __HIP_MEMORY_SCOPE_AGENT); }
__device__ __forceinline__ unsigned xb_xcc_id() { return (unsigned)__builtin_amdgcn_s_getreg((3 << 11) | 20) & 0xFu; }
#define XB_SPIN(cond, bar) do { unsigned _sp = 0; while (cond) { __builtin_amdgcn_s_sleep(1); \
    if ((++_sp & 255u) == 0u) { if (xb_ld(&(bar)[XB_TMO])) break; if (_sp > XB_SPIN_CAP) { atomicAdd(&(bar)[XB_TMO], 1u); break; } } } } while (0)

struct XcdBarrier {
    unsigned* bar; unsigned x;
    volatile LAS unsigned* st;
};

__device__ __forceinline__ XcdBarrier xcd_barrier_post(unsigned* bar, volatile LAS unsigned* st) {
    XcdBarrier b; b.bar = bar; b.x = xb_xcc_id(); b.st = st;
    if (threadIdx.x == 0) (void)xb_add(&bar[XB_XCNT(b.x)], 1u);
    return b;
}
__device__ __forceinline__ void xcd_barrier_complete(unsigned* bar, unsigned x, unsigned& nloc, unsigned& nx) {
    const unsigned G = gridDim.x * gridDim.y * gridDim.z;
    unsigned sum, cnt, mine, sp = 0u;
    for (;;) {
        sum = 0u; cnt = 0u; mine = 0u;
#pragma unroll
        for (unsigned j = 0; j < 16; ++j) { const unsigned c = xb_ld(&bar[XB_XCNT(j)]); sum += c; cnt += (c > 0u) ? 1u : 0u; mine = (j == x) ? c : mine; }
        if (sum == G) break;
        __builtin_amdgcn_s_sleep(1);
        if ((++sp & 255u) == 0u) { if (xb_ld(&bar[XB_TMO])) break; if (sp > XB_SPIN_CAP) { atomicAdd(&bar[XB_TMO], 1u); break; } }
    }
    nloc = mine > 0u ? mine : 1u; nx = cnt > 0u ? cnt : 1u;
}

__device__ __forceinline__ void xcd_barrier(const XcdBarrier& b) {
    asm volatile("s_waitcnt vmcnt(0)" ::: "memory");
    __syncthreads();
    if (threadIdx.x == 0) {
        unsigned* bar = b.bar;
        __builtin_amdgcn_s_waitcnt(0);
        unsigned nloc = b.st[0], nx = b.st[1];
        if (nloc == 0u) { xcd_barrier_complete(bar, b.x, nloc, nx); b.st[0] = nloc; b.st[1] = nx; }
        const unsigned old = xb_add(&bar[XB_XSUB(b.x)], 1u);
        const unsigned gen = old / nloc;
        if (old + 1u == (gen + 1u) * nloc) {
            __builtin_amdgcn_fence(__ATOMIC_RELEASE, "agent");
            asm volatile("s_waitcnt vmcnt(0)" ::: "memory");
            const unsigned og = xb_add(&bar[XB_TOP], 1u);
            const unsigned tg = og / nx;
            if (og + 1u == (tg + 1u) * nx) xb_add(&bar[XB_TOPGEN], 1u);
            else XB_SPIN(xb_ld(&bar[XB_TOPGEN]) == tg, bar);
            __builtin_amdgcn_fence(__ATOMIC_ACQUIRE, "agent");
            xb_add(&bar[XB_XGEN(b.x)], 1u);
            asm volatile("s_waitcnt vmcnt(0)" ::: "memory");
        } else {
            XB_SPIN(xb_ld(&bar[XB_XGEN(b.x)]) == gen, bar);
            __builtin_amdgcn_fence(__ATOMIC_ACQUIRE, "agent");
            asm volatile("s_waitcnt vmcnt(0)" ::: "memory");
        }
    }
    __syncthreads();
}


__device__ __forceinline__ int otid() { int t = threadIdx.x; asm volatile("" : "+v"(t)); return t; }
__device__ __forceinline__ float wave_sum(float v) {
#pragma unroll
    for (int o = 1; o < 64; o <<= 1) v += __shfl_xor(v, o);
    return v;
}
__device__ __forceinline__ bf16_t f2bf(float x) { return (bf16_t)(cvt_pk_bf16(x, 0.f) & 0xffffu); }

__device__ __forceinline__ int colmap(int mode, int R) {
    const int hc = (R & 96) + pg8::perm32(R & 31);
    const int bj = (R >> 7) & 1, tile = R >> 8;
    if (mode == 0) return (R & ~127) + hc;
    if (mode == 1) { if (tile < 8) return (bj ? 2048 : 0) + 128 * tile + hc;
        const int type = (tile - 8) >> 2, tl = (tile - 8) & 3; const int base = type == 0 ? 1024 : type == 1 ? 3072 : type == 2 ? 4096 : type == 3 ? 5120 : 6144;
        return base + 256 * tl + 128 * bj + hc; }
    return (bj ? DFF : 0) + 128 * tile + hc;
}

template <int RT, int NG, int K, class F>
__device__ __forceinline__ void sample_item(LAS unsigned char* lds, const bf16_t* A, int lda, int rt0, const bf16_t* Bt, int ldb, const int (&gr)[NG], const F& f) {
    static_assert(8 * RT * NG * 1024 <= LDS_STAGE, "sample_item: the eight partial tiles must fit the stage region");
    constexpr int KPER = K / 8, NKS = KPER / 32;
    static_assert(NKS * 32 * 8 == K, "sample_item: K must be a multiple of 256");
    int tid_ = threadIdx.x; asm volatile("" : "+v"(tid_));
    const int tid = tid_, w = __builtin_amdgcn_readfirstlane(tid >> 6), lane = tid & 63, fr = lane & 15, fq = lane >> 4;
    const bf16_t* ap = A + (size_t)(16 * rt0 + fr) * lda + w * KPER + 8 * fq;
    bf16x8 a[RT][NKS], b[NG][NKS];
#pragma unroll
    for (int ks = 0; ks < NKS; ++ks) {
#pragma unroll
        for (int rt = 0; rt < RT; ++rt) a[rt][ks] = *(const bf16x8*)(ap + (size_t)(16 * rt) * lda + 32 * ks);
#pragma unroll
        for (int g = 0; g < NG; ++g) b[g][ks] = *(const bf16x8*)(Bt + (size_t)(gr[g] + fr) * ldb + w * KPER + 8 * fq + 32 * ks);
    }
    f32x4 acc[RT][NG];
#pragma unroll
    for (int rt = 0; rt < RT; ++rt)
#pragma unroll
        for (int g = 0; g < NG; ++g) acc[rt][g] = (f32x4){0.f, 0.f, 0.f, 0.f};
#pragma unroll
    for (int ks = 0; ks < NKS; ++ks)
#pragma unroll
        for (int rt = 0; rt < RT; ++rt)
#pragma unroll
            for (int g = 0; g < NG; ++g) acc[rt][g] = __builtin_amdgcn_mfma_f32_16x16x32_bf16(b[g][ks], a[rt][ks], acc[rt][g], 0, 0, 0);
    LAS float* P = (LAS float*)lds;
#pragma unroll
    for (int rt = 0; rt < RT; ++rt)
#pragma unroll
        for (int g = 0; g < NG; ++g) *(LAS f32x4*)(P + ((w * RT + rt) * NG + g) * 256 + fr * 16 + 4 * fq) = acc[rt][g];
    BLK_BAR();
#pragma unroll
    for (int q = 0; q < (RT * 256 + 511) / 512; ++q) {
        const int e = tid + 512 * q;
        if (e < RT * 256) {
            const int rt = e >> 8, rc = e & 255;
            float v[NG];
#pragma unroll
            for (int g = 0; g < NG; ++g) { float s = 0.f;
#pragma unroll
                for (int w8 = 0; w8 < 8; ++w8) s += P[((w8 * RT + rt) * NG + g) * 256 + rc];
                v[g] = s; }
            f(16 * (rt0 + rt) + (rc >> 4), rc & 15, v);
        }
    }
    BLK_BAR();
}
__device__ __forceinline__ float grp16_sum(float s) {
    s += __shfl_xor(s, 1); s += __shfl_xor(s, 2); s += __shfl_xor(s, 4); s += __shfl_xor(s, 8); return s;
}
__device__ __forceinline__ void sample_rstd_table(LAS float* tab, const float* ssq_s) {
    const int tid = otid();
    if (tid < MS) { const f32x4* p = (const f32x4*)(ssq_s + (size_t)tid * 32); float s = 0.f;
#pragma unroll
        for (int q = 0; q < 8; ++q) { const f32x4 a = p[q]; s += (a[0] + a[1]) + (a[2] + a[3]); }
        tab[tid] = 1.0f / sqrtf(s * (1.0f / D) + EPS); }
    BLK_BAR();
}

struct SfInA {
    Ctx cx; int R0;
    __device__ __forceinline__ void operator()(int i, int c, const float (&v)[6]) const {
        const KPtr kp = kargs(); const float* rstd0 = (const float*)(cx.ws + WS_RSTD0); const float* wca = kp->w_conv_a; const float* sa = kp->st_a; bf16_t* ba = (bf16_t*)(cx.ws + WS_BA); float* out = cx.out;
        const float rs = rstd0[MP + i];
#pragma unroll
        for (int n = 0; n < 2; ++n) { const int ch = colmap(1, R0 + 16 * n + c);
            const float cav = (v[n] * rs) * (v[2 + n] * rs), bb = v[4 + n] * rs;
            out[O_CAS + (size_t)(i * 2 + 1) * D + ch] = cav;
            const float conv = wca[ch] * sa[(size_t)(i * 2) * D + ch] + wca[D + ch] * sa[(size_t)(i * 2 + 1) * D + ch] + wca[2 * D + ch] * cav;
            ba[(size_t)(MP + i) * D + ch] = f2bf(bb * conv); }
    }
};
struct SfInB {
    Ctx cx; int R0, type, slot;
    __device__ __forceinline__ void operator()(int i, int c, const float (&v)[4]) const {
        const float* rstd0 = (const float*)(cx.ws + WS_RSTD0); float* vssq_s = (float*)(cx.ws + WS_VSSQS);
        bf16_t* dst = type == 0 ? (bf16_t*)(cx.ws + WS_UU) : type == 1 ? (bf16_t*)(cx.ws + WS_VP) : type == 2 ? (bf16_t*)(cx.ws + WS_SGA) : (bf16_t*)cx.out;
        const int base = type == 0 ? 3072 : type == 1 ? 4096 : type == 2 ? 5120 : 6144;
        const float rs = rstd0[MP + i]; float s = 0.f;
#pragma unroll
        for (int g = 0; g < 4; ++g) { const int col = colmap(1, R0 + 16 * g + c) - base; float x = v[g] * rs;
            x = type <= 1 ? gelu_tanh(x) : sigmoid_f(x); s += x * x;
            dst[(size_t)(MP + i) * D + col] = f2bf(x); }
        if (type == 1) { s = grp16_sum(s); if (c == 0) vssq_s[i * 16 + slot] = s; }
    }
};
struct SfYa { Ctx cx; int R0;
    __device__ __forceinline__ void operator()(int i, int c, const float (&v)[2]) const {
        const bf16_t* sga = (const bf16_t*)(cx.ws + WS_SGA); float* t1s = (float*)(cx.ws + WS_T1S);
#pragma unroll
        for (int g = 0; g < 2; ++g) { const int col = colmap(0, R0 + 16 * g + c); t1s[i * D + col] = bf2f(sga[(size_t)(MP + i) * D + col]) * v[g]; }
    }
};
struct SfYb { Ctx cx; int R0;
    __device__ __forceinline__ void operator()(int i, int c, const float (&v)[2]) const {
        const bf16_t* sgb = (const bf16_t*)cx.out; const float* t1s = (const float*)(cx.ws + WS_T1S); bf16_t* mm = (bf16_t*)(cx.ws + WS_XB);
#pragma unroll
        for (int g = 0; g < 2; ++g) { const int col = colmap(0, R0 + 16 * g + c); mm[(size_t)(MP + i) * D + col] = f2bf(t1s[i * D + col] + bf2f(sgb[(size_t)(MP + i) * D + col]) * v[g]); }
    }
};
struct SfRes {
    Ctx cx; int R0, slot, which;
    __device__ __forceinline__ void operator()(int i, int c, const float (&v)[2]) const {
        float* h = cx.out; const float* base = which == 0 ? kargs()->x_s : h + (size_t)MP * D; bf16_t* hb = (bf16_t*)(cx.ws + (which == 0 ? WS_H1B : WS_H2B)); float* ssq_s = (float*)(cx.ws + (which == 0 ? WS_SSQ1S : WS_SSQ2S));
        float s = 0.f;
#pragma unroll
        for (int g = 0; g < 2; ++g) { const int col = colmap(0, R0 + 16 * g + c); const float x = base[(size_t)i * D + col] + v[g];
            h[(size_t)(MP + i) * D + col] = x; hb[(size_t)(MP + i) * D + col] = f2bf(x); s += x * x; }
        s = grp16_sum(s); if (c == 0) ssq_s[i * 32 + slot] = s;
    }
};
struct SfUp {
    Ctx cx; const LAS float* rs; int R0;
    __device__ __forceinline__ void operator()(int i, int c, const float (&v)[4]) const {
        const KPtr kp = kargs(); const float* wcf = kp->w_conv_f; const float* sf = kp->st_f; bf16_t* a3 = (bf16_t*)(cx.ws + WS_A3); float* out = cx.out;
        const float r = rs[i];
        float* o = out + O_CFS + (size_t)(i * 2 + 1) * NUP; const float* s0 = sf + (size_t)(i * 2) * NUP; const float* s1 = s0 + NUP;
#pragma unroll
        for (int n = 0; n < 2; ++n) { const int ja = colmap(2, R0 + 16 * n + c), jb = ja + DFF;
            const float ua = v[n] * r, ub = v[2 + n] * r;
            o[ja] = ua; o[jb] = ub;
            const float ca = wcf[ja] * s0[ja] + wcf[NUP + ja] * s1[ja] + wcf[2 * NUP + ja] * ua;
            const float cb = wcf[jb] * s0[jb] + wcf[NUP + jb] * s1[jb] + wcf[2 * NUP + jb] * ub;
            a3[(size_t)(MP + i) * DFF + ja] = f2bf(gelu_tanh(ca) * cb); }
    }
};
struct SfPe { Ctx cx; int R0;
    __device__ __forceinline__ void operator()(int i, int c, const float (&v)[2]) const {
        float* pes = (float*)(cx.ws + WS_PES);
#pragma unroll
        for (int g = 0; g < 2; ++g) pes[i * D + colmap(0, R0 + 16 * g + c)] = v[g];
    }
};
struct SfGate { Ctx cx; const LAS float* rs; int R0;
    __device__ __forceinline__ void operator()(int i, int c, const float (&v)[2]) const {
        const float* pes = (const float*)(cx.ws + WS_PES); float* h = cx.out;
        const float r = rs[i];
#pragma unroll
        for (int g = 0; g < 2; ++g) { const int col = colmap(0, R0 + 16 * g + c); float* hp = h + (size_t)(MP + i) * D + col; *hp = *hp + sigmoid_f(r * v[g]) * pes[i * D + col]; }
    }
};

__device__ __forceinline__ void p0_rows(const KPtr P, bf16_t* xb, float* rstd0, bf16_t* pb) {
    const int tid = otid(), lane = tid & 63, gw = blockIdx.x * 8 + (tid >> 6), NGW = gridDim.x * 8;
    for (int r = gw; r < MV; r += NGW) {
        const f32x4* src = (const f32x4*)(r < MP ? P->x_p + (size_t)r * D : P->x_s + (size_t)(r - MP) * D) + lane;
        f32x4 v[4]; float s = 0.f;
#pragma unroll
        for (int j = 0; j < 4; ++j) { v[j] = src[64 * j]; s += sum4sq(v[j]); }
        s = wave_sum(s);
        if (lane == 0) rstd0[r] = 1.0f / sqrtf(s * (1.0f / D) + EPS);
        unsigned long long* o8 = (unsigned long long*)(xb + (size_t)r * D) + lane;
#pragma unroll
        for (int j = 0; j < 4; ++j) o8[64 * j] = (unsigned long long)cvt_pk_bf16(v[j][0], v[j][1]) | ((unsigned long long)cvt_pk_bf16(v[j][2], v[j][3]) << 32);
    }
    const size_t gt = (size_t)blockIdx.x * 512 + tid, gs = (size_t)gridDim.x * 512;
    for (size_t i4 = gt; i4 < (size_t)MV * PD / 4; i4 += gs) { const size_t i = i4 * 4;
        const f32x4 v = i < (size_t)MP * PD ? *(const f32x4*)(P->p_p + i) : *(const f32x4*)(P->p_s + (i - (size_t)MP * PD));
        *(unsigned long long*)(pb + i) = (unsigned long long)cvt_pk_bf16(v[0], v[1]) | ((unsigned long long)cvt_pk_bf16(v[2], v[3]) << 32); }
    for (size_t e = gt; e < (size_t)MS * (D + NUP); e += gs) { const int i = (int)(e / (D + NUP)), c = (int)(e % (D + NUP));
        if (c < D) P->out[O_CAS + (size_t)(i * 2) * D + c] = P->st_a[(size_t)(i * 2 + 1) * D + c];
        else P->out[O_CFS + (size_t)(i * 2) * NUP + (c - D)] = P->st_f[(size_t)(i * 2 + 1) * NUP + (c - D)]; }
}
struct WtJob { const float* W; const float* scale; bf16_t* out; int ld, Nw, mode, nk; };
__device__ __forceinline__ bool wt_decode(const KPtr P, unsigned char* ws, int& it, WtJob& j) {
    constexpr int T_IN = (NIN / 32) * (D / 64), T_SQ = (D / 32) * (D / 64), T_UP = (NUP / 32) * (D / 64), T_DN = (D / 32) * (DFF / 64), T_PL = (D / 32) * (PD / 64);
    if (it < T_IN) { j.W = P->w_in; j.scale = P->g_mix; j.out = (bf16_t*)(ws + WS_WIN); j.ld = D; j.Nw = NIN; j.mode = 1; j.nk = D / 64; }
    else if ((it -= T_IN) < T_SQ) { j.W = P->w_out_a; j.scale = nullptr; j.out = (bf16_t*)(ws + WS_WOA); j.ld = 2 * D; j.Nw = D; j.mode = 0; j.nk = D / 64; }
    else if ((it -= T_SQ) < T_SQ) { j.W = P->w_out_b; j.scale = nullptr; j.out = (bf16_t*)(ws + WS_WOA) + D; j.ld = 2 * D; j.Nw = D; j.mode = 0; j.nk = D / 64; }
    else if ((it -= T_SQ) < T_SQ) { j.W = P->w_o; j.scale = nullptr; j.out = (bf16_t*)(ws + WS_WO); j.ld = D; j.Nw = D; j.mode = 0; j.nk = D / 64; }
    else if ((it -= T_SQ) < T_SQ) { j.W = P->w_pg; j.scale = P->g_ple; j.out = (bf16_t*)(ws + WS_WPG); j.ld = D; j.Nw = D; j.mode = 0; j.nk = D / 64; }
    else if ((it -= T_SQ) < T_UP) { j.W = P->w_up; j.scale = P->g_ffn; j.out = (bf16_t*)(ws + WS_WUP); j.ld = D; j.Nw = NUP; j.mode = 2; j.nk = D / 64; }
    else if ((it -= T_UP) < T_DN) { j.W = P->w_down; j.scale = nullptr; j.out = (bf16_t*)(ws + WS_WDOWN); j.ld = DFF; j.Nw = D; j.mode = 0; j.nk = DFF / 64; }
    else if ((it -= T_DN) < T_PL) { j.W = P->w_ple; j.scale = nullptr; j.out = (bf16_t*)(ws + WS_WPLE); j.ld = PD; j.Nw = D; j.mode = 0; j.nk = PD / 64; }
    else return false;
    return true;
}
constexpr int WT_ITEMS = (NIN / 32) * (D / 64) + 4 * (D / 32) * (D / 64) + (NUP / 32) * (D / 64) + (D / 32) * (DFF / 64) + (D / 32) * (PD / 64);
__device__ __forceinline__ void p0_weights(const KPtr P, unsigned char* ws, LAS unsigned char* lds) {
    const int tid = otid(), lane = tid & 63, wv = __builtin_amdgcn_readfirstlane(tid >> 6);
    LAS float* scr = (LAS float*)lds + wv * (64 * 33);
    for (int item = blockIdx.x * 8 + wv; item < WT_ITEMS; item += gridDim.x * 8) {
        int it = item; WtJob j; if (!wt_decode(P, ws, it, j)) break;
        const int R0 = (it / j.nk) * 32, k0 = (it % j.nk) * 64, cb = colmap(j.mode, R0);
        const float* src = j.W + (size_t)k0 * j.Nw + cb + (lane & 31);
        float v[32];
#pragma unroll
        for (int i = 0; i < 32; ++i) v[i] = src[(size_t)(2 * i + (lane >> 5)) * j.Nw];
        if (j.scale) {
#pragma unroll
            for (int i = 0; i < 32; ++i) v[i] *= j.scale[k0 + 2 * i + (lane >> 5)]; }
#pragma unroll
        for (int i = 0; i < 32; ++i) scr[(2 * i + (lane >> 5)) * 33 + (lane & 31)] = v[i];
        asm volatile("s_waitcnt lgkmcnt(0)" ::: "memory");
        const int cch = lane & 7;
#pragma unroll
        for (int q = 0; q < 4; ++q) { const int n = (lane >> 3) + 8 * q; const LAS float* s = scr + (8 * cch) * 33 + pg8::perm32(n);
            u32x4 o; o.x = cvt_pk_bf16(s[0 * 33], s[1 * 33]); o.y = cvt_pk_bf16(s[2 * 33], s[3 * 33]); o.z = cvt_pk_bf16(s[4 * 33], s[5 * 33]); o.w = cvt_pk_bf16(s[6 * 33], s[7 * 33]);
            *(u32x4*)(j.out + (size_t)(R0 + n) * j.ld + k0 + 8 * cch) = o; }
        asm volatile("s_waitcnt lgkmcnt(0)" ::: "memory");
    }
    BLK_BAR();
}
__device__ __forceinline__ void p2_convA(const bf16_t* ca, const bf16_t* ba, bf16_t* dst, const float* wc) {
    const f32x4 z = (f32x4){0.f, 0.f, 0.f, 0.f};
    for (size_t idx = (size_t)blockIdx.x * 512 + otid(); idx < (size_t)MP * 128; idx += (size_t)gridDim.x * 512) {
        const int r = (int)(idx >> 7), j = (int)(idx & 127) * 8, t = r & (SEQ - 1);
        f32x4 c0a, c0b, c1a = z, c1b = z, c2a = z, c2b = z;
        load8_bf16(ca + (size_t)r * D + j, c0a, c0b);
        if (t >= 1) load8_bf16(ca + (size_t)(r - 1) * D + j, c1a, c1b);
        if (t >= 2) load8_bf16(ca + (size_t)(r - 2) * D + j, c2a, c2b);
        const f32x4 w0a = *(const f32x4*)(wc + j), w0b = *(const f32x4*)(wc + j + 4), w1a = *(const f32x4*)(wc + D + j), w1b = *(const f32x4*)(wc + D + j + 4),
                    w2a = *(const f32x4*)(wc + 2 * D + j), w2b = *(const f32x4*)(wc + 2 * D + j + 4);
        f32x4 b0, b1; load8_bf16(ba + (size_t)r * D + j, b0, b1);
        store8_bf16(dst + (size_t)r * D + j, b0 * (w0a * c2a + w1a * c1a + w2a * c0a), b1 * (w0b * c2b + w1b * c1b + w2b * c0b));
    }
}
__device__ __forceinline__ unsigned sp_off(unsigned row, unsigned ch) { return 256u * row + 16u * (ch ^ (((row & 3u) << 2) | ((row >> 2) & 3u))); }
typedef unsigned short u16x4_t __attribute__((ext_vector_type(4)));
__device__ __forceinline__ void p2_spatial(const KPtr P, LAS unsigned char* lds, const bf16_t* vp, const bf16_t* uu, bf16_t* udst, const float* vssq) {
    int tid_ = threadIdx.x; asm volatile("" : "+v"(tid_));
    const int tid = tid_, w = __builtin_amdgcn_readfirstlane(tid >> 6), lane = tid & 63, fr = lane & 15, fq = lane >> 4;
    LAS unsigned char* Vimg = lds; LAS unsigned char* Wimg = lds + 32768; LAS float* rs = (LAS float*)(lds + 65536);
    const float* gv = P->g_v; const float* wsp = P->w_sp; const float* bsp = P->b_sp; float* out = P->out;
    int g_loaded = -1;
    for (int it = blockIdx.x; it < (MP / 128) * 8; it += gridDim.x) {
        const int g = it & 7, c = it >> 3, r0 = c * 128, d0 = g * 128;
        if (tid < 128) { const f32x4* p = (const f32x4*)(vssq + (size_t)(r0 + tid) * 16); float s = 0.f;
#pragma unroll
            for (int q = 0; q < 4; ++q) { const f32x4 a = p[q]; s += (a[0] + a[1]) + (a[2] + a[3]); }
            rs[tid] = 1.0f / sqrtf(s * (1.0f / D) + EPS); }
        if (g != g_loaded) {
            const float* W = wsp + (size_t)g * 128 * 128;
#pragma unroll
            for (int i = 0; i < 4; ++i) { const int n = tid + 512 * i, t = n >> 4, ch = n & 15, s0 = 8 * ch;
                f32x4 a = *(const f32x4*)(W + t * 128 + s0), b = *(const f32x4*)(W + t * 128 + s0 + 4);
#pragma unroll
                for (int j = 0; j < 4; ++j) { if (s0 + j > t) a[j] = 0.f; if (s0 + 4 + j > t) b[j] = 0.f; }
                u32x4 pk; pk.x = cvt_pk_bf16(a[0], a[1]); pk.y = cvt_pk_bf16(a[2], a[3]); pk.z = cvt_pk_bf16(b[0], b[1]); pk.w = cvt_pk_bf16(b[2], b[3]);
                *(LAS u32x4*)(Wimg + sp_off(t, ch)) = pk; }
            g_loaded = g;
        }
        BLK_BAR();
        const bool last = (c & 15) == 15; const int b = c >> 4;
#pragma unroll
        for (int i = 0; i < 4; ++i) { const int n = tid + 512 * i, s = n >> 4, ch = n & 15;
            f32x4 a, bq; load8_bf16(vp + (size_t)(r0 + s) * D + d0 + 8 * ch, a, bq);
            const float r = rs[s]; const f32x4 ga = *(const f32x4*)(gv + d0 + 8 * ch), gb = *(const f32x4*)(gv + d0 + 8 * ch + 4);
            a = a * r * ga; bq = bq * r * gb;
            if (last) { float* o = out + O_CVP + ((size_t)(b * 128 + s)) * D + d0 + 8 * ch; *(f32x4*)o = a; *(f32x4*)(o + 4) = bq; }
            u32x4 pk; pk.x = cvt_pk_bf16(a[0], a[1]); pk.y = cvt_pk_bf16(a[2], a[3]); pk.z = cvt_pk_bf16(bq[0], bq[1]); pk.w = cvt_pk_bf16(bq[2], bq[3]);
            *(LAS u32x4*)(Vimg + sp_off(s, ch)) = pk; }
        BLK_BAR();
        const unsigned q4 = (unsigned)(fr >> 2), p4 = (unsigned)(fr & 3);
        const unsigned vbase = (unsigned)(size_t)Vimg;
        const unsigned a0 = vbase + sp_off(8u * fq + q4, 2u * w + (p4 >> 1)) + 8u * (p4 & 1u);
        const unsigned a1 = vbase + sp_off(8u * fq + 4u + q4, 2u * w + (p4 >> 1)) + 8u * (p4 & 1u);
        u16x4_t v00, v01, v10, v11, v20, v21, v30, v31;
        asm volatile("ds_read_b64_tr_b16 %0, %8\n\tds_read_b64_tr_b16 %1, %9\n\tds_read_b64_tr_b16 %2, %8 offset:8192\n\tds_read_b64_tr_b16 %3, %9 offset:8192\n\t"
                     "ds_read_b64_tr_b16 %4, %8 offset:16384\n\tds_read_b64_tr_b16 %5, %9 offset:16384\n\tds_read_b64_tr_b16 %6, %8 offset:24576\n\tds_read_b64_tr_b16 %7, %9 offset:24576\n\t"
                     "s_waitcnt lgkmcnt(0)"
                     : "=&v"(v00), "=&v"(v01), "=&v"(v10), "=&v"(v11), "=&v"(v20), "=&v"(v21), "=&v"(v30), "=&v"(v31) : "v"(a0), "v"(a1) : "memory");
        bf16x8 Vf[4];
        Vf[0] = (bf16x8){(short)v00[0], (short)v00[1], (short)v00[2], (short)v00[3], (short)v01[0], (short)v01[1], (short)v01[2], (short)v01[3]};
        Vf[1] = (bf16x8){(short)v10[0], (short)v10[1], (short)v10[2], (short)v10[3], (short)v11[0], (short)v11[1], (short)v11[2], (short)v11[3]};
        Vf[2] = (bf16x8){(short)v20[0], (short)v20[1], (short)v20[2], (short)v20[3], (short)v21[0], (short)v21[1], (short)v21[2], (short)v21[3]};
        Vf[3] = (bf16x8){(short)v30[0], (short)v30[1], (short)v30[2], (short)v30[3], (short)v31[0], (short)v31[1], (short)v31[2], (short)v31[3]};
        f32x4 acc[8];
#pragma unroll
        for (int tt = 0; tt < 8; ++tt) { acc[tt] = (f32x4){0.f, 0.f, 0.f, 0.f};
#pragma unroll
            for (int ks = 0; ks < 4; ++ks) if (2 * ks <= tt) {
                const bf16x8 Wf = *(const LAS bf16x8*)(Wimg + sp_off((unsigned)(16 * tt + fr), (unsigned)(4 * ks + fq)));
                acc[tt] = __builtin_amdgcn_mfma_f32_16x16x32_bf16(Vf[ks], Wf, acc[tt], 0, 0, 0); } }
#pragma unroll
        for (int tt = 0; tt < 8; ++tt) { const int t = 16 * tt + fr; const float bb = bsp[g * 128 + t];
            const size_t uo = (size_t)(r0 + t) * D + d0 + 16 * w + 4 * fq;
            const unsigned long long uw = *(const unsigned long long*)(uu + uo);
            const float u0 = __uint_as_float((unsigned)(uw << 16)), u1 = __uint_as_float((unsigned)uw & 0xffff0000u), u2 = __uint_as_float((unsigned)(uw >> 32) << 16), u3 = __uint_as_float((unsigned)(uw >> 32) & 0xffff0000u);
            const f32x4 s4 = acc[tt] + bb;
            *(unsigned long long*)(udst + uo) = (unsigned long long)cvt_pk_bf16(u0 * s4[0], u1 * s4[1]) | ((unsigned long long)cvt_pk_bf16(u2 * s4[2], u3 * s4[3]) << 32); }
        BLK_BAR();
    }
}
__device__ __forceinline__ void p2_spatial_s(const KPtr P, const bf16_t* vp, bf16_t* uu, const float* vssq_s) {
    const int tid = otid(), lane = tid & 63, gw = blockIdx.x * 8 + (tid >> 6), NGW = gridDim.x * 8;
    for (int i = gw; i < MS; i += NGW) {
        float s = lane < 16 ? vssq_s[i * 16 + lane] : 0.f; s = wave_sum(s);
        const float rsv = 1.0f / sqrtf(s * (1.0f / D) + EPS); const size_t r = (size_t)(MP + i) * D;
        for (int d = lane; d < D; d += 64) { const int g = d >> 7;
            const float vnv = bf2f(vp[r + d]) * rsv * P->g_v[d];
            P->out[O_CVS + (size_t)i * D + d] = vnv;
            uu[r + d] = f2bf(bf2f(uu[r + d]) * (P->w_sp[(size_t)g * 128 * 128] * vnv + P->b_sp[g * 128])); }
    }
}
__device__ __forceinline__ void p5_convF(const bf16_t* uph, bf16_t* a3, const float* wcf, int half) {
    const f32x4 z = (f32x4){0.f, 0.f, 0.f, 0.f};
    for (size_t idx = (size_t)blockIdx.x * 512 + threadIdx.x; idx < (size_t)MP * 176; idx += (size_t)gridDim.x * 512) {
        const int c8 = (int)(idx & 15), t = (int)((idx >> 4) % 11), r = (int)(idx / 176), tt = r & (SEQ - 1);
        const int c = c8 * 8, ja = 1408 * half + 128 * t + c, jb = DFF + ja;
        const bf16_t* pa = uph + (size_t)r * DFF + 256 * t + c; const bf16_t* pb = pa + 128;
        f32x4 a0[2], a1[2], a2[2], b0[2], b1[2], b2[2];
        load8_bf16(pa, a0[0], a0[1]); load8_bf16(pb, b0[0], b0[1]);
        if (tt >= 1) { load8_bf16(pa - DFF, a1[0], a1[1]); load8_bf16(pb - DFF, b1[0], b1[1]); } else { a1[0] = a1[1] = b1[0] = b1[1] = z; }
        if (tt >= 2) { load8_bf16(pa - 2 * DFF, a2[0], a2[1]); load8_bf16(pb - 2 * DFF, b2[0], b2[1]); } else { a2[0] = a2[1] = b2[0] = b2[1] = z; }
        f32x4 o[2];
#pragma unroll
        for (int q = 0; q < 2; ++q) {
            const f32x4 wa0 = *(const f32x4*)(wcf + ja + 4 * q), wa1 = *(const f32x4*)(wcf + NUP + ja + 4 * q), wa2 = *(const f32x4*)(wcf + 2 * NUP + ja + 4 * q);
            const f32x4 wb0 = *(const f32x4*)(wcf + jb + 4 * q), wb1 = *(const f32x4*)(wcf + NUP + jb + 4 * q), wb2 = *(const f32x4*)(wcf + 2 * NUP + jb + 4 * q);
            f32x4 cav = wa0 * a2[q] + wa1 * a1[q] + wa2 * a0[q]; const f32x4 cbv = wb0 * b2[q] + wb1 * b1[q] + wb2 * b0[q];
#pragma unroll
            for (int j = 0; j < 4; ++j) cav[j] = gelu_tanh(cav[j]);
            o[q] = cav * cbv; }
        store8_bf16(a3 + (size_t)r * DFF + ja, o[0], o[1]);
    }
}
__device__ __forceinline__ void p8_final(const float* h, float* dst, const float* gf) {
    const int tid = otid(), lane = tid & 63, gw = blockIdx.x * 8 + (tid >> 6), NGW = gridDim.x * 8;
    for (int r = gw; r < MV; r += NGW) {
        const f32x4* p = (const f32x4*)(h + (size_t)r * D) + lane; f32x4* pd = (f32x4*)(dst + (size_t)r * D) + lane; f32x4 v[4]; float s = 0.f;
#pragma unroll
        for (int j = 0; j < 4; ++j) { v[j] = p[64 * j]; s += sum4sq(v[j]); }
        s = wave_sum(s); const float rs = 1.0f / sqrtf(s * (1.0f / D) + EPS);
#pragma unroll
        for (int j = 0; j < 4; ++j) { const f32x4 g = *((const f32x4*)gf + lane + 64 * j); pd[64 * j] = v[j] * rs * g; }
    }
}

__device__ __forceinline__ void p6_fixup(const Ctx c, const KPtr P, int pm) {
    if ((pm & 7) == 0) return;
    const float* hb = WSP(const float, WS_HB); bf16_t* a3 = WSP(bf16_t, WS_A3); const float* wcf = P->w_conv_f;
    const float* pv = hb + ((size_t)(pm - 1) * 4) * NUP;
    const float* cu = hb + ((size_t)pm * 4 + 2) * NUP;
    for (int e = otid(); e < 2 * (DFF / 4); e += 512) { const int row = e / (DFF / 4), ja = (e % (DFF / 4)) * 4, jb = DFF + ja;
        f32x4 cv[2];
#pragma unroll
        for (int s = 0; s < 2; ++s) { const int j = s ? jb : ja;
            const f32x4 w0 = *(const f32x4*)(wcf + j), w1 = *(const f32x4*)(wcf + NUP + j), w2 = *(const f32x4*)(wcf + 2 * NUP + j);
            const f32x4 m2 = row == 0 ? *(const f32x4*)(pv + j) : *(const f32x4*)(pv + NUP + j);
            const f32x4 m1 = row == 0 ? *(const f32x4*)(pv + NUP + j) : *(const f32x4*)(cu + j);
            const f32x4 m0 = row == 0 ? *(const f32x4*)(cu + j) : *(const f32x4*)(cu + NUP + j);
            cv[s] = w0 * m2 + w1 * m1 + w2 * m0; }
        f32x4 o;
#pragma unroll
        for (int j = 0; j < 4; ++j) o[j] = gelu_tanh(cv[0][j]) * cv[1][j];
        *(unsigned long long*)(a3 + (size_t)(pm * 256 + row) * DFF + ja) = (unsigned long long)cvt_pk_bf16(o[0], o[1]) | ((unsigned long long)cvt_pk_bf16(o[2], o[3]) << 32); }
    asm volatile("s_waitcnt vmcnt(0)" ::: "memory");
    __syncthreads();
}
template <class Epi> __device__ __forceinline__ void run_gemm(LAS unsigned char* lds, const bf16_t* A, int lda, const bf16_t* Bt, int ldb, int N, int K, const Epi& E) {
    pg8::Gemm g; g.A = A; g.Bt = Bt; g.M = MP; g.N = N; g.K = K; g.lda = lda; g.ldb = ldb; g.ksplit = 1 << 20; g.ajump = 0;
    pg8::StaticOrder S; S.init(MP, N, (int)gridDim.x, (int)blockIdx.x);
    pg8::gemm_phase<Epi, pg8::StaticOrder, true, true>(lds, g, S, E);
}

#ifndef PROBE_A
#define PROBE_A -1
#define PROBE_B -1
#endif
template <class Epi> __device__ __forceinline__ void run_gemm2(LAS unsigned char* lds, const Ctx c, size_t a_off, int lda, size_t b_off, int ldb, int N, int K, const Epi& E, int ksplit = 1 << 20, long ajump = 0) {
    pg8::Gemm g; g.A = (const bf16_t*)(c.ws + a_off); g.Bt = (const bf16_t*)(c.ws + b_off); g.M = MP; g.N = N; g.K = K; g.lda = lda; g.ldb = ldb; g.ksplit = ksplit; g.ajump = ajump;
    pg8::StaticOrder S; S.init(MP, N, (int)gridDim.x, (int)blockIdx.x);
    pg8::gemm_phase<Epi, pg8::StaticOrder, true, true>(lds, g, S, E);
}
__global__ void __launch_bounds__(512, 2) mega_fwd(Ptrs P_unused) {
    extern __shared__ __attribute__((aligned(16))) unsigned char lds_raw[];
    LAS unsigned char* lds = (LAS unsigned char*)lds_raw;
    volatile LAS unsigned* MISC = (volatile LAS unsigned*)(lds + LDS_CTL_OFF);
    if (threadIdx.x < 128) MISC[threadIdx.x] = 0u;
    __syncthreads();
    { const KPtr kp = kargs(); (void)xcd_barrier_post((unsigned*)(kp->ws + WS_CTL), MISC + 8); }
    enum { CNT0 = __COUNTER__ };
#define STAMP(k) do { if (PROBE_A >= 0 && threadIdx.x == 0) ((volatile LAS unsigned*)(lds + LDS_CTL_OFF + 256))[k] = (unsigned)__builtin_amdgcn_s_memrealtime(); } while (0)
#define GRID_BAR() do { XcdBarrier b_; b_.bar = (unsigned*)(kargs()->ws + WS_CTL); b_.x = xb_xcc_id(); b_.st = (volatile LAS unsigned*)(lds + LDS_CTL_OFF) + 8; xcd_barrier(b_); STAMP(__COUNTER__ - CNT0); } while (0)
#define CTX() Ctx c; { const KPtr kp_ = kargs(); c.ws = kp_->ws; c.out = kp_->out; }
    STAMP(0);
#define rstab ((LAS float*)(lds + LDS_XTRA_OFF))
#define G ((int)gridDim.x)
#define bid ((int)blockIdx.x)

    {   CTX();
    { const KPtr kp = kargs();
      p0_rows(kp, WSP(bf16_t, WS_XB), WSP(float, WS_RSTD0), WSP(bf16_t, WS_PB));
      p0_weights(kp, c.ws, lds); }
    }
    GRID_BAR();
    {   CTX();
    { EpiIn E; E.c = c; run_gemm2(lds, c, WS_XB, D, WS_WIN, D, NIN, D, E); }
    for (int it = bid; it < 512; it += G) {
        const bf16_t* As = WSP(const bf16_t, WS_XB) + (size_t)MP * D; const bf16_t* Bt = WSP(const bf16_t, WS_WIN);
        if (it < 256) { const int rt = it >> 5, t = (it >> 2) & 7, wc = it & 3, Rx = t * 256 + wc * 32, Rb = (8 + (t >> 1)) * 256 + (t & 1) * 128 + wc * 32;
            const int gr[6] = {Rx, Rx + 16, Rx + 128, Rx + 144, Rb, Rb + 16};
            SfInA f; f.cx = c; f.R0 = Rx;
            sample_item<1, 6, D>(lds, As, D, rt, Bt, D, gr, f);
        } else { const int j = it - 256, rh = j >> 6, tile = 12 + ((j >> 2) & 15), bj = (j >> 1) & 1, wcp = j & 1, R0 = tile * 256 + bj * 128 + wcp * 64, type = (tile - 12) >> 2;
            const int gr[4] = {R0, R0 + 16, R0 + 32, R0 + 48};
            SfInB f; f.cx = c; f.R0 = R0; f.type = type; f.slot = ((tile - 16) & 3) * 4 + bj * 2 + wcp;
            sample_item<2, 4, D>(lds, As, D, 2 * rh, Bt, D, gr, f); }
    }
    }
    GRID_BAR();
    {   CTX();
    { const KPtr kp = kargs();
      p2_convA(WSP(const bf16_t, WS_CA), WSP(const bf16_t, WS_BA), WSP(bf16_t, WS_BA), kp->w_conv_a);
      p2_spatial(kp, lds, WSP(const bf16_t, WS_VP), WSP(const bf16_t, WS_UU), WSP(bf16_t, WS_UU), WSP(const float, WS_VSSQ));
      p2_spatial_s(kp, WSP(const bf16_t, WS_VP), WSP(bf16_t, WS_UU), WSP(const float, WS_VSSQS)); }
    }
    GRID_BAR();
    {   CTX();
    { EpiYab E; E.c = c; run_gemm2(lds, c, WS_BA, D, WS_WOA, 2 * D, D, 2 * D, E, 16, (long)(WS_UU - WS_BA) - 16 * 128); }
    for (int it = bid; it < 256; it += G) { const int rt = it >> 5, cg = it & 31; const int gr[2] = {cg * 32, cg * 32 + 16};
        { SfYa f; f.cx = c; f.R0 = cg * 32; sample_item<1, 2, D>(lds, WSP(const bf16_t, WS_BA) + (size_t)MP * D, D, rt, WSP(const bf16_t, WS_WOA), 2 * D, gr, f); }
        { SfYb f; f.cx = c; f.R0 = cg * 32; sample_item<1, 2, D>(lds, WSP(const bf16_t, WS_UU) + (size_t)MP * D, D, rt, WSP(const bf16_t, WS_WOA) + D, 2 * D, gr, f); } }
    }
    GRID_BAR();
    {   CTX();
    { EpiRes<0> E; E.c = c; run_gemm2(lds, c, WS_XB, D, WS_WO, D, D, D, E); }
    for (int it = bid; it < 256; it += G) { const int rt = it >> 5, cg = it & 31; const int gr[2] = {cg * 32, cg * 32 + 16}; SfRes f; f.cx = c; f.R0 = cg * 32; f.slot = cg; f.which = 0;
        sample_item<1, 2, D>(lds, WSP(const bf16_t, WS_XB) + (size_t)MP * D, D, rt, WSP(const bf16_t, WS_WO), D, gr, f); }
    }
    GRID_BAR();
    {   CTX();
    { EpiUpF E; E.c = c; E.halo = (LAS float*)(lds + LDS_XTRA_OFF); run_gemm2(lds, c, WS_H1B, D, WS_WUP, D, NUP, D, E); }
    sample_rstd_table(rstab, WSP(const float, WS_SSQ1S));
    for (int it = (G == 256 ? (bid >= 128 ? bid - 128 : 1 << 30) : bid); it < 352; it += (G == 256 ? 128 : G)) { const int rh = it / 88, j = it % 88, T = j >> 2, wc = j & 3, Ra = T * 256 + wc * 32; const int gr[4] = {Ra, Ra + 16, Ra + 128, Ra + 144};
        SfUp f; f.cx = c; f.rs = rstab; f.R0 = Ra;
        sample_item<2, 4, D>(lds, WSP(const bf16_t, WS_H1B) + (size_t)MP * D, D, 2 * rh, WSP(const bf16_t, WS_WUP), D, gr, f); }
    }
    GRID_BAR();
    {   CTX();
    { pg8::StaticOrder S0; S0.init(MP, D, G, bid); pg8::Unit u0; for (int i = 0; S0.next(i, u0); ++i) p6_fixup(c, kargs(), u0.pm); }
    { EpiRes<1> E; E.c = c; run_gemm2(lds, c, WS_A3, DFF, WS_WDOWN, DFF, D, DFF, E); }
    for (int it = bid; it < 256; it += G) { const int rt = it >> 5, cg = it & 31; const int gr[2] = {cg * 32, cg * 32 + 16};
        SfRes f; f.cx = c; f.R0 = cg * 32; f.slot = cg; f.which = 1;
        sample_item<1, 2, DFF>(lds, WSP(const bf16_t, WS_A3) + (size_t)MP * DFF, DFF, rt, WSP(const bf16_t, WS_WDOWN), DFF, gr, f); }
    }
    GRID_BAR();
    {   CTX();
    { EpiPe E; E.c = c; run_gemm2(lds, c, WS_PB, PD, WS_WPLE, PD, D, PD, E); }
    { EpiGate E; E.c = c; run_gemm2(lds, c, WS_H2B, D, WS_WPG, D, D, D, E); }
    sample_rstd_table(rstab, WSP(const float, WS_SSQ2S));
    for (int it = bid; it < 256; it += G) { const int rt = it >> 5, cg = it & 31; const int gr[2] = {cg * 32, cg * 32 + 16};
        { SfPe f; f.cx = c; f.R0 = cg * 32; sample_item<1, 2, PD>(lds, WSP(const bf16_t, WS_PB) + (size_t)MP * PD, PD, rt, WSP(const bf16_t, WS_WPLE), PD, gr, f); }
        { SfGate f; f.cx = c; f.rs = rstab; f.R0 = cg * 32; sample_item<1, 2, D>(lds, WSP(const bf16_t, WS_H2B) + (size_t)MP * D, D, rt, WSP(const bf16_t, WS_WPG), D, gr, f); } }
    }
    GRID_BAR();
    {   CTX();
    p8_final(c.out, c.out, kargs()->g_final);
    }
#if PROBE_A >= 0
    GRID_BAR();
    if (bid == 0) { CTX();
        volatile LAS unsigned* tsl = (volatile LAS unsigned*)(lds + LDS_CTL_OFF + 256);
        const float da = (float)(tsl[PROBE_A + 1] - tsl[PROBE_A]) * 0.01f;
        const float db = (float)(tsl[PROBE_B + 1] - tsl[PROBE_B]) * 0.01f;
        const float sc = 1.0f + da * 0.001f;
        for (int i = threadIdx.x; i < MS * D; i += 512) c.out[(size_t)MP * D + i] *= sc;
        if (threadIdx.x == 0) c.out[O_CAP] += db;
    }
#endif
}

extern "C" void kernel_launch(void* const* d_in, const int* in_sizes, int n_in, void* d_out, int out_size, void* d_ws, size_t ws_size, hipStream_t stream) {
    (void)in_sizes; (void)n_in; (void)out_size; (void)ws_size;
    static int grid = 0;
    if (grid == 0) {
        int dev = 0, cus = 0, per_cu = 0;
        (void)hipGetDevice(&dev); (void)hipDeviceGetAttribute(&cus, hipDeviceAttributeMultiprocessorCount, dev);
        (void)hipFuncSetAttribute((const void*)mega_fwd, hipFuncAttributeMaxDynamicSharedMemorySize, LDS_TOTAL);
        if (hipOccupancyMaxActiveBlocksPerMultiprocessor(&per_cu, (const void*)mega_fwd, 512, LDS_TOTAL) != hipSuccess || per_cu < 1) { per_cu = 1; (void)hipGetLastError(); }
        grid = cus * (per_cu > 1 ? 1 : per_cu);
        if (grid <= 0) grid = 256;
    }
    (void)hipMemsetAsync((char*)d_ws + WS_CTL, 0, CTL_BYTES, stream);
    Ptrs P{};
    const float** pf = (const float**)&P;
    for (int i = 0; i < 23; ++i) pf[i] = (const float*)d_in[i];
    P.out = (float*)d_out; P.ws = (unsigned char*)d_ws;
    void* args[] = {&P};
    hipError_t e = hipLaunchCooperativeKernel((const void*)mega_fwd, dim3(grid), dim3(512), args, LDS_TOTAL, stream);
    if (e != hipSuccess) { fprintf(stderr, "cooperative launch failed: %s (grid %d)\n", hipGetErrorString(e), grid); (void)hipGetLastError();
        hipLaunchKernelGGL(mega_fwd, dim3(grid), dim3(512), LDS_TOTAL, stream, P); }
}
```
